# Optimizing an MI355X kernel written in HIP

```python
import math
import jax, jax.numpy as jnp
from jax import lax
import numpy as np

D_MODEL = 2048
BATCH = 2
SEQ = 16384
DEPTH = 2

N_MIXERS = 2
DIFF_HEADS = 8
DIFF_HEAD_DIM = D_MODEL // DIFF_HEADS // 2
FOX_HEADS = 16
FOX_HEAD_DIM = D_MODEL // FOX_HEADS
D_FF = 5632
REL_BUCKETS = 32
REL_MAX_DIST = 128
Q_BLOCK = 128
ALPHA = (2 * DEPTH) ** 0.25
BETA = (8 * DEPTH) ** -0.25
LN_EPS = 1e-5
N_DIFF = (DEPTH + 1) // 2
N_FOX = DEPTH // 2

kernel_name = "hybrid_diff_fox_macaron_deepnorm"


def layer_norm(x, g, b):
    xf = x.astype(jnp.float32)
    mu = jnp.mean(xf, axis=-1, keepdims=True)
    var = jnp.mean(jnp.square(xf - mu), axis=-1, keepdims=True)
    return ((xf - mu) * lax.rsqrt(var + LN_EPS) * g + b).astype(x.dtype)


def rms_norm(x, g):
    xf = x.astype(jnp.float32)
    return (xf * lax.rsqrt(jnp.mean(jnp.square(xf), axis=-1, keepdims=True) + LN_EPS) * g).astype(x.dtype)


def swiglu(x, wg, wu, wd):
    return (jax.nn.silu(x @ wg) * (x @ wu)) @ wd


def t5_bucket(rel):
    n = jnp.maximum(rel, 0)
    max_exact = REL_BUCKETS // 2
    nf = jnp.maximum(n, 1).astype(jnp.float32)
    large = max_exact + (jnp.log(nf / max_exact) / math.log(REL_MAX_DIST / max_exact)
                         * (REL_BUCKETS - max_exact)).astype(jnp.int32)
    large = jnp.minimum(large, REL_BUCKETS - 1)
    return jnp.where(n < max_exact, n, large)


def diff_attention(x, w_qkv, w_o, lq1, lk1, lq2, lk2, sub_g, rel_table, lam_init):
    B, S, D = x.shape
    H, d = DIFF_HEADS, DIFF_HEAD_DIM
    nb = S // Q_BLOCK
    q, k, v = jnp.split(x @ w_qkv, 3, axis=-1)
    q = q.reshape(B, S, H, 2, d)
    k = k.reshape(B, S, H, 2, d)
    v = v.reshape(B, S, H, 2 * d)
    scale = d ** -0.5
    lam = (jnp.exp(jnp.sum(lq1.astype(jnp.float32) * lk1.astype(jnp.float32)))
           - jnp.exp(jnp.sum(lq2.astype(jnp.float32) * lk2.astype(jnp.float32))) + lam_init)
    qb = q.reshape(B, nb, Q_BLOCK, H, 2, d).transpose(1, 0, 2, 3, 4, 5)
    kpos = jnp.arange(S)

    def block(args):
        qi, bi = args
        qpos = bi * Q_BLOCK + jnp.arange(Q_BLOCK)
        rel = qpos[:, None] - kpos[None, :]
        s = jnp.einsum('bqhmd,bkhmd->bhmqk', qi, k,
                       preferred_element_type=jnp.float32) * scale
        bias = rel_table.astype(jnp.float32)[t5_bucket(rel)].transpose(2, 0, 1)
        s = jnp.where(rel >= 0, s + bias[None, :, None], -jnp.inf)
        p = jax.nn.softmax(s, axis=-1)
        a = p[:, :, 0] - lam * p[:, :, 1]
        return jnp.einsum('bhqk,bkhe->bqhe', a.astype(v.dtype), v)

    o = lax.map(block, (qb, jnp.arange(nb)))
    o = o.transpose(1, 0, 2, 3, 4).reshape(B, S, H, 2 * d)
    o = rms_norm(o, sub_g) * (1.0 - lam_init)
    return o.reshape(B, S, D) @ w_o


def forgetting_attention(x, w_qkv, w_o, w_f, b_f):
    B, S, D = x.shape
    H, d = FOX_HEADS, FOX_HEAD_DIM
    nb = S // Q_BLOCK
    q, k, v = jnp.split(x @ w_qkv, 3, axis=-1)
    q = q.reshape(B, S, H, d)
    k = k.reshape(B, S, H, d)
    v = v.reshape(B, S, H, d)
    logf = jax.nn.log_sigmoid((x @ w_f + b_f).astype(jnp.float32))
    c = jnp.cumsum(logf, axis=1).transpose(0, 2, 1)
    qb = q.reshape(B, nb, Q_BLOCK, H, d).transpose(1, 0, 2, 3, 4)
    cb = c.reshape(B, H, nb, Q_BLOCK).transpose(2, 0, 1, 3)
    kpos = jnp.arange(S)
    scale = d ** -0.5

    def block(args):
        qi, ci, bi = args
        qpos = bi * Q_BLOCK + jnp.arange(Q_BLOCK)
        causal = qpos[:, None] >= kpos[None, :]
        s = jnp.einsum('bqhd,bkhd->bhqk', qi, k, preferred_element_type=jnp.float32) * scale
        s = s + ci[..., None] - c[:, :, None, :]
        s = jnp.where(causal, s, -jnp.inf)
        p = jax.nn.softmax(s, axis=-1)
        return jnp.einsum('bhqk,bkhd->bqhd', p.astype(v.dtype), v)

    o = lax.map(block, (qb, cb, jnp.arange(nb)))
    o = o.transpose(1, 0, 2, 3, 4).reshape(B, S, D)
    return o @ w_o


def setup_inputs(seed: int = 0) -> dict:
    key = jax.random.key(seed)
    ks = jax.random.split(key, 24)
    D, F = D_MODEL, D_FF
    sd = D ** -0.5
    nrm = lambda k, shp, s: jax.random.normal(k, shp, jnp.float32) * s

    def qkv_weight(k, n, out_qk):
        kq, kv = jax.random.split(k)
        qk = nrm(kq, (n, D, 2 * out_qk), sd)
        vv = nrm(kv, (n, D, out_qk), sd * BETA)
        return jnp.concatenate([qk, vv], axis=-1)

    return {
        "x": jax.random.normal(ks[0], (BATCH, SEQ, D), jnp.float32),
        "rel_table": nrm(ks[1], (REL_BUCKETS, DIFF_HEADS), 0.5),
        "ffn1_wg": nrm(ks[2], (DEPTH, D, F), sd),
        "ffn1_wu": nrm(ks[3], (DEPTH, D, F), sd * BETA),
        "ffn1_wd": nrm(ks[4], (DEPTH, F, D), F ** -0.5 * BETA),
        "ffn2_wg": nrm(ks[5], (DEPTH, D, F), sd),
        "ffn2_wu": nrm(ks[6], (DEPTH, D, F), sd * BETA),
        "ffn2_wd": nrm(ks[7], (DEPTH, F, D), F ** -0.5 * BETA),
        "ln_g": 1.0 + nrm(ks[8], (DEPTH, 3, D), 0.02),
        "ln_b": nrm(ks[9], (DEPTH, 3, D), 0.02),
        "diff_wqkv": qkv_weight(ks[10], N_DIFF, D),
        "diff_wo": nrm(ks[11], (N_DIFF, D, D), sd * BETA),
        "diff_lq1": nrm(ks[12], (N_DIFF, DIFF_HEAD_DIM), 0.1),
        "diff_lk1": nrm(ks[13], (N_DIFF, DIFF_HEAD_DIM), 0.1),
        "diff_lq2": nrm(ks[14], (N_DIFF, DIFF_HEAD_DIM), 0.1),
        "diff_lk2": nrm(ks[15], (N_DIFF, DIFF_HEAD_DIM), 0.1),
        "diff_subln_g": 1.0 + nrm(ks[16], (N_DIFF, 2 * DIFF_HEAD_DIM), 0.02),
        "fox_wqkv": qkv_weight(ks[17], N_FOX, D),
        "fox_wo": nrm(ks[18], (N_FOX, D, D), sd * BETA),
        "fox_wf": nrm(ks[19], (N_FOX, D, FOX_HEADS), sd),
        "fox_bf": jax.random.uniform(ks[20], (N_FOX, FOX_HEADS), jnp.float32, 1.0, 6.0),
    }


def reference(x, rel_table, ffn1_wg, ffn1_wu, ffn1_wd, ffn2_wg, ffn2_wu, ffn2_wd, ln_g, ln_b,
              diff_wqkv, diff_wo, diff_lq1, diff_lk1, diff_lq2, diff_lk2, diff_subln_g,
              fox_wqkv, fox_wo, fox_wf, fox_bf):
    for i in range(DEPTH):
        j = i // N_MIXERS
        x = layer_norm(ALPHA * x + 0.5 * swiglu(x, ffn1_wg[i], ffn1_wu[i], ffn1_wd[i]), ln_g[i, 0], ln_b[i, 0])
        if i % N_MIXERS == 0:
            lam_init = 0.8 - 0.6 * math.exp(-0.3 * i)
            m = diff_attention(x, diff_wqkv[j], diff_wo[j], diff_lq1[j], diff_lk1[j], diff_lq2[j],
                               diff_lk2[j], diff_subln_g[j], rel_table, lam_init)
        else:
            m = forgetting_attention(x, fox_wqkv[j], fox_wo[j], fox_wf[j], fox_bf[j])
        x = layer_norm(ALPHA * x + m, ln_g[i, 1], ln_b[i, 1])
        x = layer_norm(ALPHA * x + 0.5 * swiglu(x, ffn2_wg[i], ffn2_wu[i], ffn2_wd[i]), ln_g[i, 2], ln_b[i, 2])
    return x
```

```cpp
#include <hip/hip_runtime.h>
#include <hip/hip_cooperative_groups.h>
#include <hip/hip_bf16.h>
#include <cstdio>
#include <cstdint>
#include <cmath>
namespace pg8 {
#define PG8_LAS __attribute__((address_space(3)))
typedef unsigned short bf16_t;
typedef short bf16x8 __attribute__((ext_vector_type(8)));
typedef float f32x4 __attribute__((ext_vector_type(4)));
typedef unsigned u32x4 __attribute__((ext_vector_type(4)));
constexpr int BM = 256, BK = 64, HALF = 128, HTB = HALF * BK * 2  , STAGE_BYTES = 8 * HTB, NXCD = 8, WGM = 8;

__host__ __device__ __forceinline__ int lds_byte(int r, int c) { const int st = (r >> 4) * 2 + (c >> 5), rr = r & 15, cc = c & 31, ob = rr * 64 + cc * 2; return st * 1024 + (ob ^ (((ob >> 9) & 1) << 5)); }
__host__ __device__ __forceinline__ void stage_rc(int b, int& R, int& C) { const int st = b / 1024, sb = b % 1024, swz = sb ^ (((sb >> 9) & 1) << 5); R = (st >> 1) * 16 + swz / 64; C = (st & 1) * 32 + (swz % 64) / 2; }
__host__ __device__ __forceinline__ int perm32(int rho) { const int n = rho >> 4, i = rho & 15; return 8 * (i >> 2) + 4 * n + (i & 3); }

struct Unit { int pm, pn; };
struct Gemm { const bf16_t* A; const bf16_t* Bt; int M, N, K; };

struct StaticOrder {
    int nM, nN, nwg, G, c;
    __host__ __device__ void init(int M, int N, int G_, int c_) { nM = M / BM; nN = N / BM; nwg = nM * nN; G = G_; c = c_; }
    __host__ __device__ bool next(int i, Unit& u) const {
        const long L = (long)i * G + c; if (L >= nwg) return false;
        int wgid = (int)L; { const int q = nwg / NXCD, r = nwg % NXCD, xcd = wgid % NXCD, off = wgid / NXCD; wgid = (xcd < r ? xcd * (q + 1) : r * (q + 1) + (xcd - r) * q) + off; }
        const int nig = WGM * nN, gid = wgid / nig, fm = gid * WGM, gsz = (nM - fm) < WGM ? (nM - fm) : WGM;
        u.pm = fm + ((wgid % nig) % gsz); u.pn = (wgid % nig) / gsz; return true;
    }
    __device__ __forceinline__ void a_ready(const Unit&) const {}
    __device__ __forceinline__ void done(const Unit&) const {}
};

__device__ __forceinline__ unsigned cvt_pk_bf16(float lo, float hi) { unsigned r; asm volatile("v_cvt_pk_bf16_f32 %0, %1, %2" : "=v"(r) : "v"(lo), "v"(hi)); return r; }
typedef float f32x2 __attribute__((ext_vector_type(2)));
struct EpiBf16S {
    static constexpr bool PERM = true, AFTER_DRAIN = false;
    bf16_t* O; int ldc; int scale_cols; float scale0;
    __device__ __forceinline__ void operator()(const f32x4 (&acc)[2][2][4][2], const Unit& u, int wr, int wc, int fr, int fq) const {
        const int row0 = u.pm * BM + wr * 64 + fr; const int colt = u.pn * BM;
        const float sc = (colt < scale_cols) ? scale0 : 1.f;
        const int col0 = colt + wc * 32 + 8 * fq;
#pragma unroll
        for (int ai = 0; ai < 2; ++ai)
#pragma unroll
            for (int m = 0; m < 4; ++m) { bf16_t* rowp = O + (size_t)(row0 + ai * HALF + m * 16) * ldc + col0;
#pragma unroll
                for (int bj = 0; bj < 2; ++bj) { f32x4 v0 = acc[ai][bj][m][0] * sc, v1 = acc[ai][bj][m][1] * sc;
                    u32x4 w; w.x = cvt_pk_bf16(v0[0], v0[1]); w.y = cvt_pk_bf16(v0[2], v0[3]); w.z = cvt_pk_bf16(v1[0], v1[1]); w.w = cvt_pk_bf16(v1[2], v1[3]);
                    *(u32x4*)(rowp + bj * HALF) = w; } }
    }
};
__device__ __forceinline__ float silu_mul(float g, float u) { return g * __builtin_amdgcn_rcpf(1.f + __builtin_amdgcn_exp2f(-1.4426950408889634f * g)) * u; }
struct EpiSwiGLU {
    static constexpr bool PERM = true, AFTER_DRAIN = false;
    bf16_t* H; int ldh;
    __device__ __forceinline__ void operator()(const f32x4 (&acc)[2][2][4][2], const Unit& u, int wr, int wc, int fr, int fq) const {
        const int row0 = u.pm * BM + wr * 64 + fr; const int col0 = u.pn * HALF + wc * 32 + 8 * fq;
#pragma unroll
        for (int ai = 0; ai < 2; ++ai)
#pragma unroll
            for (int m = 0; m < 4; ++m) { bf16_t* rowp = H + (size_t)(row0 + ai * HALF + m * 16) * ldh + col0;
                const f32x4 g0 = acc[ai][0][m][0], g1 = acc[ai][0][m][1], u0 = acc[ai][1][m][0], u1 = acc[ai][1][m][1];
                u32x4 w;
                w.x = cvt_pk_bf16(silu_mul(g0[0], u0[0]), silu_mul(g0[1], u0[1])); w.y = cvt_pk_bf16(silu_mul(g0[2], u0[2]), silu_mul(g0[3], u0[3]));
                w.z = cvt_pk_bf16(silu_mul(g1[0], u1[0]), silu_mul(g1[1], u1[1])); w.w = cvt_pk_bf16(silu_mul(g1[2], u1[2]), silu_mul(g1[3], u1[3]));
                *(u32x4*)rowp = w; }
    }
};
struct EpiRes {
    static constexpr bool PERM = false, AFTER_DRAIN = false;
    const float* base; float* out; int ldc; float alpha, s;
    __device__ __forceinline__ void operator()(const f32x4 (&acc)[2][2][4][2], const Unit& u, int wr, int wc, int fr, int fq) const {
        const int row0 = u.pm * BM + wr * 64 + fr; const int col0 = u.pn * BM + wc * 32 + 4 * fq;
#pragma unroll
        for (int ai = 0; ai < 2; ++ai)
#pragma unroll
            for (int m = 0; m < 4; ++m) { const size_t off = (size_t)(row0 + ai * HALF + m * 16) * ldc + col0;
#pragma unroll
                for (int bj = 0; bj < 2; ++bj)
#pragma unroll
                    for (int n = 0; n < 2; ++n) { const f32x4 bs = *(const f32x4*)(base + off + bj * HALF + n * 16);
                        const f32x4 o = bs * alpha + acc[ai][bj][m][n] * s; *(f32x4*)(out + off + bj * HALF + n * 16) = o; } }
    }
};
template <class Epi, class Sched, bool ALIGN_EPI = false, bool SP2 = false>
__device__ __forceinline__ void gemm_phase(PG8_LAS unsigned char* lds, const Gemm g, const Sched& S, const Epi& E) {
    const int tid = threadIdx.x, wid = __builtin_amdgcn_readfirstlane(tid >> 6), lane = tid & 63, wr = wid >> 2, wc = wid & 3, fr = lane & 15, fq = lane >> 4;
    const int K = g.K, nt = K / BK;
    unsigned voffA[2], voffB[2];
#pragma unroll
    for (int i = 0; i < 2; ++i) { int R, C; stage_rc(tid * 16 + i * 8192, R, C); const int Rb = Epi::PERM ? ((R & ~31) + perm32(R & 31)) : R;
        voffA[i] = (unsigned)(R * K + C) * 2u; voffB[i] = (unsigned)(Rb * K + C) * 2u; }
    const size_t kstep = (size_t)(BK * 2);
    const size_t hstep = (size_t)HALF * K * 2;
    const size_t tstep = 2 * hstep;
    const unsigned ldsw = (unsigned)wid * 1024u;
    const int aoff = lds_byte(wr * 64 + fr, fq * 8), boff = lds_byte(wc * 32 + fr, fq * 8);
#define PG8_SA(b, h) (((b) * 2 + (h)) * HTB)
#define PG8_SB(b, h) ((4 + (b) * 2 + (h)) * HTB)
#define PG8_STAGE(bufoff, gbase, voff) do { _Pragma("unroll") for (int _i = 0; _i < 2; ++_i) \
        __builtin_amdgcn_global_load_lds((const unsigned*)((const char*)(gbase) + (voff)[_i]), (PG8_LAS unsigned*)(lds + (bufoff) + ldsw + _i * 8192), 16, 0, 0); } while (0)
#define PG8_LDA(dst, b, h) do { _Pragma("unroll") for (int m = 0; m < 4; ++m) _Pragma("unroll") for (int k = 0; k < 2; ++k) dst[m][k] = *(const PG8_LAS bf16x8*)(lds + PG8_SA(b, h) + aoff + m * 2048 + k * 1024); } while (0)
#define PG8_LDB(dst, b, h) do { _Pragma("unroll") for (int n = 0; n < 2; ++n) _Pragma("unroll") for (int k = 0; k < 2; ++k) dst[n][k] = *(const PG8_LAS bf16x8*)(lds + PG8_SB(b, h) + boff + n * 2048 + k * 1024); } while (0)
#define PG8_MMA(ai, bj, At, Bt) do { __builtin_amdgcn_s_setprio(1); _Pragma("unroll") for (int m = 0; m < 4; ++m) _Pragma("unroll") for (int n = 0; n < 2; ++n) _Pragma("unroll") for (int k = 0; k < 2; ++k) \
        acc[ai][bj][m][n] = __builtin_amdgcn_mfma_f32_16x16x32_bf16(Bt[n][k], At[m][k], acc[ai][bj][m][n], 0, 0, 0); __builtin_amdgcn_s_setprio(0); } while (0)
#define PG8_WAIT_V(n) asm volatile("s_waitcnt vmcnt(" #n ")" ::: "memory")
#define PG8_WAIT_L(n) asm volatile("s_waitcnt lgkmcnt(" #n ")" ::: "memory")
#define PG8_BAR __builtin_amdgcn_s_barrier()
#define PG8_SCHED __builtin_amdgcn_sched_barrier(0)
    Unit cur, nxt; int ui = 0;
    if (!S.next(0, cur)) return;
    f32x4 acc[2][2][4][2];
#pragma unroll
    for (int a = 0; a < 2; ++a)
#pragma unroll
        for (int b = 0; b < 2; ++b)
#pragma unroll
            for (int m = 0; m < 4; ++m)
#pragma unroll
                for (int n = 0; n < 2; ++n) acc[a][b][m][n] = (f32x4){0.f, 0.f, 0.f, 0.f};
    bf16x8 At[4][2], B0[2][2], B1[2][2];
    const char* cA = (const char*)g.A + (size_t)cur.pm * tstep; const char* cB = (const char*)g.Bt + (size_t)cur.pn * tstep;
    S.a_ready(cur);
    if constexpr (SP2) {
        PG8_STAGE(PG8_SB(0, 0), cB, voffB); PG8_STAGE(PG8_SB(0, 1), cB + hstep, voffB); PG8_STAGE(PG8_SA(0, 0), cA, voffA); PG8_STAGE(PG8_SA(0, 1), cA + hstep, voffA);
        if (wr == 1) PG8_BAR;
        PG8_WAIT_V(2); PG8_BAR;
        PG8_STAGE(PG8_SB(1, 0), cB + kstep, voffB); PG8_STAGE(PG8_SA(1, 0), cA + kstep, voffA); PG8_STAGE(PG8_SB(1, 1), cB + hstep + kstep, voffB);
        PG8_WAIT_V(6); PG8_BAR;
    } else {
        PG8_STAGE(PG8_SB(0, 0), cB, voffB); PG8_STAGE(PG8_SA(0, 0), cA, voffA); PG8_STAGE(PG8_SB(0, 1), cB + hstep, voffB); PG8_STAGE(PG8_SA(0, 1), cA + hstep, voffA);
        if (wr == 1) PG8_BAR;
        PG8_WAIT_V(4); PG8_BAR;
        PG8_STAGE(PG8_SB(1, 0), cB + kstep, voffB); PG8_STAGE(PG8_SA(1, 0), cA + kstep, voffA); PG8_STAGE(PG8_SB(1, 1), cB + hstep + kstep, voffB);
        PG8_WAIT_V(6); PG8_BAR;
    }
    for (;;) {
        const bool has_next = S.next(ui + 1, nxt);
        const char* nA = has_next ? (const char*)g.A + (size_t)nxt.pm * tstep : cA; const char* nB = has_next ? (const char*)g.Bt + (size_t)nxt.pn * tstep : cB;
        for (int t = 0; t < nt; t += 2) {
            const bool last = (t == nt - 2);
            const char* a1 = cA + (size_t)(t + 1) * kstep;
            const char* a2 = last ? nA : cA + (size_t)(t + 2) * kstep; const char* b2 = last ? nB : cB + (size_t)(t + 2) * kstep;
            const char* a3 = a2 + kstep; const char* b3 = b2 + kstep;
            if (last && has_next) S.a_ready(nxt);
            if constexpr (SP2) {
            PG8_LDB(B0, 0, 0); PG8_LDB(B1, 0, 1); PG8_SCHED; PG8_LDA(At, 0, 0); PG8_STAGE(PG8_SA(1, 1), a1 + hstep, voffA);
            PG8_WAIT_V(8); PG8_WAIT_L(0); PG8_BAR; PG8_MMA(0, 0, At, B0); PG8_MMA(0, 1, At, B1); PG8_BAR; PG8_SCHED;
            PG8_LDA(At, 0, 1); PG8_STAGE(PG8_SB(0, 0), b2, voffB); PG8_STAGE(PG8_SB(0, 1), b2 + hstep, voffB); PG8_STAGE(PG8_SA(0, 0), a2, voffA);
            PG8_WAIT_V(8); PG8_WAIT_L(0); PG8_BAR; PG8_MMA(1, 0, At, B0); PG8_MMA(1, 1, At, B1); PG8_BAR; PG8_SCHED;
            PG8_LDB(B0, 1, 0); PG8_LDB(B1, 1, 1); PG8_SCHED; PG8_LDA(At, 1, 0); PG8_STAGE(PG8_SA(0, 1), a2 + hstep, voffA);
            PG8_WAIT_V(8); PG8_WAIT_L(0); PG8_BAR; PG8_MMA(0, 0, At, B0); PG8_MMA(0, 1, At, B1); PG8_BAR; PG8_SCHED;
            PG8_LDA(At, 1, 1); PG8_STAGE(PG8_SB(1, 0), b3, voffB); PG8_STAGE(PG8_SB(1, 1), b3 + hstep, voffB); PG8_STAGE(PG8_SA(1, 0), a3, voffA);
            PG8_WAIT_V(8); PG8_WAIT_L(0); PG8_BAR; PG8_MMA(1, 0, At, B0); PG8_MMA(1, 1, At, B1); PG8_BAR; PG8_SCHED;
            } else {
            PG8_LDB(B0, 0, 0); PG8_SCHED; PG8_LDA(At, 0, 0); PG8_STAGE(PG8_SA(1, 1), a1 + hstep, voffA);
            PG8_WAIT_L(8); PG8_BAR; PG8_WAIT_L(0); PG8_MMA(0, 0, At, B0); PG8_BAR; PG8_SCHED;
            PG8_LDB(B1, 0, 1); PG8_STAGE(PG8_SB(0, 0), b2, voffB);
            PG8_BAR; PG8_WAIT_L(0); PG8_MMA(0, 1, At, B1); PG8_BAR;
            PG8_LDA(At, 0, 1); PG8_STAGE(PG8_SA(0, 0), a2, voffA);
            PG8_BAR; PG8_WAIT_L(0); PG8_MMA(1, 0, At, B0); PG8_BAR; PG8_SCHED;
            PG8_STAGE(PG8_SB(0, 1), b2 + hstep, voffB);
            PG8_WAIT_V(6); PG8_BAR; PG8_MMA(1, 1, At, B1); PG8_BAR;
            PG8_LDB(B0, 1, 0); PG8_SCHED; PG8_LDA(At, 1, 0); PG8_STAGE(PG8_SA(0, 1), a2 + hstep, voffA);
            PG8_WAIT_L(8); PG8_BAR; PG8_WAIT_L(0); PG8_MMA(0, 0, At, B0); PG8_BAR; PG8_SCHED;
            PG8_LDB(B1, 1, 1); PG8_STAGE(PG8_SB(1, 0), b3, voffB);
            PG8_BAR; PG8_WAIT_L(0); PG8_MMA(0, 1, At, B1); PG8_BAR;
            PG8_LDA(At, 1, 1); PG8_STAGE(PG8_SA(1, 0), a3, voffA);
            PG8_BAR; PG8_WAIT_L(0); PG8_MMA(1, 0, At, B0); PG8_BAR; PG8_SCHED;
            PG8_STAGE(PG8_SB(1, 1), b3 + hstep, voffB);
            PG8_WAIT_V(6); PG8_BAR; PG8_MMA(1, 1, At, B1); PG8_BAR;
            }
        }
        if constexpr (ALIGN_EPI) { if (wr == 0) PG8_BAR; }
        if constexpr (!Epi::AFTER_DRAIN) { E(acc, cur, wr, wc, fr, fq); S.done(cur); }
        if (!has_next) break;
#pragma unroll
        for (int a = 0; a < 2; ++a)
#pragma unroll
            for (int b = 0; b < 2; ++b)
#pragma unroll
                for (int m = 0; m < 4; ++m)
#pragma unroll
                    for (int n = 0; n < 2; ++n) acc[a][b][m][n] = (f32x4){0.f, 0.f, 0.f, 0.f};
        cur = nxt; cA = nA; cB = nB; ++ui;
        if constexpr (ALIGN_EPI) { if (wr == 1) PG8_BAR; }
    }
    PG8_WAIT_V(0);
    if constexpr (!ALIGN_EPI) { if (wr == 0) PG8_BAR; }
    PG8_BAR;
    if constexpr (Epi::AFTER_DRAIN) { E.fused(acc, cur, wr, wc, fr, fq, lds, wid, lane); S.done(cur); }
#undef PG8_SA
#undef PG8_SB
#undef PG8_STAGE
#undef PG8_LDA
#undef PG8_LDB
#undef PG8_MMA
#undef PG8_WAIT_V
#undef PG8_WAIT_L
#undef PG8_BAR
#undef PG8_SCHED
}
}
namespace att {
using bf16 = __hip_bfloat16;
typedef short bf16x8 __attribute__((ext_vector_type(8)));
typedef short s16x4 __attribute__((ext_vector_type(4)));
typedef float f32x16 __attribute__((ext_vector_type(16)));
typedef float f32x4 __attribute__((ext_vector_type(4)));
typedef unsigned u32x4 __attribute__((ext_vector_type(4)));
constexpr int D = 128, NW = 8, QBLK = 32, KVBLK = 64, QB = NW * QBLK;
constexpr int SHM_V = KVBLK * D * 2, SHM_K = KVBLK * D * 2;
constexpr int OFF_WS = 2 * SHM_V + 2 * SHM_K;
constexpr int OFF_CK = OFF_WS + NW * 64 * 4;
constexpr int OFF_BT = OFF_CK + 512;
constexpr int LDS_BYTES = OFF_BT + 8 * 128 * 4;
constexpr int LDQ = 6144;
constexpr float THR2 = 11.5f;
constexpr float LOG2E = 1.4426950408889634f;
constexpr unsigned WBIG = 1u << 30;

#define KSWZ(row, colB) ((row) * 256 + ((colB) ^ (((row) & 7) << 4)))
#define SBAR() __builtin_amdgcn_sched_barrier(0)
__device__ __forceinline__ int v_st(int k, int c) { const int kk = (k & ~0xC) | ((k & 4) << 1) | ((k & 8) >> 1); return ((kk >> 3) * 4 + (c >> 5)) * 512 + ((kk & 7) * 32 + (c & 31)) * 2; }
__device__ __forceinline__ int v_rd_base(int lane) { return ((lane & 3) << 3) | (((lane >> 2) & 3) << 6) | (((lane >> 4) & 1) << 5) | (((lane >> 5) & 1) << 8); }
constexpr int v_rd_off(int d0, int ks, int half) { return d0 * 512 + ks * 4096 + half * 2048; }
__device__ __forceinline__ int crow(int r, int hi) { return (r & 3) + 8 * (r >> 2) + 4 * hi; }
__device__ __forceinline__ unsigned cvtpk(float lo, float hi) { unsigned r; asm volatile("v_cvt_pk_bf16_f32 %0, %1, %2" : "=v"(r) : "v"(lo), "v"(hi)); return r; }
__device__ __forceinline__ bf16x8 load8(const bf16* p) { return *reinterpret_cast<const bf16x8*>(p); }
__device__ __forceinline__ void mask_tile(f32x16& p0, f32x16& p1, int dq, unsigned W) {
    const float NEG = -__builtin_inff();
#pragma unroll
    for (int r = 0; r < 16; ++r) {
        const int c = (r & 3) + 8 * (r >> 2);
        if ((unsigned)(dq - c) >= W) p0[r] = NEG;
        if ((unsigned)(dq - c - 32) >= W) p1[r] = NEG;
    }
}
__device__ __forceinline__ void partialSM(f32x16& p0, f32x16& p1, float& m_reg, float& mn, float& alpha) {
    float pmax = p0[0]; for (int r = 1; r < 16; ++r) pmax = fmaxf(pmax, p0[r]); for (int r = 0; r < 16; ++r) pmax = fmaxf(pmax, p1[r]);
    { auto rr = __builtin_amdgcn_permlane32_swap(__float_as_uint(pmax), __float_as_uint(pmax), false, false);
      pmax = fmaxf(__uint_as_float(rr[0]), __uint_as_float(rr[1])); }
    if (__builtin_expect(__all((pmax - m_reg) <= THR2), 1)) { mn = m_reg; alpha = 1.f; }
    else { mn = fmaxf(m_reg, pmax); alpha = __builtin_amdgcn_exp2f(m_reg - mn); m_reg = mn; }
    for (int r = 0; r < 16; ++r) p0[r] = p0[r] - mn; for (int r = 0; r < 16; ++r) p1[r] = p1[r] - mn;
    for (int r = 0; r < 16; ++r) p0[r] = __builtin_amdgcn_exp2f(p0[r]);
}
__device__ __forceinline__ void finishSM(f32x16& p0, f32x16& p1, float alpha, float& l_reg, bf16x8& pa0, bf16x8& pa1, bf16x8& pa2, bf16x8& pa3) {
    for (int r = 0; r < 16; ++r) p1[r] = __builtin_amdgcn_exp2f(p1[r]);
    float ps = 0; for (int r = 0; r < 16; ++r) ps += p0[r]; for (int r = 0; r < 16; ++r) ps += p1[r];
    { auto rr = __builtin_amdgcn_permlane32_swap(__float_as_uint(ps), __float_as_uint(ps), false, false);
      ps = __uint_as_float(rr[0]) + __uint_as_float(rr[1]); }
    l_reg = l_reg * alpha + ps;
#define PK4(P, B_, OUT) do { unsigned a0 = cvtpk(P[B_+0], P[B_+1]), a1 = cvtpk(P[B_+2], P[B_+3]);                          \
        unsigned b0 = cvtpk(P[B_+4], P[B_+5]), b1 = cvtpk(P[B_+6], P[B_+7]);                                             \
        auto r0 = __builtin_amdgcn_permlane32_swap(a0, b0, false, false); auto r1 = __builtin_amdgcn_permlane32_swap(a1, b1, false, false); \
        u32x4 w = {r0[0], r1[0], r0[1], r1[1]}; OUT = *reinterpret_cast<bf16x8*>(&w); } while (0)
    PK4(p0, 0, pa0); PK4(p0, 8, pa1); PK4(p1, 0, pa2); PK4(p1, 8, pa3);
#undef PK4
}
template <int KB, int MODE>
__device__ __forceinline__ void qkt(f32x16& p0, f32x16& p1, const char* K_lds, const char* lds, int r32, int hi, const bf16x8* qr, bool near, int dq, int bt) {
    if constexpr (MODE == 1) {
        const f32x4* cp = (const f32x4*)(lds + OFF_CK + KB * 256 + hi * 16);
#pragma unroll
        for (int i = 0; i < 4; ++i) { const f32x4 a = cp[2 * i], b = cp[2 * i + 8];
            p0[4 * i] = a[0]; p0[4 * i + 1] = a[1]; p0[4 * i + 2] = a[2]; p0[4 * i + 3] = a[3];
            p1[4 * i] = b[0]; p1[4 * i + 1] = b[1]; p1[4 * i + 2] = b[2]; p1[4 * i + 3] = b[3]; }
    } else {
        if (near) { const float* btp = (const float*)(lds + bt);
#pragma unroll
            for (int r = 0; r < 16; ++r) { const int c = (r & 3) + 8 * (r >> 2); int d0 = dq - c, d1 = dq - c - 32;
                d0 = d0 < 0 ? 0 : (d0 > 127 ? 127 : d0); d1 = d1 < 0 ? 0 : (d1 > 127 ? 127 : d1);
                p0[r] = btp[d0]; p1[r] = btp[d1]; } }
        else { p0 = f32x16{}; p1 = f32x16{}; }
    }
    const char* kb[4];
#pragma unroll
    for (int dd = 0; dd < 4; ++dd) kb[dd] = K_lds + KB * SHM_K + KSWZ(r32, (dd * 16 + hi * 8) * 2);
#pragma unroll
    for (int d0 = 0; d0 < 8; ++d0) { const char* a = kb[d0 & 3] + (d0 >> 2) * 128;
        bf16x8 b0 = *reinterpret_cast<const bf16x8*>(a);
        bf16x8 b1 = *reinterpret_cast<const bf16x8*>(a + 32 * 256);
        p0 = __builtin_amdgcn_mfma_f32_32x32x16_bf16(b0, qr[d0], p0, 0, 0, 0);
        p1 = __builtin_amdgcn_mfma_f32_32x32x16_bf16(b1, qr[d0], p1, 0, 0, 0); }
}
template <int VB>
__device__ __forceinline__ void pv_tile(f32x16* o, int vb0, bf16x8 pa0, bf16x8 pa1, bf16x8 pa2, bf16x8 pa3) {
#define TRRD(dst, off) asm volatile("ds_read_b64_tr_b16 %0, %1 offset:%2" : "=&v"(dst) : "v"(vb0), "i"(off) : "memory")
#define PV_D0(d0) do { s16x4 l0, l1, l2, l3, h0, h1, h2, h3; constexpr int b_ = VB * SHM_V + v_rd_off(d0, 0, 0); \
        TRRD(l0, b_); TRRD(h0, b_ + 2048); TRRD(l1, b_ + 4096); TRRD(h1, b_ + 6144); TRRD(l2, b_ + 8192); TRRD(h2, b_ + 10240); TRRD(l3, b_ + 12288); TRRD(h3, b_ + 14336); \
        asm volatile("s_waitcnt lgkmcnt(0)" ::: "memory"); SBAR();   \
        o[d0] = __builtin_amdgcn_mfma_f32_32x32x16_bf16(pa0, (bf16x8){l0[0], l0[1], l0[2], l0[3], h0[0], h0[1], h0[2], h0[3]}, o[d0], 0, 0, 0);   \
        o[d0] = __builtin_amdgcn_mfma_f32_32x32x16_bf16(pa1, (bf16x8){l1[0], l1[1], l1[2], l1[3], h1[0], h1[1], h1[2], h1[3]}, o[d0], 0, 0, 0);   \
        o[d0] = __builtin_amdgcn_mfma_f32_32x32x16_bf16(pa2, (bf16x8){l2[0], l2[1], l2[2], l2[3], h2[0], h2[1], h2[2], h2[3]}, o[d0], 0, 0, 0);   \
        o[d0] = __builtin_amdgcn_mfma_f32_32x32x16_bf16(pa3, (bf16x8){l3[0], l3[1], l3[2], l3[3], h3[0], h3[1], h3[2], h3[3]}, o[d0], 0, 0, 0); } while (0)
    PV_D0(0); PV_D0(1); PV_D0(2); PV_D0(3);
#undef PV_D0
#undef TRRD
}

struct BlockRef { const bf16* Q; const bf16* K; const bf16* V; bf16* O; const float* C; int P0; int bt; };
struct Seam { bf16x8 qr[8]; bf16x8 st_v0, st_v1, st_k0, st_k1; float st_c; };
#define ROW(p, k0, rr) ((p) + (size_t)((k0) + (rr)) * LDQ + sc)
#define VMW() asm volatile("s_waitcnt vmcnt(0)" ::: "memory")
#define VMWN(n) asm volatile("s_waitcnt vmcnt(%0)" :: "i"(n) : "memory")
#define SLOAD_H(Kp, Vp, Cp, k0) do { S.st_v0 = load8(ROW(Vp, k0, sr)); S.st_v1 = load8(ROW(Vp, k0, 32 + sr));              \
                         S.st_k0 = load8(ROW(Kp, k0, sr)); S.st_k1 = load8(ROW(Kp, k0, 32 + sr));                        \
                         if (MODE == 1 && wid == 0) S.st_c = (Cp)[(k0) + lane]; } while (0)
#define SWRITE_HK(bf, cr) do { *(bf16x8*)(K_lds + (bf) * SHM_K + kws) = S.st_k0; *(bf16x8*)(K_lds + (bf) * SHM_K + kws + 32 * 256) = S.st_k1; \
                         if (MODE == 1 && wid == 0) ((float*)(lds + OFF_CK))[(bf) * 64 + lane] = ((cr) - S.st_c) * LOG2E; } while (0)
#define SWRITE_HV(bf) do { *(bf16x8*)(V_lds + (bf) * SHM_V + vst0) = S.st_v0; *(bf16x8*)(V_lds + (bf) * SHM_V + vst1) = S.st_v1; } while (0)
#define SWRITE_H(bf, cr) do { SWRITE_HV(bf); SWRITE_HK(bf, cr); } while (0)
template <int MODE>
__device__ __forceinline__ void attn_prime(const BlockRef& cur, char* lds, Seam& S) {
    const int tid = threadIdx.x, wid = __builtin_amdgcn_readfirstlane(tid >> 6), lane = tid & 63, r32 = lane & 31, hi = lane >> 5;
    const int sr = tid >> 4, sc = (tid & 15) * 8, kws = KSWZ(sr, sc * 2); char* K_lds = lds + 2 * SHM_V;
    float cref = 0.f; if (MODE == 1) cref = cur.C[cur.P0];
    for (int d0 = 0; d0 < 8; ++d0) S.qr[d0] = load8(cur.Q + (size_t)(wid * QBLK + r32) * LDQ + d0 * 16 + hi * 8);
    SLOAD_H(cur.K, cur.V, cur.C, 0); VMW(); SWRITE_HK(0, cref);
    __syncthreads();
}
template <int MODE, int LDO>
__device__ __forceinline__ void attn_block(const BlockRef& cur, const BlockRef& nxt, char* lds, Seam& S) {
    const int tid = threadIdx.x, wid = __builtin_amdgcn_readfirstlane(tid >> 6), lane = tid & 63, r32 = lane & 31, hi = lane >> 5;
    const int NT = (cur.P0 + QB - 1) / KVBLK + 1;
    const int qlo = cur.P0 + wid * QBLK, qm = qlo + r32 - 4 * hi;
    char* V_lds = lds; char* K_lds = lds + 2 * SHM_V;
    float* ws = (float*)(lds + OFF_WS) + wid * 64; float* li_l = ws, * al_l = ws + 32;
    float m_reg = -1e30f, l_reg = 0; f32x16 o[4] = {};
    const int sr = tid >> 4, sc = (tid & 15) * 8, vst0 = v_st(sr, sc), vst1 = v_st(32 + sr, sc), kws = KSWZ(sr, sc * 2);
    const int vb0 = (int)(uintptr_t)V_lds + v_rd_base(lane);
    const bf16* Kh = cur.K; const bf16* Vh = cur.V; const float* Ch = cur.C;
    float cref = 0.f, crefn = 0.f; if (MODE == 1) { cref = cur.C[cur.P0]; crefn = nxt.C[nxt.P0]; }
    const int bt = cur.bt;
#define RESC(a) do { if (__any((a) < 1.f)) { if (hi == 0) al_l[r32] = (a); asm volatile("s_waitcnt lgkmcnt(0)" ::: "memory");              \
                     for (int d_ = 0; d_ < 4; ++d_) for (int r = 0; r < 16; ++r) o[d_][r] *= al_l[crow(r, hi)]; } } while (0)
#define KBASE(t) ((t) * KVBLK)
#define NEAR(t) (KBASE(t) + 191 > qlo)
#define MASKT(P0_, P1_, t) do { const int kb_ = KBASE(t); if (kb_ + KVBLK - 1 > qlo) mask_tile(P0_, P1_, qm - kb_, WBIG); } while (0)
#define QKT(KB, PX0, PX1, t) qkt<KB, MODE>(PX0, PX1, K_lds, lds, r32, hi, S.qr, NEAR(t), qm - KBASE(t), bt)
    constexpr int NQL = 8;
#define SEAM_K0() do { VMWN(NQL); SWRITE_HK(0, crefn); SBAR(); } while (0)
    f32x16 pA0, pA1, pB0, pB1; float mnA, mnB, alA, alB; bf16x8 pa0, pa1, pa2, pa3;
    SWRITE_HV(0); SBAR();
    if (NT > 1) { SLOAD_H(Kh, Vh, Ch, KBASE(1)); }
    SBAR(); QKT(0, pA0, pA1, 0);
    MASKT(pA0, pA1, 0); partialSM(pA0, pA1, m_reg, mnA, alA);
    if (NT > 1) { VMW(); SWRITE_H(1, cref); }
    __syncthreads();
#define HALF_STEP(PX0, PX1, mnX, alX, PY0, PY1, alY, t, KB, VB, SB) do {                                                      \
        SBAR(); QKT(KB, PX0, PX1, t);                                                                                         \
        finishSM(PY0, PY1, alY, l_reg, pa0, pa1, pa2, pa3); SBAR();                                                           \
        if ((t) + 1 < NT) { SLOAD_H(Kh, Vh, Ch, KBASE((t) + 1)); SBAR(); }                                                    \
        pv_tile<VB>(o, vb0, pa0, pa1, pa2, pa3); MASKT(PX0, PX1, (t)); partialSM(PX0, PX1, m_reg, mnX, alX);                  \
        __syncthreads();                                                                                                      \
        if ((t) + 1 < NT) { VMW(); SWRITE_H(SB, cref); }                                                                      \
        RESC(alX); __syncthreads(); } while (0)
    for (int t = 1; t + 1 < NT; t += 2) {
        HALF_STEP(pB0, pB1, mnB, alB, pA0, pA1, alA, t, 1, 0, 0);
        HALF_STEP(pA0, pA1, mnA, alA, pB0, pB1, alB, t + 1, 0, 1, 1);
    }
    const bool even = (NT & 1) == 0;
    if (even) { SBAR(); QKT(1, pB0, pB1, NT - 1); SBAR(); }
    SLOAD_H(nxt.K, nxt.V, nxt.C, 0); SBAR();
#pragma unroll
    for (int d0 = 0; d0 < 8; ++d0) S.qr[d0] = load8(nxt.Q + (size_t)(wid * QBLK + r32) * LDQ + d0 * 16 + hi * 8);
    SBAR();
    finishSM(pA0, pA1, alA, l_reg, pa0, pa1, pa2, pa3); SBAR();
    pv_tile<0>(o, vb0, pa0, pa1, pa2, pa3);
    if (even) { MASKT(pB0, pB1, NT - 1); partialSM(pB0, pB1, m_reg, mnB, alB); __syncthreads(); RESC(alB);
        finishSM(pB0, pB1, alB, l_reg, pa0, pa1, pa2, pa3); SBAR(); pv_tile<1>(o, vb0, pa0, pa1, pa2, pa3); }
    SBAR(); SEAM_K0();
    if (hi == 0) li_l[r32] = l_reg; asm volatile("s_waitcnt lgkmcnt(0)" ::: "memory");
    float rli[16];
#pragma unroll
    for (int r = 0; r < 16; ++r) rli[r] = __builtin_amdgcn_rcpf(li_l[crow(r, hi)]);
    bf16* Ow = cur.O + (size_t)(wid * QBLK) * LDO;
#pragma unroll
    for (int r = 0; r < 16; ++r) { const int orow = crow(r, hi);
#pragma unroll
        for (int d0 = 0; d0 < 4; ++d0) { const float v = o[d0][r] * rli[r];
            const float vn = __shfl_xor(v, 1);
            if ((r32 & 1) == 0) *(unsigned*)(Ow + (size_t)orow * LDO + d0 * 32 + r32) = cvtpk(v, vn); } }
    __syncthreads();
#undef RESC
#undef KBASE
#undef NEAR
#undef MASKT
#undef QKT
#undef SEAM_K0
#undef HALF_STEP
}
#undef ROW
#undef VMW
#undef VMWN
#undef SLOAD_H
#undef SWRITE_HK
#undef SWRITE_HV
#undef SWRITE_H
#undef KSWZ
#undef SBAR
}
namespace cg = cooperative_groups;
#define LAS __attribute__((address_space(3)))
typedef unsigned short bf16;
typedef unsigned v4u __attribute__((ext_vector_type(4)));
typedef unsigned v2u __attribute__((ext_vector_type(2)));
typedef float f32x4 __attribute__((ext_vector_type(4)));

constexpr int BATCH = 2, SEQ = 16384, DM = 2048, FF = 5632, DEPTH = 2;
constexpr int M = BATCH * SEQ;
constexpr int NQKV = 3 * DM;
constexpr float LN_EPS = 1e-5f;
constexpr float ALPHA = 1.4142135623730951f;
constexpr float QSCALE = 0.08838834764831845f * 1.4426950408889634f;
constexpr int NWAVES = 8, NTHREADS = 512;
constexpr int LDS_BYTES = 147456;

constexpr size_t MiB = 1u << 20;
constexpr size_t WS_WGU1 = 1 * MiB;
constexpr size_t WS_WD1 = WS_WGU1 + 44 * MiB;
constexpr size_t WS_WGU2 = WS_WD1 + 22 * MiB;
constexpr size_t WS_WD2 = WS_WGU2 + 44 * MiB;
constexpr size_t WS_WQKV = WS_WD2 + 22 * MiB;
constexpr size_t WS_WO = WS_WQKV + 24 * MiB;
constexpr size_t WS_XB = WS_WO + 8 * MiB;
constexpr size_t WS_BIG = WS_XB + 128 * MiB;
constexpr size_t WS_OP = WS_BIG + 384 * MiB;
constexpr size_t WS_LF = WS_OP + 256 * MiB;
constexpr size_t WS_C = WS_LF + 2 * MiB;
constexpr size_t WS_END = WS_C + 2 * MiB;

__device__ __forceinline__ unsigned f2bf(float f) { unsigned u = __builtin_bit_cast(unsigned, f); return (u + 0x7fffu + ((u >> 16) & 1u)) >> 16; }
__device__ __forceinline__ unsigned pk2(float lo, float hi) { return f2bf(lo) | (f2bf(hi) << 16); }
__device__ __forceinline__ float bf2f(unsigned short b) { return __builtin_bit_cast(float, (unsigned)b << 16); }
__device__ __forceinline__ float wave_sum(float v) {
#pragma unroll
    for (int o = 1; o < 64; o <<= 1) v += __shfl_xor(v, o);
    return v;
}
#define LDS_WAIT() asm volatile("s_waitcnt lgkmcnt(0)" ::: "memory")

__device__ __forceinline__ void transpose_item(const float* W, int K, int N, bf16* WT, int gu, LAS float* scr, int item, int lane) {
    const int nblk = N / 32, kb = item / nblk, nb = item % nblk, k0 = 64 * kb, n0 = 32 * nb;
    const int r0 = gu == 0 ? n0 : ((n0 >> 7) * 256 + (n0 & 127) + (gu == 2 ? 128 : 0));
#pragma unroll 8
    for (int i = 0; i < 32; ++i) { const int kk = 2 * i + (lane >> 5); scr[kk * 33 + (lane & 31)] = W[(size_t)(k0 + kk) * N + n0 + (lane & 31)]; }
    LDS_WAIT(); asm volatile("" ::: "memory");
    const int c = lane & 7;
#pragma unroll
    for (int j = 0; j < 4; ++j) { const int n = (lane >> 3) + 8 * j; const LAS float* s = scr + (8 * c) * 33 + n;
        v4u o; o.x = pk2(s[0 * 33], s[1 * 33]); o.y = pk2(s[2 * 33], s[3 * 33]); o.z = pk2(s[4 * 33], s[5 * 33]); o.w = pk2(s[6 * 33], s[7 * 33]);
        *(v4u*)(WT + (size_t)(r0 + n) * K + k0 + 8 * c) = o; }
    LDS_WAIT(); asm volatile("" ::: "memory");
}

struct Args { const float* in[21]; float* out; unsigned char* ws; int ph_lo, ph_hi; };

template <bool GATE, bool WRITE_XB>
__device__ __forceinline__ void ln_phase(const float* Y, float* X, bf16* XB, const float* g, const float* b, const float* wf, const float* bfv, float* LF,
                                         LAS unsigned char* lds, int gw, int NGW, int tid, int lane) {
    LAS float* wT = (LAS float*)lds;
    if (GATE) {
        for (int idx = tid; idx < DM * 16; idx += NTHREADS) { const int k = idx >> 4, hh = idx & 15; wT[hh * DM + k] = wf[idx]; }
        __syncthreads();
    }
    for (int m = gw; m < M; m += NGW) {
        const f32x4* yr = (const f32x4*)(Y + (size_t)m * DM) + lane;
        f32x4 v[8]; float s = 0.f;
#pragma unroll
        for (int j = 0; j < 8; ++j) { v[j] = yr[64 * j]; s += (v[j].x + v[j].y) + (v[j].z + v[j].w); }
        const float mean = wave_sum(s) * (1.f / DM); float s2 = 0.f;
#pragma unroll
        for (int j = 0; j < 8; ++j) { v[j] = v[j] - mean; s2 += (v[j].x * v[j].x + v[j].y * v[j].y) + (v[j].z * v[j].z + v[j].w * v[j].w); }
        const float rstd = 1.f / sqrtf(wave_sum(s2) * (1.f / DM) + LN_EPS);
        f32x4* xr = (f32x4*)(X + (size_t)m * DM) + lane;
        v2u* o8 = (v2u*)(XB + (size_t)m * DM) + lane;
#pragma unroll
        for (int j = 0; j < 8; ++j) { const f32x4 gv = ((const f32x4*)g)[64 * j + lane], bv = ((const f32x4*)b)[64 * j + lane];
            v[j] = v[j] * rstd * gv + bv; xr[64 * j] = v[j];
            if (WRITE_XB) { v2u w; w.x = pk2(v[j].x, v[j].y); w.y = pk2(v[j].z, v[j].w); o8[64 * j] = w; } }
        if (GATE) {
            float zmine = 0.f;
#pragma unroll 1
            for (int hh = 0; hh < 16; ++hh) { float a = 0.f;
#pragma unroll
                for (int j = 0; j < 8; ++j) { const f32x4 w = *(const LAS f32x4*)(wT + hh * DM + 256 * j + 4 * lane);
                    a += (v[j].x * w.x + v[j].y * w.y) + (v[j].z * w.z + v[j].w * w.w); }
                a = wave_sum(a); if (lane == hh) zmine = a; }
            if (lane < 16) { const float z = zmine + bfv[lane];
                const float ls = fminf(z, 0.f) - log1pf(expf(-fabsf(z)));
                LF[(size_t)m * 16 + lane] = ls; }
        }
    }
    if (GATE) __syncthreads();
}

__device__ __forceinline__ void cumsum_unit(const float* LF, float* C, int bh, LAS unsigned char* lds, int tid) {
    const int b = bh >> 4, hh = bh & 15; LAS double* sd = (LAS double*)lds;
    const float* src = LF + ((size_t)b * SEQ + 32 * tid) * 16 + hh;
    double t = 0.0;
    for (int i = 0; i < 32; ++i) t += (double)src[(size_t)i * 16];
    sd[tid] = t; __syncthreads();
    if (tid == 0) { double run = 0.0; for (int i = 0; i < NTHREADS; ++i) { const double x = sd[i]; sd[i] = run; run += x; } }
    __syncthreads();
    double pre = sd[tid]; float* dst = C + (size_t)bh * SEQ + 32 * tid;
    for (int i = 0; i < 32; ++i) { pre += (double)src[(size_t)i * 16]; dst[i] = (float)pre; }
    __syncthreads();
}

__device__ __forceinline__ void diff_combine(const bf16* OP, bf16* OB, const float* lq1, const float* lk1, const float* lq2, const float* lk2, const float* subg, float lam_init,
                                             int gw, int NGW, int lane) {
    const float d1 = wave_sum(lq1[lane] * lk1[lane] + lq1[lane + 64] * lk1[lane + 64]);
    const float d2 = wave_sum(lq2[lane] * lk2[lane] + lq2[lane + 64] * lk2[lane + 64]);
    const float lam = expf(d1) - expf(d2) + lam_init;
    const f32x4 sg = ((const f32x4*)subg)[lane]; const float osc = 1.f - lam_init;
    for (int m = gw; m < M; m += NGW) {
#pragma unroll
        for (int h = 0; h < 8; ++h) {
            const v2u a = *((const v2u*)(OP + (size_t)m * 4096 + (h * 2 + 0) * 256) + lane);
            const v2u c = *((const v2u*)(OP + (size_t)m * 4096 + (h * 2 + 1) * 256) + lane);
            f32x4 o;
            o.x = bf2f((unsigned short)(a.x & 0xffff)) - lam * bf2f((unsigned short)(c.x & 0xffff));
            o.y = bf2f((unsigned short)(a.x >> 16)) - lam * bf2f((unsigned short)(c.x >> 16));
            o.z = bf2f((unsigned short)(a.y & 0xffff)) - lam * bf2f((unsigned short)(c.y & 0xffff));
            o.w = bf2f((unsigned short)(a.y >> 16)) - lam * bf2f((unsigned short)(c.y >> 16));
            const float ss = wave_sum((o.x * o.x + o.y * o.y) + (o.z * o.z + o.w * o.w));
            const float r = osc / sqrtf(ss * (1.f / 256.f) + LN_EPS);
            v2u w; w.x = pk2(o.x * r * sg.x, o.y * r * sg.y); w.y = pk2(o.z * r * sg.z, o.w * r * sg.w);
            *((v2u*)(OB + (size_t)m * DM + h * 256) + lane) = w;
        }
    }
}

template <int MODE>
__device__ __forceinline__ att::BlockRef attn_ref(int bh, int qb, const bf16* QKV, bf16* O, const float* C) {
    att::BlockRef r;
    if (MODE == 0) { const int b = bh >> 5, vh = bh & 31, h = vh >> 2, mp = (vh >> 1) & 1, e = vh & 1;
        const bf16* base = QKV + (size_t)b * SEQ * NQKV;
        r.Q = (const att::bf16*)(base + h * 256 + mp * 128 + (size_t)qb * 256 * NQKV);
        r.K = (const att::bf16*)(base + DM + h * 256 + mp * 128);
        r.V = (const att::bf16*)(base + 2 * DM + h * 256 + e * 128);
        r.O = (att::bf16*)(O + ((size_t)b * SEQ + (size_t)qb * 256) * 4096 + (h * 2 + mp) * 256 + e * 128);
        r.C = nullptr; r.bt = att::OFF_BT + h * 512;
    } else { const int b = bh >> 4, hh = bh & 15;
        const bf16* base = QKV + (size_t)b * SEQ * NQKV;
        r.Q = (const att::bf16*)(base + hh * 128 + (size_t)qb * 256 * NQKV);
        r.K = (const att::bf16*)(base + DM + hh * 128);
        r.V = (const att::bf16*)(base + 2 * DM + hh * 128);
        r.O = (att::bf16*)(O + ((size_t)b * SEQ + (size_t)qb * 256) * DM + hh * 128);
        r.C = C + (size_t)bh * SEQ; r.bt = 0;
    }
    r.P0 = qb * 256;
    return r;
}
__device__ __forceinline__ void attn_decode(int L, int& bh, int& x) { const int xcd = L & 7, k = L >> 3, gi = k >> 5, r = k & 31; bh = gi * 8 + xcd; x = r; }
template <int MODE>
__device__ __forceinline__ void attn_phase(const bf16* QKV, bf16* O, const float* C, const float* rel_table, char* lds, int tid) {
    constexpr int NBH = MODE == 0 ? 64 : 32, NQB = SEQ / 256, total = NBH * 32;
    if (MODE == 0) {
        float* btab = (float*)(lds + att::OFF_BT);
        for (int i = tid; i < 8 * 128; i += NTHREADS) { const int h = i >> 7, n = i & 127;
            int bk = n; if (n >= 16) { bk = 16 + (int)(logf((float)n * (1.f / 16.f)) / 2.0794415416798357f * 16.f); bk = bk > 31 ? 31 : bk; }
            btab[i] = (rel_table[bk * 8 + h] - rel_table[31 * 8 + h]) * att::LOG2E; }
        __syncthreads();
    }
    const int stride = gridDim.x; int L = blockIdx.x; if (L >= total) return;
    int bh, x; attn_decode(L, bh, x); int pass = 0;
    att::BlockRef cur = attn_ref<MODE>(bh, x, QKV, O, C);
    att::Seam S;
    att::attn_prime<MODE>(cur, lds, S);
    for (;;) {
        const bool more_pass = pass == 0, more_item = L + stride < total, last = !more_pass && !more_item;
        int bhn = bh, xn = x, passn = pass + 1, Ln = L;
        if (!more_pass) { passn = 0; Ln = more_item ? L + stride : L; attn_decode(Ln, bhn, xn); }
        const att::BlockRef nxt = last ? cur : attn_ref<MODE>(bhn, passn ? NQB - 1 - xn : xn, QKV, O, C);
        att::attn_block<MODE, (MODE == 0 ? 4096 : DM)>(cur, nxt, lds, S);
        if (last) break;
        cur = nxt; bh = bhn; x = xn; pass = passn; L = Ln;
    }
}

#define PHASE_BEGIN if (ph >= lo && ph < hi) {
#define PHASE_END   if (ph + 1 < hi) grid.sync(); } ++ph;
template <int layer>
__device__ __forceinline__ void layer_body(const Args& args, cg::grid_group& grid, unsigned char* lds, int& ph) {
    LAS unsigned char* ldsl = (LAS unsigned char*)lds;
    const int tid = threadIdx.x, lane = tid & 63, wave = __builtin_amdgcn_readfirstlane(tid >> 6);
    const int G = gridDim.x; const int bx = blockIdx.x;
    const int vcu = (G % 8 == 0) ? (bx % 8) * (G / 8) + bx / 8 : bx;
    const int gw = vcu * NWAVES + wave, NGW = G * NWAVES;
    unsigned char* ws = args.ws;
    const float* x_in = args.in[0]; float* X = args.out;
    bf16* Wgu1 = (bf16*)(ws + WS_WGU1); bf16* Wd1 = (bf16*)(ws + WS_WD1); bf16* Wgu2 = (bf16*)(ws + WS_WGU2); bf16* Wd2 = (bf16*)(ws + WS_WD2);
    bf16* Wqkv = (bf16*)(ws + WS_WQKV); bf16* Wo = (bf16*)(ws + WS_WO);
    bf16* XB = (bf16*)(ws + WS_XB); bf16* HB = (bf16*)(ws + WS_BIG); bf16* QKV = (bf16*)(ws + WS_BIG); bf16* OP = (bf16*)(ws + WS_OP);
    float* LF = (float*)(ws + WS_LF); float* CC = (float*)(ws + WS_C);
    const int lo = args.ph_lo, hi = args.ph_hi;
        constexpr bool fox = (layer & 1) != 0;
        const float* w1g = args.in[2] + (size_t)layer * DM * FF; const float* w1u = args.in[3] + (size_t)layer * DM * FF; const float* w1d = args.in[4] + (size_t)layer * DM * FF;
        const float* w2g = args.in[5] + (size_t)layer * DM * FF; const float* w2u = args.in[6] + (size_t)layer * DM * FF; const float* w2d = args.in[7] + (size_t)layer * DM * FF;
        const float* lng = args.in[8] + (size_t)layer * 3 * DM; const float* lnb = args.in[9] + (size_t)layer * 3 * DM;
        const float* wqkv_f = fox ? args.in[17] : args.in[10]; const float* wo_f = fox ? args.in[18] : args.in[11];

        PHASE_BEGIN
            LAS float* scr = (LAS float*)(ldsl + wave * 16384);
            constexpr int I_F = (DM / 64) * (FF / 32), I_D = (FF / 64) * (DM / 32), I_Q = (DM / 64) * (NQKV / 32), I_O = (DM / 64) * (DM / 32);
            constexpr int NITEMS = 4 * I_F + 2 * I_D + I_Q + I_O;
            for (int it = gw; it < NITEMS; it += NGW) {
                int r = it;
                if (r < I_F) { transpose_item(w1g, DM, FF, Wgu1, 1, scr, r, lane); continue; } r -= I_F;
                if (r < I_F) { transpose_item(w1u, DM, FF, Wgu1, 2, scr, r, lane); continue; } r -= I_F;
                if (r < I_D) { transpose_item(w1d, FF, DM, Wd1, 0, scr, r, lane); continue; } r -= I_D;
                if (r < I_F) { transpose_item(w2g, DM, FF, Wgu2, 1, scr, r, lane); continue; } r -= I_F;
                if (r < I_F) { transpose_item(w2u, DM, FF, Wgu2, 2, scr, r, lane); continue; } r -= I_F;
                if (r < I_D) { transpose_item(w2d, FF, DM, Wd2, 0, scr, r, lane); continue; } r -= I_D;
                if (r < I_Q) { transpose_item(wqkv_f, DM, NQKV, Wqkv, 0, scr, r, lane); continue; } r -= I_Q;
                transpose_item(wo_f, DM, DM, Wo, 0, scr, r, lane);
            }
            if (layer == 0) {
                for (int m = gw; m < M; m += NGW) { const f32x4* xr = (const f32x4*)(x_in + (size_t)m * DM) + lane; v2u* o8 = (v2u*)(XB + (size_t)m * DM) + lane;
#pragma unroll
                    for (int j = 0; j < 8; ++j) { const f32x4 v = xr[64 * j]; v2u w; w.x = pk2(v.x, v.y); w.y = pk2(v.z, v.w); o8[64 * j] = w; } }
            }
            __syncthreads();
        PHASE_END

        PHASE_BEGIN
            pg8::Gemm g{XB, Wgu1, M, 2 * FF, DM}; pg8::StaticOrder S; S.init(M, 2 * FF, G, bx);
            pg8::EpiSwiGLU E{HB, FF};
#ifndef NO_GEMM_SW
            pg8::gemm_phase<pg8::EpiSwiGLU, pg8::StaticOrder, true, true>(ldsl, g, S, E);
#endif
        PHASE_END
        PHASE_BEGIN
            pg8::Gemm g{HB, Wd1, M, DM, FF}; pg8::StaticOrder S; S.init(M, DM, G, bx);
            pg8::EpiRes E{layer == 0 ? x_in : X, X, DM, ALPHA, 0.5f};
#ifndef NO_GEMM_RES
            pg8::gemm_phase<pg8::EpiRes, pg8::StaticOrder, true, true>(ldsl, g, S, E);
#endif
        PHASE_END
        PHASE_BEGIN
            if (fox) ln_phase<true, true>(X, X, XB, lng, lnb, args.in[19], args.in[20], LF, ldsl, gw, NGW, tid, lane);
            else ln_phase<false, true>(X, X, XB, lng, lnb, nullptr, nullptr, nullptr, ldsl, gw, NGW, tid, lane);
        PHASE_END
        PHASE_BEGIN
            if (fox && bx < 32) cumsum_unit(LF, CC, bx, ldsl, tid);
            pg8::Gemm g{XB, Wqkv, M, NQKV, DM}; pg8::StaticOrder S; S.init(M, NQKV, G, bx);
            pg8::EpiBf16S E{QKV, NQKV, DM, QSCALE};
#ifndef NO_GEMM_QKV
            pg8::gemm_phase<pg8::EpiBf16S, pg8::StaticOrder, true, true>(ldsl, g, S, E);
#endif
        PHASE_END
        PHASE_BEGIN
#ifndef NO_ATT1
            if (fox) attn_phase<1>(QKV, XB, CC, nullptr, (char*)lds, tid);
#endif
#ifndef NO_ATT0
            if (!fox) attn_phase<0>(QKV, OP, nullptr, args.in[1], (char*)lds, tid);
#endif
            __syncthreads();
        PHASE_END
        if (!fox) {
        PHASE_BEGIN
            const float lam_init = 0.8f - 0.6f * expf(-0.3f * (float)layer);
            diff_combine(OP, XB, args.in[12], args.in[13], args.in[14], args.in[15], args.in[16], lam_init, gw, NGW, lane);
        PHASE_END
        } else { ++ph; }
        PHASE_BEGIN
            pg8::Gemm g{XB, Wo, M, DM, DM}; pg8::StaticOrder S; S.init(M, DM, G, bx);
            pg8::EpiRes E{X, X, DM, ALPHA, 1.0f};
#ifndef NO_GEMM_RES
            pg8::gemm_phase<pg8::EpiRes, pg8::StaticOrder, true, true>(ldsl, g, S, E);
#endif
        PHASE_END
        PHASE_BEGIN
            ln_phase<false, true>(X, X, XB, lng + DM, lnb + DM, nullptr, nullptr, nullptr, ldsl, gw, NGW, tid, lane);
        PHASE_END
        PHASE_BEGIN
            pg8::Gemm g{XB, Wgu2, M, 2 * FF, DM}; pg8::StaticOrder S; S.init(M, 2 * FF, G, bx);
            pg8::EpiSwiGLU E{HB, FF};
#ifndef NO_GEMM_SW
            pg8::gemm_phase<pg8::EpiSwiGLU, pg8::StaticOrder, true, true>(ldsl, g, S, E);
#endif
        PHASE_END
        PHASE_BEGIN
            pg8::Gemm g{HB, Wd2, M, DM, FF}; pg8::StaticOrder S; S.init(M, DM, G, bx);
            pg8::EpiRes E{X, X, DM, ALPHA, 0.5f};
#ifndef NO_GEMM_RES
            pg8::gemm_phase<pg8::EpiRes, pg8::StaticOrder, true, true>(ldsl, g, S, E);
#endif
        PHASE_END
        PHASE_BEGIN
            ln_phase<false, true>(X, X, XB, lng + 2 * DM, lnb + 2 * DM, nullptr, nullptr, nullptr, ldsl, gw, NGW, tid, lane);
        PHASE_END
    }
#undef PHASE_BEGIN
#undef PHASE_END
__global__ void __launch_bounds__(NTHREADS, 2) fwd_megakernel(Args args) {
    extern __shared__ __attribute__((aligned(16))) unsigned char lds[];
    cg::grid_group grid = cg::this_grid();
    int ph = 0;
    layer_body<0>(args, grid, lds, ph);
    layer_body<1>(args, grid, lds, ph);
}

extern "C" void kernel_launch(void* const* d_in, const int* in_sizes, int n_in, void* d_out, int out_size, void* d_ws, size_t ws_size, hipStream_t stream) {
    static int grid = 0;
    if (grid == 0) {
        if (n_in != 21 || in_sizes[0] != M * DM || out_size != M * DM || ws_size < WS_END) {
            fprintf(stderr, "kernel_launch: unexpected shapes (n_in %d, in0 %d, out %d, ws %zu < %zu); nothing launched\n", n_in, n_in > 0 ? in_sizes[0] : -1, out_size, ws_size, (size_t)WS_END); grid = -1; return; }
        int dev = 0, cus = 0, per_cu = 0;
        (void)hipGetDevice(&dev); (void)hipDeviceGetAttribute(&cus, hipDeviceAttributeMultiprocessorCount, dev);
        if (hipFuncSetAttribute((const void*)fwd_megakernel, hipFuncAttributeMaxDynamicSharedMemorySize, LDS_BYTES) != hipSuccess) { fprintf(stderr, "kernel_launch: hipFuncSetAttribute failed\n"); grid = -1; return; }
        if (hipOccupancyMaxActiveBlocksPerMultiprocessor(&per_cu, (const void*)fwd_megakernel, NTHREADS, LDS_BYTES) != hipSuccess || per_cu < 1) { fprintf(stderr, "kernel_launch: occupancy query says %d\n", per_cu); per_cu = 1; }
        (void)hipGetLastError();
        grid = cus * 1;
        if (grid <= 0) grid = 256;
    }
    if (grid < 0) return;
    Args a{};
    for (int i = 0; i < 21; ++i) a.in[i] = (const float*)d_in[i];
    a.out = (float*)d_out; a.ws = (unsigned char*)d_ws; a.ph_lo = 0; a.ph_hi = 1000;
    void* kargs[] = {&a};
    hipError_t e = hipLaunchCooperativeKernel((const void*)fwd_megakernel, dim3(grid), dim3(NTHREADS), kargs, LDS_BYTES, stream);
    if (e != hipSuccess) fprintf(stderr, "kernel_launch: cooperative launch failed: %s (grid %d)\n", hipGetErrorString(e), grid);
}
```

```cpp
#include <hip/hip_runtime.h>
#include <hip/hip_cooperative_groups.h>
#include <hip/hip_bf16.h>
#include <cstdio>
#include <cstdint>
#include <cmath>
namespace pg8 {
#define PG8_LAS __attribute__((address_space(3)))
typedef unsigned short bf16_t;
typedef short bf16x8 __attribute__((ext_vector_type(8)));
typedef float f32x4 __attribute__((ext_vector_type(4)));
typedef unsigned u32x4 __attribute__((ext_vector_type(4)));
constexpr int BM = 256, BK = 64, HALF = 128, HTB = HALF * BK * 2  , STAGE_BYTES = 8 * HTB, NXCD = 8, WGM = 8;

__host__ __device__ __forceinline__ int lds_byte(int r, int c) { const int st = (r >> 4) * 2 + (c >> 5), rr = r & 15, cc = c & 31, ob = rr * 64 + cc * 2; return st * 1024 + (ob ^ (((ob >> 9) & 1) << 5)); }
__host__ __device__ __forceinline__ void stage_rc(int b, int& R, int& C) { const int st = b / 1024, sb = b % 1024, swz = sb ^ (((sb >> 9) & 1) << 5); R = (st >> 1) * 16 + swz / 64; C = (st & 1) * 32 + (swz % 64) / 2; }
__host__ __device__ __forceinline__ int perm32(int rho) { const int n = rho >> 4, i = rho & 15; return 8 * (i >> 2) + 4 * n + (i & 3); }

struct Unit { int pm, pn; };
struct Gemm { const bf16_t* A; const bf16_t* Bt; int M, N, K; };

struct StaticOrder {
    int nM, nN, nwg, G, c;
    __host__ __device__ void init(int M, int N, int G_, int c_) { nM = M / BM; nN = N / BM; nwg = nM * nN; G = G_; c = c_; }
    __host__ __device__ bool next(int i, Unit& u) const {
        const long L = (long)i * G + c; if (L >= nwg) return false;
        int wgid = (int)L; { const int q = nwg / NXCD, r = nwg % NXCD, xcd = wgid % NXCD, off = wgid / NXCD; wgid = (xcd < r ? xcd * (q + 1) : r * (q + 1) + (xcd - r) * q) + off; }
        const int nig = WGM * nN, gid = wgid / nig, fm = gid * WGM, gsz = (nM - fm) < WGM ? (nM - fm) : WGM;
        u.pm = fm + ((wgid % nig) % gsz); u.pn = (wgid % nig) / gsz; return true;
    }
    __device__ __forceinline__ void a_ready(const Unit&) const {}
    __device__ __forceinline__ void done(const Unit&) const {}
};

__device__ __forceinline__ unsigned cvt_pk_bf16(float lo, float hi) { unsigned r; asm volatile("v_cvt_pk_bf16_f32 %0, %1, %2" : "=v"(r) : "v"(lo), "v"(hi)); return r; }
typedef float f32x2 __attribute__((ext_vector_type(2)));
struct EpiBf16S {
    static constexpr bool PERM = true, AFTER_DRAIN = false;
    bf16_t* O; int ldc; int scale_cols; float scale0;
    __device__ __forceinline__ void operator()(const f32x4 (&acc)[2][2][4][2], const Unit& u, int wr, int wc, int fr, int fq) const {
        const int row0 = u.pm * BM + wr * 64 + fr; const int colt = u.pn * BM;
        const float sc = (colt < scale_cols) ? scale0 : 1.f;
        const int col0 = colt + wc * 32 + 8 * fq;
#pragma unroll
        for (int ai = 0; ai < 2; ++ai)
#pragma unroll
            for (int m = 0; m < 4; ++m) { bf16_t* rowp = O + (size_t)(row0 + ai * HALF + m * 16) * ldc + col0;
#pragma unroll
                for (int bj = 0; bj < 2; ++bj) { f32x4 v0 = acc[ai][bj][m][0] * sc, v1 = acc[ai][bj][m][1] * sc;
                    u32x4 w; w.x = cvt_pk_bf16(v0[0], v0[1]); w.y = cvt_pk_bf16(v0[2], v0[3]); w.z = cvt_pk_bf16(v1[0], v1[1]); w.w = cvt_pk_bf16(v1[2], v1[3]);
                    *(u32x4*)(rowp + bj * HALF) = w; } }
    }
};
__device__ __forceinline__ float silu_mul(float g, float u) { return g * __builtin_amdgcn_rcpf(1.f + __builtin_amdgcn_exp2f(-1.4426950408889634f * g)) * u; }
struct EpiSwiGLU {
    static constexpr bool PERM = true, AFTER_DRAIN = false;
    bf16_t* H; int ldh;
    __device__ __forceinline__ void operator()(const f32x4 (&acc)[2][2][4][2], const Unit& u, int wr, int wc, int fr, int fq) const {
        const int row0 = u.pm * BM + wr * 64 + fr; const int col0 = u.pn * HALF + wc * 32 + 8 * fq;
#pragma unroll
        for (int ai = 0; ai < 2; ++ai)
#pragma unroll
            for (int m = 0; m < 4; ++m) { bf16_t* rowp = H + (size_t)(row0 + ai * HALF + m * 16) * ldh + col0;
                const f32x4 g0 = acc[ai][0][m][0], g1 = acc[ai][0][m][1], u0 = acc[ai][1][m][0], u1 = acc[ai][1][m][1];
                u32x4 w;
                w.x = cvt_pk_bf16(silu_mul(g0[0], u0[0]), silu_mul(g0[1], u0[1])); w.y = cvt_pk_bf16(silu_mul(g0[2], u0[2]), silu_mul(g0[3], u0[3]));
                w.z = cvt_pk_bf16(silu_mul(g1[0], u1[0]), silu_mul(g1[1], u1[1])); w.w = cvt_pk_bf16(silu_mul(g1[2], u1[2]), silu_mul(g1[3], u1[3]));
                *(u32x4*)rowp = w; }
    }
};
template <bool LNB> struct EpiRes {
    static constexpr bool PERM = false, AFTER_DRAIN = false;
    const float* base; float* out; int ldc; float alpha, s; const f32x2* st; const float* g; const float* b;
    __device__ __forceinline__ void operator()(const f32x4 (&acc)[2][2][4][2], const Unit& u, int wr, int wc, int fr, int fq) const {
        const int row0 = u.pm * BM + wr * 64 + fr; const int col0 = u.pn * BM + wc * 32 + 4 * fq;
        f32x2 mr[2][4];
        if (LNB) {
#pragma unroll
            for (int ai = 0; ai < 2; ++ai)
#pragma unroll
                for (int m = 0; m < 4; ++m) mr[ai][m] = st[row0 + ai * HALF + m * 16];
        }
#pragma unroll
        for (int bj = 0; bj < 2; ++bj)
#pragma unroll
            for (int n = 0; n < 2; ++n) { const int cc = col0 + bj * HALF + n * 16;
                f32x4 gv = {1.f, 1.f, 1.f, 1.f}, bv = {0.f, 0.f, 0.f, 0.f}; if (LNB) { gv = *(const f32x4*)(g + cc); bv = *(const f32x4*)(b + cc); }
#pragma unroll
                for (int ai = 0; ai < 2; ++ai)
#pragma unroll
                    for (int m = 0; m < 4; ++m) { const size_t off = (size_t)(row0 + ai * HALF + m * 16) * ldc + cc;
                        f32x4 y = *(const f32x4*)(base + off);
                        if (LNB) y = (y - mr[ai][m].x) * mr[ai][m].y * gv + bv;
                        const f32x4 o = y * alpha + acc[ai][bj][m][n] * s; *(f32x4*)(out + off) = o; }
                asm volatile("" ::: "memory"); }
    }
};
template <class Epi, class Sched, bool ALIGN_EPI = false, bool SP2 = false>
__device__ __forceinline__ void gemm_phase(PG8_LAS unsigned char* lds, const Gemm g, const Sched& S, const Epi& E) {
    const int tid = threadIdx.x, wid = __builtin_amdgcn_readfirstlane(tid >> 6), lane = tid & 63, wr = wid >> 2, wc = wid & 3, fr = lane & 15, fq = lane >> 4;
    const int K = g.K, nt = K / BK;
    unsigned voffA[2], voffB[2];
#pragma unroll
    for (int i = 0; i < 2; ++i) { int R, C; stage_rc(tid * 16 + i * 8192, R, C); const int Rb = Epi::PERM ? ((R & ~31) + perm32(R & 31)) : R;
        voffA[i] = (unsigned)(R * K + C) * 2u; voffB[i] = (unsigned)(Rb * K + C) * 2u; }
    const size_t kstep = (size_t)(BK * 2);
    const size_t hstep = (size_t)HALF * K * 2;
    const size_t tstep = 2 * hstep;
    const unsigned ldsw = (unsigned)wid * 1024u;
    const int aoff = lds_byte(wr * 64 + fr, fq * 8), boff = lds_byte(wc * 32 + fr, fq * 8);
#define PG8_SA(b, h) (((b) * 2 + (h)) * HTB)
#define PG8_SB(b, h) ((4 + (b) * 2 + (h)) * HTB)
#define PG8_STAGE(bufoff, gbase, voff) do { _Pragma("unroll") for (int _i = 0; _i < 2; ++_i) \
        __builtin_amdgcn_global_load_lds((const unsigned*)((const char*)(gbase) + (voff)[_i]), (PG8_LAS unsigned*)(lds + (bufoff) + ldsw + _i * 8192), 16, 0, 0); } while (0)
#define PG8_LDA(dst, b, h) do { _Pragma("unroll") for (int m = 0; m < 4; ++m) _Pragma("unroll") for (int k = 0; k < 2; ++k) dst[m][k] = *(const PG8_LAS bf16x8*)(lds + PG8_SA(b, h) + aoff + m * 2048 + k * 1024); } while (0)
#define PG8_LDB(dst, b, h) do { _Pragma("unroll") for (int n = 0; n < 2; ++n) _Pragma("unroll") for (int k = 0; k < 2; ++k) dst[n][k] = *(const PG8_LAS bf16x8*)(lds + PG8_SB(b, h) + boff + n * 2048 + k * 1024); } while (0)
#define PG8_MMA(ai, bj, At, Bt) do { __builtin_amdgcn_s_setprio(1); _Pragma("unroll") for (int m = 0; m < 4; ++m) _Pragma("unroll") for (int n = 0; n < 2; ++n) _Pragma("unroll") for (int k = 0; k < 2; ++k) \
        acc[ai][bj][m][n] = __builtin_amdgcn_mfma_f32_16x16x32_bf16(Bt[n][k], At[m][k], acc[ai][bj][m][n], 0, 0, 0); __builtin_amdgcn_s_setprio(0); } while (0)
#define PG8_WAIT_V(n) asm volatile("s_waitcnt vmcnt(" #n ")" ::: "memory")
#define PG8_WAIT_L(n) asm volatile("s_waitcnt lgkmcnt(" #n ")" ::: "memory")
#define PG8_BAR __builtin_amdgcn_s_barrier()
#define PG8_SCHED __builtin_amdgcn_sched_barrier(0)
    Unit cur, nxt; int ui = 0;
    if (!S.next(0, cur)) return;
    f32x4 acc[2][2][4][2];
#pragma unroll
    for (int a = 0; a < 2; ++a)
#pragma unroll
        for (int b = 0; b < 2; ++b)
#pragma unroll
            for (int m = 0; m < 4; ++m)
#pragma unroll
                for (int n = 0; n < 2; ++n) acc[a][b][m][n] = (f32x4){0.f, 0.f, 0.f, 0.f};
    bf16x8 At[4][2], B0[2][2], B1[2][2];
    const char* cA = (const char*)g.A + (size_t)cur.pm * tstep; const char* cB = (const char*)g.Bt + (size_t)cur.pn * tstep;
    S.a_ready(cur);
    if constexpr (SP2) {
        PG8_STAGE(PG8_SB(0, 0), cB, voffB); PG8_STAGE(PG8_SB(0, 1), cB + hstep, voffB); PG8_STAGE(PG8_SA(0, 0), cA, voffA); PG8_STAGE(PG8_SA(0, 1), cA + hstep, voffA);
        if (wr == 1) PG8_BAR;
        PG8_WAIT_V(2); PG8_BAR;
        PG8_STAGE(PG8_SB(1, 0), cB + kstep, voffB); PG8_STAGE(PG8_SA(1, 0), cA + kstep, voffA); PG8_STAGE(PG8_SB(1, 1), cB + hstep + kstep, voffB);
        PG8_WAIT_V(6); PG8_BAR;
    } else {
        PG8_STAGE(PG8_SB(0, 0), cB, voffB); PG8_STAGE(PG8_SA(0, 0), cA, voffA); PG8_STAGE(PG8_SB(0, 1), cB + hstep, voffB); PG8_STAGE(PG8_SA(0, 1), cA + hstep, voffA);
        if (wr == 1) PG8_BAR;
        PG8_WAIT_V(4); PG8_BAR;
        PG8_STAGE(PG8_SB(1, 0), cB + kstep, voffB); PG8_STAGE(PG8_SA(1, 0), cA + kstep, voffA); PG8_STAGE(PG8_SB(1, 1), cB + hstep + kstep, voffB);
        PG8_WAIT_V(6); PG8_BAR;
    }
    for (;;) {
        const bool has_next = S.next(ui + 1, nxt);
        const char* nA = has_next ? (const char*)g.A + (size_t)nxt.pm * tstep : cA; const char* nB = has_next ? (const char*)g.Bt + (size_t)nxt.pn * tstep : cB;
        for (int t = 0; t < nt; t += 2) {
            const bool last = (t == nt - 2);
            const char* a1 = cA + (size_t)(t + 1) * kstep;
            const char* a2 = last ? nA : cA + (size_t)(t + 2) * kstep; const char* b2 = last ? nB : cB + (size_t)(t + 2) * kstep;
            const char* a3 = a2 + kstep; const char* b3 = b2 + kstep;
            if (last && has_next) S.a_ready(nxt);
            if constexpr (SP2) {
            PG8_LDB(B0, 0, 0); PG8_LDB(B1, 0, 1); PG8_SCHED; PG8_LDA(At, 0, 0); PG8_STAGE(PG8_SA(1, 1), a1 + hstep, voffA);
            PG8_WAIT_V(8); PG8_WAIT_L(0); PG8_BAR; PG8_MMA(0, 0, At, B0); PG8_MMA(0, 1, At, B1); PG8_BAR; PG8_SCHED;
            PG8_LDA(At, 0, 1); PG8_STAGE(PG8_SB(0, 0), b2, voffB); PG8_STAGE(PG8_SB(0, 1), b2 + hstep, voffB); PG8_STAGE(PG8_SA(0, 0), a2, voffA);
            PG8_WAIT_V(8); PG8_WAIT_L(0); PG8_BAR; PG8_MMA(1, 0, At, B0); PG8_MMA(1, 1, At, B1); PG8_BAR; PG8_SCHED;
            PG8_LDB(B0, 1, 0); PG8_LDB(B1, 1, 1); PG8_SCHED; PG8_LDA(At, 1, 0); PG8_STAGE(PG8_SA(0, 1), a2 + hstep, voffA);
            PG8_WAIT_V(8); PG8_WAIT_L(0); PG8_BAR; PG8_MMA(0, 0, At, B0); PG8_MMA(0, 1, At, B1); PG8_BAR; PG8_SCHED;
            PG8_LDA(At, 1, 1); PG8_STAGE(PG8_SB(1, 0), b3, voffB); PG8_STAGE(PG8_SB(1, 1), b3 + hstep, voffB); PG8_STAGE(PG8_SA(1, 0), a3, voffA);
            PG8_WAIT_V(8); PG8_WAIT_L(0); PG8_BAR; PG8_MMA(1, 0, At, B0); PG8_MMA(1, 1, At, B1); PG8_BAR; PG8_SCHED;
            } else {
            PG8_LDB(B0, 0, 0); PG8_SCHED; PG8_LDA(At, 0, 0); PG8_STAGE(PG8_SA(1, 1), a1 + hstep, voffA);
            PG8_WAIT_L(8); PG8_BAR; PG8_WAIT_L(0); PG8_MMA(0, 0, At, B0); PG8_BAR; PG8_SCHED;
            PG8_LDB(B1, 0, 1); PG8_STAGE(PG8_SB(0, 0), b2, voffB);
            PG8_BAR; PG8_WAIT_L(0); PG8_MMA(0, 1, At, B1); PG8_BAR;
            PG8_LDA(At, 0, 1); PG8_STAGE(PG8_SA(0, 0), a2, voffA);
            PG8_BAR; PG8_WAIT_L(0); PG8_MMA(1, 0, At, B0); PG8_BAR; PG8_SCHED;
            PG8_STAGE(PG8_SB(0, 1), b2 + hstep, voffB);
            PG8_WAIT_V(6); PG8_BAR; PG8_MMA(1, 1, At, B1); PG8_BAR;
            PG8_LDB(B0, 1, 0); PG8_SCHED; PG8_LDA(At, 1, 0); PG8_STAGE(PG8_SA(0, 1), a2 + hstep, voffA);
            PG8_WAIT_L(8); PG8_BAR; PG8_WAIT_L(0); PG8_MMA(0, 0, At, B0); PG8_BAR; PG8_SCHED;
            PG8_LDB(B1, 1, 1); PG8_STAGE(PG8_SB(1, 0), b3, voffB);
            PG8_BAR; PG8_WAIT_L(0); PG8_MMA(0, 1, At, B1); PG8_BAR;
            PG8_LDA(At, 1, 1); PG8_STAGE(PG8_SA(1, 0), a3, voffA);
            PG8_BAR; PG8_WAIT_L(0); PG8_MMA(1, 0, At, B0); PG8_BAR; PG8_SCHED;
            PG8_STAGE(PG8_SB(1, 1), b3 + hstep, voffB);
            PG8_WAIT_V(6); PG8_BAR; PG8_MMA(1, 1, At, B1); PG8_BAR;
            }
        }
        if constexpr (ALIGN_EPI) { if (wr == 0) PG8_BAR; }
        if constexpr (!Epi::AFTER_DRAIN) { E(acc, cur, wr, wc, fr, fq); S.done(cur); }
        if (!has_next) break;
#pragma unroll
        for (int a = 0; a < 2; ++a)
#pragma unroll
            for (int b = 0; b < 2; ++b)
#pragma unroll
                for (int m = 0; m < 4; ++m)
#pragma unroll
                    for (int n = 0; n < 2; ++n) acc[a][b][m][n] = (f32x4){0.f, 0.f, 0.f, 0.f};
        cur = nxt; cA = nA; cB = nB; ++ui;
        if constexpr (ALIGN_EPI) { if (wr == 1) PG8_BAR; }
    }
    PG8_WAIT_V(0);
    if constexpr (!ALIGN_EPI) { if (wr == 0) PG8_BAR; }
    PG8_BAR;
    if constexpr (Epi::AFTER_DRAIN) { E.fused(acc, cur, wr, wc, fr, fq, lds, wid, lane); S.done(cur); }
#undef PG8_SA
#undef PG8_SB
#undef PG8_STAGE
#undef PG8_LDA
#undef PG8_LDB
#undef PG8_MMA
#undef PG8_WAIT_V
#undef PG8_WAIT_L
#undef PG8_BAR
#undef PG8_SCHED
}
}
namespace att {
using bf16 = __hip_bfloat16;
typedef short bf16x8 __attribute__((ext_vector_type(8)));
typedef short s16x4 __attribute__((ext_vector_type(4)));
typedef float f32x16 __attribute__((ext_vector_type(16)));
typedef float f32x4 __attribute__((ext_vector_type(4)));
typedef unsigned u32x4 __attribute__((ext_vector_type(4)));
constexpr int D = 128, NW = 8, QBLK = 32, KVBLK = 64, QB = NW * QBLK;
constexpr int SHM_V = KVBLK * D * 2, SHM_K = KVBLK * D * 2;
constexpr int OFF_WS = 2 * SHM_V + 2 * SHM_K;
constexpr int OFF_CK = OFF_WS + NW * 64 * 4;
constexpr int OFF_BT = OFF_CK + 512;
constexpr int LDS_BYTES = OFF_BT + 8 * 128 * 4;
constexpr int LDQ = 6144;
constexpr float THR2 = 11.5f;
constexpr float LOG2E = 1.4426950408889634f;
constexpr unsigned WBIG = 1u << 30;

#define KSWZ(row, colB) ((row) * 256 + ((colB) ^ (((row) & 7) << 4)))
#define SBAR() __builtin_amdgcn_sched_barrier(0)
__device__ __forceinline__ int v_st(int k, int c) { const int kk = (k & ~0xC) | ((k & 4) << 1) | ((k & 8) >> 1); return ((kk >> 3) * 4 + (c >> 5)) * 512 + ((kk & 7) * 32 + (c & 31)) * 2; }
__device__ __forceinline__ int v_rd_base(int lane) { return ((lane & 3) << 3) | (((lane >> 2) & 3) << 6) | (((lane >> 4) & 1) << 5) | (((lane >> 5) & 1) << 8); }
constexpr int v_rd_off(int d0, int ks, int half) { return d0 * 512 + ks * 4096 + half * 2048; }
__device__ __forceinline__ int crow(int r, int hi) { return (r & 3) + 8 * (r >> 2) + 4 * hi; }
__device__ __forceinline__ unsigned cvtpk(float lo, float hi) { unsigned r; asm volatile("v_cvt_pk_bf16_f32 %0, %1, %2" : "=v"(r) : "v"(lo), "v"(hi)); return r; }
__device__ __forceinline__ bf16x8 load8(const bf16* p) { return *reinterpret_cast<const bf16x8*>(p); }
__device__ __forceinline__ void mask_tile(f32x16& p0, f32x16& p1, int dq, unsigned W) {
    const float NEG = -__builtin_inff();
#pragma unroll
    for (int r = 0; r < 16; ++r) {
        const int c = (r & 3) + 8 * (r >> 2);
        if ((unsigned)(dq - c) >= W) p0[r] = NEG;
        if ((unsigned)(dq - c - 32) >= W) p1[r] = NEG;
    }
}
__device__ __forceinline__ void partialSM(f32x16& p0, f32x16& p1, float& m_reg, float& mn, float& alpha) {
    float mx0 = fmaxf(p0[0], p1[0]), mx1 = fmaxf(p0[1], p1[1]), mx2 = fmaxf(p0[2], p1[2]), mx3 = fmaxf(p0[3], p1[3]);
    for (int r = 4; r < 16; r += 4) { mx0 = fmaxf(mx0, fmaxf(p0[r], p1[r])); mx1 = fmaxf(mx1, fmaxf(p0[r + 1], p1[r + 1])); mx2 = fmaxf(mx2, fmaxf(p0[r + 2], p1[r + 2])); mx3 = fmaxf(mx3, fmaxf(p0[r + 3], p1[r + 3])); }
    float pmax = fmaxf(fmaxf(mx0, mx1), fmaxf(mx2, mx3));
    { auto rr = __builtin_amdgcn_permlane32_swap(__float_as_uint(pmax), __float_as_uint(pmax), false, false);
      pmax = fmaxf(__uint_as_float(rr[0]), __uint_as_float(rr[1])); }
    if (__builtin_expect(__all((pmax - m_reg) <= THR2), 1)) { mn = m_reg; alpha = 1.f; }
    else { mn = fmaxf(m_reg, pmax); alpha = __builtin_amdgcn_exp2f(m_reg - mn); m_reg = mn; }
    for (int r = 0; r < 16; ++r) p0[r] = p0[r] - mn; for (int r = 0; r < 16; ++r) p1[r] = p1[r] - mn;
    for (int r = 0; r < 16; ++r) p0[r] = __builtin_amdgcn_exp2f(p0[r]);
}
__device__ __forceinline__ void finishSM(f32x16& p0, f32x16& p1, float alpha, float& l_reg, bf16x8& pa0, bf16x8& pa1, bf16x8& pa2, bf16x8& pa3) {
    for (int r = 0; r < 16; ++r) p1[r] = __builtin_amdgcn_exp2f(p1[r]);
    float ps0 = p0[0] + p1[0], ps1 = p0[1] + p1[1], ps2 = p0[2] + p1[2], ps3 = p0[3] + p1[3];
    for (int r = 4; r < 16; r += 4) { ps0 += p0[r] + p1[r]; ps1 += p0[r + 1] + p1[r + 1]; ps2 += p0[r + 2] + p1[r + 2]; ps3 += p0[r + 3] + p1[r + 3]; }
    float ps = (ps0 + ps1) + (ps2 + ps3);
    { auto rr = __builtin_amdgcn_permlane32_swap(__float_as_uint(ps), __float_as_uint(ps), false, false);
      ps = __uint_as_float(rr[0]) + __uint_as_float(rr[1]); }
    l_reg = l_reg * alpha + ps;
#define PK4(P, B_, OUT) do { unsigned a0 = cvtpk(P[B_+0], P[B_+1]), a1 = cvtpk(P[B_+2], P[B_+3]);                          \
        unsigned b0 = cvtpk(P[B_+4], P[B_+5]), b1 = cvtpk(P[B_+6], P[B_+7]);                                             \
        auto r0 = __builtin_amdgcn_permlane32_swap(a0, b0, false, false); auto r1 = __builtin_amdgcn_permlane32_swap(a1, b1, false, false); \
        u32x4 w = {r0[0], r1[0], r0[1], r1[1]}; OUT = *reinterpret_cast<bf16x8*>(&w); } while (0)
    PK4(p0, 0, pa0); PK4(p0, 8, pa1); PK4(p1, 0, pa2); PK4(p1, 8, pa3);
#undef PK4
}
template <int KB, int MODE>
__device__ __forceinline__ void qkt(f32x16& p0, f32x16& p1, const char* K_lds, const char* lds, int r32, int hi, const bf16x8* qr, bool near, int dq, int bt) {
    if constexpr (MODE == 1) {
        const f32x4* cp = (const f32x4*)(lds + OFF_CK + KB * 256 + hi * 16);
#pragma unroll
        for (int i = 0; i < 4; ++i) { const f32x4 a = cp[2 * i], b = cp[2 * i + 8];
            p0[4 * i] = a[0]; p0[4 * i + 1] = a[1]; p0[4 * i + 2] = a[2]; p0[4 * i + 3] = a[3];
            p1[4 * i] = b[0]; p1[4 * i + 1] = b[1]; p1[4 * i + 2] = b[2]; p1[4 * i + 3] = b[3]; }
    } else {
        if (near) { const float* btp = (const float*)(lds + bt);
#pragma unroll
            for (int r = 0; r < 16; ++r) { const int c = (r & 3) + 8 * (r >> 2); int d0 = dq - c, d1 = dq - c - 32;
                d0 = d0 < 0 ? 0 : (d0 > 127 ? 127 : d0); d1 = d1 < 0 ? 0 : (d1 > 127 ? 127 : d1);
                p0[r] = btp[d0]; p1[r] = btp[d1]; } }
        else { p0 = f32x16{}; p1 = f32x16{}; }
    }
    const char* kb[4];
#pragma unroll
    for (int dd = 0; dd < 4; ++dd) kb[dd] = K_lds + KB * SHM_K + KSWZ(r32, (dd * 16 + hi * 8) * 2);
#pragma unroll
    for (int d0 = 0; d0 < 8; ++d0) { const char* a = kb[d0 & 3] + (d0 >> 2) * 128;
        bf16x8 b0 = *reinterpret_cast<const bf16x8*>(a);
        bf16x8 b1 = *reinterpret_cast<const bf16x8*>(a + 32 * 256);
        p0 = __builtin_amdgcn_mfma_f32_32x32x16_bf16(b0, qr[d0], p0, 0, 0, 0);
        p1 = __builtin_amdgcn_mfma_f32_32x32x16_bf16(b1, qr[d0], p1, 0, 0, 0); }
}
template <int VB>
__device__ __forceinline__ void pv_tile(f32x16* o, int vb0, bf16x8 pa0, bf16x8 pa1, bf16x8 pa2, bf16x8 pa3) {
#define TRRD(dst, off) asm volatile("ds_read_b64_tr_b16 %0, %1 offset:%2" : "=&v"(dst) : "v"(vb0), "i"(off) : "memory")
#define PV_D0(d0) do { s16x4 l0, l1, l2, l3, h0, h1, h2, h3; constexpr int b_ = VB * SHM_V + v_rd_off(d0, 0, 0); \
        TRRD(l0, b_); TRRD(h0, b_ + 2048); TRRD(l1, b_ + 4096); TRRD(h1, b_ + 6144); TRRD(l2, b_ + 8192); TRRD(h2, b_ + 10240); TRRD(l3, b_ + 12288); TRRD(h3, b_ + 14336); \
        asm volatile("s_waitcnt lgkmcnt(0)" ::: "memory"); SBAR();   \
        o[d0] = __builtin_amdgcn_mfma_f32_32x32x16_bf16(pa0, (bf16x8){l0[0], l0[1], l0[2], l0[3], h0[0], h0[1], h0[2], h0[3]}, o[d0], 0, 0, 0);   \
        o[d0] = __builtin_amdgcn_mfma_f32_32x32x16_bf16(pa1, (bf16x8){l1[0], l1[1], l1[2], l1[3], h1[0], h1[1], h1[2], h1[3]}, o[d0], 0, 0, 0);   \
        o[d0] = __builtin_amdgcn_mfma_f32_32x32x16_bf16(pa2, (bf16x8){l2[0], l2[1], l2[2], l2[3], h2[0], h2[1], h2[2], h2[3]}, o[d0], 0, 0, 0);   \
        o[d0] = __builtin_amdgcn_mfma_f32_32x32x16_bf16(pa3, (bf16x8){l3[0], l3[1], l3[2], l3[3], h3[0], h3[1], h3[2], h3[3]}, o[d0], 0, 0, 0); } while (0)
    PV_D0(0); PV_D0(1); PV_D0(2); PV_D0(3);
#undef PV_D0
#undef TRRD
}

struct BlockRef { const bf16* Q; const bf16* K; const bf16* V; bf16* O; const float* C; int P0; int bt; int jlo; };
struct Seam { bf16x8 qr[8]; bf16x8 st_v0, st_v1, st_k0, st_k1; float st_c; };
#define ROW(p, k0, rr) ((p) + (unsigned)(((k0) + (rr)) * LDQ + sc))
#define VMW() asm volatile("s_waitcnt vmcnt(0)" ::: "memory")
#define VMWN(n) asm volatile("s_waitcnt vmcnt(%0)" :: "i"(n) : "memory")
#define SLOAD_H(Kp, Vp, Cp, k0) do { S.st_v0 = load8(ROW(Vp, k0, sr)); S.st_v1 = load8(ROW(Vp, k0, 32 + sr));              \
                         S.st_k0 = load8(ROW(Kp, k0, sr)); S.st_k1 = load8(ROW(Kp, k0, 32 + sr));                        \
                         if (MODE == 1 && wid == 0) S.st_c = (Cp)[(k0) + lane]; } while (0)
#define SWRITE_HK(bf, cr) do { *(bf16x8*)(K_lds + (bf) * SHM_K + kws) = S.st_k0; *(bf16x8*)(K_lds + (bf) * SHM_K + kws + 32 * 256) = S.st_k1; \
                         if (MODE == 1 && wid == 0) ((float*)(lds + OFF_CK))[(bf) * 64 + lane] = ((cr) - S.st_c) * LOG2E; } while (0)
#define SWRITE_HV(bf) do { *(bf16x8*)(V_lds + (bf) * SHM_V + vst0) = S.st_v0; *(bf16x8*)(V_lds + (bf) * SHM_V + vst0 + 8192) = S.st_v1; } while (0)
#define SWRITE_H(bf, cr) do { SWRITE_HV(bf); SWRITE_HK(bf, cr); } while (0)
template <int MODE>
__device__ __forceinline__ void attn_prime(const BlockRef& cur, char* lds, Seam& S) {
    const int tid = threadIdx.x, wid = __builtin_amdgcn_readfirstlane(tid >> 6), lane = tid & 63, r32 = lane & 31, hi = lane >> 5;
    const int sr = tid >> 4, sc = (tid & 15) * 8, kws = KSWZ(sr, sc * 2); char* K_lds = lds + 2 * SHM_V;
    float cref = 0.f; if (MODE == 1) cref = cur.C[cur.P0];
    for (int d0 = 0; d0 < 8; ++d0) S.qr[d0] = load8(cur.Q + (size_t)(wid * QBLK + r32) * LDQ + d0 * 16 + hi * 8);
    SLOAD_H(cur.K, cur.V, cur.C, cur.jlo * KVBLK); VMW(); SWRITE_HK(0, cref);
    __syncthreads();
}
template <int MODE, int LDO>
__device__ __forceinline__ void attn_block(const BlockRef& cur, const BlockRef& nxt, char* lds, Seam& S) {
    const int tid = threadIdx.x, wid = __builtin_amdgcn_readfirstlane(tid >> 6), lane = tid & 63, r32 = lane & 31, hi = lane >> 5;
    const int j_lo = cur.jlo, NT = (cur.P0 + QB - 1) / KVBLK + 1 - j_lo;
    const int kbn = nxt.jlo * KVBLK;
    const int qlo = cur.P0 + wid * QBLK, qm = qlo + r32 - 4 * hi;
    char* V_lds = lds; char* K_lds = lds + 2 * SHM_V;
    float* ws = (float*)(lds + OFF_WS) + wid * 64; float* li_l = ws, * al_l = ws + 32;
    float m_reg = -1e30f, l_reg = 0; f32x16 o[4] = {};
    const int sr = tid >> 4, sc = (tid & 15) * 8, vst0 = v_st(sr, sc), kws = KSWZ(sr, sc * 2);
    const int vb0 = (int)(uintptr_t)V_lds + v_rd_base(lane);
    const bf16* Kh = cur.K; const bf16* Vh = cur.V; const float* Ch = cur.C;
    float cref = 0.f, crefn = 0.f; if (MODE == 1) { cref = cur.C[cur.P0]; crefn = nxt.C[nxt.P0]; }
    const int bt = cur.bt;
#define RESC(a) do { if (__any((a) < 1.f)) { if (hi == 0) al_l[r32] = (a); asm volatile("s_waitcnt lgkmcnt(0)" ::: "memory");              \
                     for (int d_ = 0; d_ < 4; ++d_) for (int r = 0; r < 16; ++r) o[d_][r] *= al_l[crow(r, hi)]; } } while (0)
#define KBASE(t) ((j_lo + (t)) * KVBLK)
#define NEAR(t) (KBASE(t) + 191 > qlo)
#define MASKT(P0_, P1_, t) do { const int kb_ = KBASE(t); if (kb_ + KVBLK - 1 > qlo) mask_tile(P0_, P1_, qm - kb_, WBIG); } while (0)
#define QKT(KB, PX0, PX1, t) qkt<KB, MODE>(PX0, PX1, K_lds, lds, r32, hi, S.qr, NEAR(t), qm - KBASE(t), bt)
    constexpr int NQL = 8;
#define SEAM_K0() do { VMWN(NQL); SWRITE_HK(0, crefn); SBAR(); } while (0)
    f32x16 pA0, pA1, pB0, pB1; float mnA, mnB, alA, alB; bf16x8 pa0, pa1, pa2, pa3;
    SWRITE_HV(0); SBAR();
    if (NT > 1) { SLOAD_H(Kh, Vh, Ch, KBASE(1)); }
    SBAR(); QKT(0, pA0, pA1, 0);
    MASKT(pA0, pA1, 0); partialSM(pA0, pA1, m_reg, mnA, alA);
    if (NT > 1) { VMW(); SWRITE_H(1, cref); }
    __syncthreads();
#define HALF_STEP(PX0, PX1, mnX, alX, PY0, PY1, alY, t, KB, VB, SB) do {                                                      \
        SBAR(); QKT(KB, PX0, PX1, t);                                                                                         \
        finishSM(PY0, PY1, alY, l_reg, pa0, pa1, pa2, pa3); SBAR();                                                           \
        if ((t) + 1 < NT) { SLOAD_H(Kh, Vh, Ch, KBASE((t) + 1)); SBAR(); }                                                    \
        pv_tile<VB>(o, vb0, pa0, pa1, pa2, pa3); MASKT(PX0, PX1, (t)); partialSM(PX0, PX1, m_reg, mnX, alX);                  \
        __syncthreads();                                                                                                      \
        if ((t) + 1 < NT) { VMW(); SWRITE_H(SB, cref); }                                                                      \
        RESC(alX); __syncthreads(); } while (0)
    for (int t = 1; t + 1 < NT; t += 2) {
        HALF_STEP(pB0, pB1, mnB, alB, pA0, pA1, alA, t, 1, 0, 0);
        HALF_STEP(pA0, pA1, mnA, alA, pB0, pB1, alB, t + 1, 0, 1, 1);
    }
    const bool even = (NT & 1) == 0;
    if (even) { SBAR(); QKT(1, pB0, pB1, NT - 1); SBAR(); }
    SLOAD_H(nxt.K, nxt.V, nxt.C, kbn); SBAR();
#pragma unroll
    for (int d0 = 0; d0 < 8; ++d0) S.qr[d0] = load8(nxt.Q + (size_t)(wid * QBLK + r32) * LDQ + d0 * 16 + hi * 8);
    SBAR();
    finishSM(pA0, pA1, alA, l_reg, pa0, pa1, pa2, pa3); SBAR();
    pv_tile<0>(o, vb0, pa0, pa1, pa2, pa3);
    if (even) { MASKT(pB0, pB1, NT - 1); partialSM(pB0, pB1, m_reg, mnB, alB); __syncthreads(); RESC(alB);
        finishSM(pB0, pB1, alB, l_reg, pa0, pa1, pa2, pa3); SBAR(); pv_tile<1>(o, vb0, pa0, pa1, pa2, pa3); }
    SBAR(); SEAM_K0();
    if (hi == 0) li_l[r32] = l_reg; asm volatile("s_waitcnt lgkmcnt(0)" ::: "memory");
    float rli[16];
#pragma unroll
    for (int r = 0; r < 16; ++r) rli[r] = __builtin_amdgcn_rcpf(li_l[crow(r, hi)]);
    int lane2 = lane; asm volatile("" : "+v"(lane2));
    const int r32b = lane2 & 31, hib = lane2 >> 5;
    bf16* Ow = cur.O + (size_t)(wid * QBLK) * LDO + (unsigned)(hib * 4 * LDO + r32b);
#pragma unroll
    for (int r = 0; r < 16; ++r) { const int orow = (r & 3) + 8 * (r >> 2);
#pragma unroll
        for (int d0 = 0; d0 < 4; ++d0) { const float v = o[d0][r] * rli[r];
            const float vn = __shfl_xor(v, 1);
            if ((r32b & 1) == 0) *(unsigned*)(Ow + orow * LDO + d0 * 32) = cvtpk(v, vn); } }
    __syncthreads();
#undef RESC
#undef KBASE
#undef NEAR
#undef MASKT
#undef QKT
#undef SEAM_K0
#undef HALF_STEP
}
constexpr int D_V = 0, D_K = 65536, D_PS = 98304, D_PSW = 4608, D_SLOT = 4 * D_PSW, D_BT = D_PS + 2 * D_SLOT, D_LDS_BYTES = D_BT + 4096;
template <int KB>
__device__ __forceinline__ void qkt_ref(f32x16& p0, f32x16& p1, const char* K_lds, const char* lds, int r32, int hi, const bf16x8* qr, bool near, int dq, int bt, const f32x16& negm, float mhat) {
    const char* kb[4];
#pragma unroll
    for (int dd = 0; dd < 4; ++dd) kb[dd] = K_lds + KB * SHM_K + KSWZ(r32, (dd * 16 + hi * 8) * 2);
    if (near) { const float* btp = (const float*)(lds + bt);
#pragma unroll
        for (int r = 0; r < 16; ++r) { const int c = (r & 3) + 8 * (r >> 2); int d0 = dq - c, d1 = dq - c - 32;
            d0 = d0 < 0 ? 0 : (d0 > 127 ? 127 : d0); d1 = d1 < 0 ? 0 : (d1 > 127 ? 127 : d1);
            p0[r] = btp[d0] - mhat; p1[r] = btp[d1] - mhat; }
#pragma unroll
        for (int d0 = 0; d0 < 8; ++d0) { const char* a = kb[d0 & 3] + (d0 >> 2) * 128;
            bf16x8 b0 = *reinterpret_cast<const bf16x8*>(a); bf16x8 b1 = *reinterpret_cast<const bf16x8*>(a + 32 * 256);
            p0 = __builtin_amdgcn_mfma_f32_32x32x16_bf16(b0, qr[d0], p0, 0, 0, 0); p1 = __builtin_amdgcn_mfma_f32_32x32x16_bf16(b1, qr[d0], p1, 0, 0, 0); }
    } else {
#pragma unroll
        for (int d0 = 0; d0 < 8; ++d0) { const char* a = kb[d0 & 3] + (d0 >> 2) * 128;
            bf16x8 b0 = *reinterpret_cast<const bf16x8*>(a); bf16x8 b1 = *reinterpret_cast<const bf16x8*>(a + 32 * 256);
            if (d0 == 0) { p0 = __builtin_amdgcn_mfma_f32_32x32x16_bf16(b0, qr[0], negm, 0, 0, 0); p1 = __builtin_amdgcn_mfma_f32_32x32x16_bf16(b1, qr[0], negm, 0, 0, 0); }
            else { p0 = __builtin_amdgcn_mfma_f32_32x32x16_bf16(b0, qr[d0], p0, 0, 0, 0); p1 = __builtin_amdgcn_mfma_f32_32x32x16_bf16(b1, qr[d0], p1, 0, 0, 0); } }
    }
}
#define D_MX3(a, b, c) __builtin_fmaxf(__builtin_fmaxf((a), (b)), (c))
template <bool FIRST>
__device__ __forceinline__ void sm_head(f32x16& p0, f32x16& p1, float& mhat, f32x16& negm, float& alpha, bool& rs) {
    float a = D_MX3(p0[0], p0[1], p1[0]), b = D_MX3(p0[2], p0[3], p1[1]); a = D_MX3(a, p1[2], p1[3]);
#pragma unroll
    for (int r = 4; r < 16; r += 4) { a = D_MX3(a, p0[r], p0[r + 1]); b = D_MX3(b, p0[r + 2], p0[r + 3]); a = D_MX3(a, p1[r], p1[r + 1]); b = D_MX3(b, p1[r + 2], p1[r + 3]); }
    float rm = __builtin_fmaxf(a, b);
    { auto rr = __builtin_amdgcn_permlane32_swap(__float_as_uint(rm), __float_as_uint(rm), false, false); rm = __builtin_fmaxf(__uint_as_float(rr[0]), __uint_as_float(rr[1])); }
    alpha = 1.f; rs = false;
    if (FIRST || __any(rm > THR2)) {
        const float dl = FIRST ? rm : __builtin_fmaxf(rm, 0.f);
        mhat += dl;
#pragma unroll
        for (int r = 0; r < 16; ++r) { p0[r] -= dl; p1[r] -= dl; }
#pragma unroll
        for (int r = 0; r < 16; ++r) negm[r] = -mhat;
        if (!FIRST) { alpha = __builtin_amdgcn_exp2f(-dl); rs = true; }
    }
#pragma unroll
    for (int r = 0; r < 16; ++r) p0[r] = __builtin_amdgcn_exp2f(p0[r]);
}
__device__ __forceinline__ void sm_tail(f32x16& p0, f32x16& p1, bf16x8& pa0, bf16x8& pa1, bf16x8& pa2, bf16x8& pa3) {
#pragma unroll
    for (int r = 0; r < 16; ++r) p1[r] = __builtin_amdgcn_exp2f(p1[r]);
#define PK4(P, B_, OUT) do { unsigned a0 = cvtpk(P[B_+0], P[B_+1]), a1 = cvtpk(P[B_+2], P[B_+3]);                          \
        unsigned b0 = cvtpk(P[B_+4], P[B_+5]), b1 = cvtpk(P[B_+6], P[B_+7]);                                             \
        auto r0 = __builtin_amdgcn_permlane32_swap(a0, b0, false, false); auto r1 = __builtin_amdgcn_permlane32_swap(a1, b1, false, false); \
        u32x4 w = {r0[0], r1[0], r0[1], r1[1]}; OUT = *reinterpret_cast<bf16x8*>(&w); } while (0)
    PK4(p0, 0, pa0); PK4(p0, 8, pa1); PK4(p1, 0, pa2); PK4(p1, 8, pa3);
#undef PK4
}
__device__ __forceinline__ void glds16s(const void* gbase, unsigned voff, unsigned lds_dst) { unsigned keep;
    asm volatile("s_mov_b32 %0, m0\n\ts_mov_b32 m0, %3\n\ts_nop 0\n\tglobal_load_lds_dwordx4 %1, %2\n\ts_mov_b32 m0, %0" : "=&s"(keep) : "v"(voff), "s"(gbase), "s"(lds_dst) : "memory"); }
struct DUnit { const bf16* Q; const bf16* K; const bf16* V; bf16* O; int P0; int bt; };
#define D_BAR() asm volatile("s_waitcnt lgkmcnt(0)\n\ts_barrier" ::: "memory")
#define D_VMW() asm volatile("s_waitcnt vmcnt(0)" ::: "memory")
#define D_LGKM(n) asm volatile("s_waitcnt lgkmcnt(" #n ")" ::: "memory")
#define D_TRRD(dst, off) asm volatile("ds_read_b64_tr_b16 %0, %1 offset:%2" : "=&v"(dst) : "v"(vb0), "i"(off) : "memory")
#define D_RD8(S, d0, VB) do { constexpr int b_ = D_V + (VB) * 32768 + ((d0) >> 2) * 16384 + ((d0) & 3) * 512; \
        D_TRRD(S##l0, b_); D_TRRD(S##h0, b_ + 2048); D_TRRD(S##l1, b_ + 4096); D_TRRD(S##h1, b_ + 6144); D_TRRD(S##l2, b_ + 8192); D_TRRD(S##h2, b_ + 10240); D_TRRD(S##l3, b_ + 12288); D_TRRD(S##h3, b_ + 14336); } while (0)
#define D_MM4(OACC, S) do { \
        OACC = __builtin_amdgcn_mfma_f32_32x32x16_bf16(pa0, (bf16x8){S##l0[0], S##l0[1], S##l0[2], S##l0[3], S##h0[0], S##h0[1], S##h0[2], S##h0[3]}, OACC, 0, 0, 0);   \
        OACC = __builtin_amdgcn_mfma_f32_32x32x16_bf16(pa1, (bf16x8){S##l1[0], S##l1[1], S##l1[2], S##l1[3], S##h1[0], S##h1[1], S##h1[2], S##h1[3]}, OACC, 0, 0, 0);   \
        OACC = __builtin_amdgcn_mfma_f32_32x32x16_bf16(pa2, (bf16x8){S##l2[0], S##l2[1], S##l2[2], S##l2[3], S##h2[0], S##h2[1], S##h2[2], S##h2[3]}, OACC, 0, 0, 0);   \
        OACC = __builtin_amdgcn_mfma_f32_32x32x16_bf16(pa3, (bf16x8){S##l3[0], S##l3[1], S##l3[2], S##l3[3], S##h3[0], S##h3[1], S##h3[2], S##h3[3]}, OACC, 0, 0, 0); } while (0)
#define D_STORE_O(OACC, colb) do { _Pragma("unroll") for (int r = 0; r < 16; ++r) { const int orow = (r & 3) + 8 * (r >> 2); const float v = OACC[r] * rli[r]; const float vn = __shfl_xor(v, 1); \
        if ((r32b & 1) == 0) *(unsigned*)(Ow + orow * 4096 + (colb)) = cvtpk(v, vn); } } while (0)

#define D_DMA_SETUP(w4)                                                     \
    const unsigned ldsb = (unsigned)(uintptr_t)lds;                                                                            \
    const int dw4 = (w4);                                                                                                      \
    const int krow = 4 * dw4 + (lane >> 4);                                                                                    \
    const unsigned koff = (unsigned)((krow * LDQ + (((lane & 15) ^ (krow & 7)) * 8)) * 2);                                     \
    const int kkl = (lane & 31) >> 2, vsub = lane >> 5, vj = dw4 & 1, ve = dw4 >> 1;                                            \
    const unsigned voff = (unsigned)((((8 * (kkl >> 2) + (kkl & 3)) * LDQ) + ve * 128 + (2 * vj + vsub) * 32 + (lane & 3) * 8) * 2); \
    const char* Kb = (const char*)u.K; const char* Vb = (const char*)u.V;
#define D_DMAK(t, buf) do { _Pragma("unroll") for (int i_ = 0; i_ < 4; ++i_) \
        glds16s(Kb + (size_t)((t) * KVBLK + 16 * i_) * (LDQ * 2), koff, (unsigned)__builtin_amdgcn_readfirstlane(ldsb + D_K + (buf) * 16384 + (dw4 + 4 * i_) * 1024)); } while (0)
#define D_DMAV(t, buf) do { _Pragma("unroll") for (int q_ = 0; q_ < 8; ++q_) \
        glds16s(Vb + (size_t)((t) * KVBLK + 16 * (q_ >> 1) + 4 * (q_ & 1)) * (LDQ * 2), voff, (unsigned)__builtin_amdgcn_readfirstlane(ldsb + D_V + (buf) * 32768 + ve * 16384 + (q_ * 2 + vj) * 1024)); } while (0)
__device__ __forceinline__ void diff_producer(const DUnit& u, char* lds, int tid) {
    const int lane = tid & 63, wq = __builtin_amdgcn_readfirstlane(tid >> 6), r32 = lane & 31, hi = lane >> 5;
    const int NT = (u.P0 + 127) / KVBLK + 1;
    const int qlo = u.P0 + wq * QBLK, qm = qlo + r32 - 4 * hi;
    const char* K_lds = lds + D_K;
    char* psb = lds + D_PS + wq * D_PSW + lane * 16;
    float* psf = (float*)(lds + D_PS + wq * D_PSW + 4096);
    const int bt = u.bt;
    bf16x8 qr[8];
    D_DMA_SETUP(wq);
#pragma unroll
    for (int d0 = 0; d0 < 8; ++d0) qr[d0] = load8(u.Q + (unsigned)((wq * QBLK + r32) * LDQ + d0 * 16 + hi * 8));
    D_DMAK(0, 0); D_VMW();
    __builtin_amdgcn_s_setprio(2);
    D_BAR();
    D_DMAK(1, 1);
    float mhat = 0.f; f32x16 negm = {};
    f32x16 pA0, pA1, pB0, pB1; float alA, alB; bool rsA, rsB = false; bf16x8 pa0, pa1, pa2, pa3;
#define D_NEAR(t) ((t) * KVBLK + 191 > qlo)
#define D_MASKT(P0_, P1_, t) do { const int kb_ = (t) * KVBLK; if (kb_ + KVBLK - 1 > qlo) mask_tile(P0_, P1_, qm - kb_, WBIG); } while (0)
#define D_QKT(KB, PX0, PX1, t) qkt_ref<KB>(PX0, PX1, K_lds, lds, r32, hi, qr, D_NEAR(t), qm - (t) * KVBLK, bt, negm, mhat)
    SBAR(); D_QKT(0, pA0, pA1, 0); D_MASKT(pA0, pA1, 0); sm_head<true>(pA0, pA1, mhat, negm, alA, rsA);
    D_VMW();
    D_BAR();
#define D_PSTEP(PX0, PX1, alX, rsX, PY0, PY1, alY, rsY, t, KBX, SLOT) do {                                                     \
        SBAR(); if ((t) + 1 < NT) D_QKT(KBX, PX0, PX1, (t) + 1);                                                               \
        if ((t) + 2 < NT) D_DMAK((t) + 2, SLOT);                                   \
        sm_tail(PY0, PY1, pa0, pa1, pa2, pa3); SBAR();                                                                         \
        { char* s_ = psb + (SLOT) * D_SLOT; *(bf16x8*)(s_) = pa0; *(bf16x8*)(s_ + 1024) = pa1; *(bf16x8*)(s_ + 2048) = pa2; *(bf16x8*)(s_ + 3072) = pa3; \
          float* f_ = psf + (SLOT) * (D_SLOT / 4); if (hi == 0) { f_[r32] = (alY); } if (lane == 0) ((int*)f_)[32] = (rsY) ? 1 : 0; } \
        if ((t) + 1 < NT) { D_MASKT(PX0, PX1, (t) + 1); sm_head<false>(PX0, PX1, mhat, negm, alX, rsX); }                       \
        D_VMW();                                                                                                               \
        D_BAR();                                                                                                               \
    } while (0)
    for (int t = 0; t + 1 < NT; t += 2) {
        D_PSTEP(pB0, pB1, alB, rsB, pA0, pA1, alA, rsA, t, 1, 0);
        D_PSTEP(pA0, pA1, alA, rsA, pB0, pB1, alB, rsB, t + 1, 0, 1);
    }
    D_BAR();
    __builtin_amdgcn_s_setprio(0);
#undef D_PSTEP
#undef D_QKT
#undef D_MASKT
#undef D_NEAR
}
__device__ __forceinline__ void diff_consumer(const DUnit& u, char* lds, int tid) {
    const int lane = tid & 63, wq = __builtin_amdgcn_readfirstlane((tid >> 6) & 3), hi = lane >> 5;
    const int NT = (u.P0 + 127) / KVBLK + 1;
    const float* psf = (const float*)(lds + D_PS + wq * D_PSW + 4096);
    const int psa = (int)(uintptr_t)lds + D_PS + wq * D_PSW + lane * 16;
    const int vb0 = (int)(uintptr_t)lds + v_rd_base(lane);
    D_DMA_SETUP(wq);
    D_BAR();
    f32x16 o0 = {}, o1 = {}, o2 = {}, o3 = {}, o4 = {}, o5 = {}, o6 = {}, o7 = {}, ol = {}; bf16x8 pa0, pa1, pa2, pa3;
    const bf16x8 ones = {0x3F80, 0x3F80, 0x3F80, 0x3F80, 0x3F80, 0x3F80, 0x3F80, 0x3F80};
#define D_MML() do { ol = __builtin_amdgcn_mfma_f32_32x32x16_bf16(pa0, ones, ol, 0, 0, 0); ol = __builtin_amdgcn_mfma_f32_32x32x16_bf16(pa1, ones, ol, 0, 0, 0); \
        ol = __builtin_amdgcn_mfma_f32_32x32x16_bf16(pa2, ones, ol, 0, 0, 0); ol = __builtin_amdgcn_mfma_f32_32x32x16_bf16(pa3, ones, ol, 0, 0, 0); } while (0)
    s16x4 Al0, Al1, Al2, Al3, Ah0, Ah1, Ah2, Ah3, Bl0, Bl1, Bl2, Bl3, Bh0, Bh1, Bh2, Bh3;
    D_VMW();
    D_BAR();
#define D_STAGE_UNUSED(t, SLOT) do { D_VMW(); if ((t) + 2 < NT) D_WRITEK(SLOT); D_WRITEV(SLOT);     \
        if ((t) + 3 < NT) D_LOADK((t) + 3); if ((t) + 1 < NT) D_LOADV((t) + 1); } while (0)
    D_DMAV(0, 0);
    D_VMW();
    D_BAR();
#define D_RDPA(SLOT) do { asm volatile("ds_read_b128 %0, %1 offset:%2" : "=&v"(pa0) : "v"(psa), "i"((SLOT) * D_SLOT) : "memory"); asm volatile("ds_read_b128 %0, %1 offset:%2" : "=&v"(pa1) : "v"(psa), "i"((SLOT) * D_SLOT + 1024) : "memory"); \
        asm volatile("ds_read_b128 %0, %1 offset:%2" : "=&v"(pa2) : "v"(psa), "i"((SLOT) * D_SLOT + 2048) : "memory"); asm volatile("ds_read_b128 %0, %1 offset:%2" : "=&v"(pa3) : "v"(psa), "i"((SLOT) * D_SLOT + 3072) : "memory"); } while (0)
#define D_CPV(VB) do { D_LGKM(0); SBAR();                                        \
        D_MM4(o0, A); D_RD8(A, 2, VB); D_MM4(o1, B); D_RD8(B, 3, VB); D_MML();                                                 \
        D_LGKM(8); SBAR(); D_MM4(o2, A); D_RD8(A, 4, VB);                                                                      \
        D_LGKM(8); SBAR(); D_MM4(o3, B); D_RD8(B, 5, VB);                                                                      \
        D_LGKM(8); SBAR(); D_MM4(o4, A); D_RD8(A, 6, VB);                                                                      \
        D_LGKM(8); SBAR(); D_MM4(o5, B); D_RD8(B, 7, VB);                                                                      \
        D_LGKM(8); SBAR(); D_MM4(o6, A);                                                                                       \
        D_LGKM(0); SBAR(); D_MM4(o7, B); } while (0)
#define D_CRESC(SLOT) do { const float* f_ = psf + (SLOT) * (D_SLOT / 4); if (__builtin_amdgcn_readfirstlane(((const int*)f_)[32]) != 0) { _Pragma("unroll") for (int r = 0; r < 16; ++r) { const float a_ = f_[crow(r, hi)];  \
            o0[r] *= a_; o1[r] *= a_; o2[r] *= a_; o3[r] *= a_; o4[r] *= a_; o5[r] *= a_; o6[r] *= a_; o7[r] *= a_; ol[r] *= a_; } } } while (0)
#define D_CSTEP(t, VB) do { D_RD8(A, 0, VB); if ((t) < NT) { D_DMAV((t), 1 - (VB)); } D_RD8(B, 1, VB); D_RDPA(VB); D_CRESC(VB); D_CPV(VB); D_VMW(); D_BAR(); } while (0)
    for (int t = 1; t < NT; t += 2) {
        D_CSTEP(t, 0);
        D_CSTEP(t + 1, 1);
    }
    {   unsigned short* stg = (unsigned short*)(lds + D_V + wq * 16384);
        const int r32 = lane & 31;
#define D_STG(OACC, colb) do { _Pragma("unroll") for (int r = 0; r < 16; ++r) stg[crow(r, hi) * 256 + (colb) + r32] = (unsigned short)(cvtpk(OACC[r] * __builtin_amdgcn_rcpf(ol[r]), 0.f) & 0xffffu); } while (0)
        D_STG(o0, 0); D_STG(o1, 32); D_STG(o2, 64); D_STG(o3, 96); D_STG(o4, 128); D_STG(o5, 160); D_STG(o6, 192); D_STG(o7, 224);
#undef D_STG
        asm volatile("s_waitcnt lgkmcnt(0)" ::: "memory");
        bf16* Ow = u.O + (unsigned)((wq * QBLK) * 4096);
#pragma unroll
        for (int i = 0; i < 16; ++i) { const int row = 2 * i + (lane >> 5), ch = lane & 31;
            const u32x4 v = *(const u32x4*)(stg + row * 256 + ch * 8); *(u32x4*)(Ow + row * 4096 + ch * 8) = v; }
        asm volatile("s_waitcnt lgkmcnt(0)" ::: "memory");
    }
#undef D_MML
#undef D_CSTEP
#undef D_STAGE_UNUSED
#undef D_CRESC
#undef D_CPV
#undef D_RDPA
}
#undef D_DMA_SETUP
#undef D_DMAK
#undef D_DMAV
#undef D_BAR
#undef D_VMW
#undef D_LGKM
#undef D_TRRD
#undef D_RD8
#undef D_MM4
#undef D_STORE_O
#undef ROW
#undef VMW
#undef VMWN
#undef SLOAD_H
#undef SWRITE_HK
#undef SWRITE_HV
#undef SWRITE_H
#undef KSWZ
#undef SBAR
}
namespace cg = cooperative_groups;
#define LAS __attribute__((address_space(3)))
typedef unsigned short bf16;
typedef unsigned v4u __attribute__((ext_vector_type(4)));
typedef unsigned v2u __attribute__((ext_vector_type(2)));
typedef float f32x4 __attribute__((ext_vector_type(4)));

constexpr int BATCH = 2, SEQ = 16384, DM = 2048, FF = 5632, DEPTH = 2;
constexpr int M = BATCH * SEQ;
constexpr int NQKV = 3 * DM;
constexpr float LN_EPS = 1e-5f;
constexpr float ALPHA = 1.4142135623730951f;
constexpr float QSCALE = 0.08838834764831845f * 1.4426950408889634f;
constexpr int NWAVES = 8, NTHREADS = 512;
constexpr int LDS_BYTES = 147456;

constexpr size_t MiB = 1u << 20;
constexpr size_t WS_WGU1 = 1 * MiB;
constexpr size_t WS_WD1 = WS_WGU1 + 44 * MiB;
constexpr size_t WS_WGU2 = WS_WD1 + 22 * MiB;
constexpr size_t WS_WD2 = WS_WGU2 + 44 * MiB;
constexpr size_t WS_WQKV = WS_WD2 + 22 * MiB;
constexpr size_t WS_WO = WS_WQKV + 24 * MiB;
constexpr size_t WS_XB = WS_WO + 8 * MiB;
constexpr size_t WS_BIG = WS_XB + 128 * MiB;
constexpr size_t WS_OP = WS_BIG + 384 * MiB;
constexpr size_t WS_LF = WS_OP + 256 * MiB;
constexpr size_t WS_C = WS_LF + 2 * MiB;
constexpr size_t WS_NR = WS_C + 2 * MiB;
constexpr size_t WS_CNT = WS_NR + 1 * MiB;
constexpr size_t WS_ST = WS_CNT + 1 * MiB;
constexpr size_t WS_BAR = WS_ST + 1 * MiB;
constexpr size_t WS_END = WS_BAR + 1 * MiB;

__device__ __forceinline__ unsigned f2bf(float f) { unsigned u = __builtin_bit_cast(unsigned, f); return (u + 0x7fffu + ((u >> 16) & 1u)) >> 16; }
__device__ __forceinline__ unsigned pk2(float lo, float hi) { return f2bf(lo) | (f2bf(hi) << 16); }
__device__ __forceinline__ float bf2f(unsigned short b) { return __builtin_bit_cast(float, (unsigned)b << 16); }
__device__ __forceinline__ float wave_sum(float v) {
#pragma unroll
    for (int o = 1; o < 64; o <<= 1) v += __shfl_xor(v, o);
    return v;
}
#define LDS_WAIT() asm volatile("s_waitcnt lgkmcnt(0)" ::: "memory")

__device__ __forceinline__ void transpose_item(const float* W, int K, int N, bf16* WT, int gu, LAS float* scr, int item, int lane) {
    const int nblk = N / 32, kb = item / nblk, nb = item % nblk, k0 = 64 * kb, n0 = 32 * nb;
    const int r0 = gu == 0 ? n0 : ((n0 >> 7) * 256 + (n0 & 127) + (gu == 2 ? 128 : 0));
    float wv[32];
#pragma unroll
    for (int i = 0; i < 32; ++i) { const int kk = 2 * i + (lane >> 5); wv[i] = W[(size_t)(k0 + kk) * N + n0 + (lane & 31)]; }
#pragma unroll
    for (int i = 0; i < 32; ++i) { const int kk = 2 * i + (lane >> 5); scr[kk * 33 + (lane & 31)] = wv[i]; }
    LDS_WAIT(); asm volatile("" ::: "memory");
    const int c = lane & 7;
#pragma unroll
    for (int j = 0; j < 4; ++j) { const int n = (lane >> 3) + 8 * j; const LAS float* s = scr + (8 * c) * 33 + n;
        v4u o; o.x = pk2(s[0 * 33], s[1 * 33]); o.y = pk2(s[2 * 33], s[3 * 33]); o.z = pk2(s[4 * 33], s[5 * 33]); o.w = pk2(s[6 * 33], s[7 * 33]);
        *(v4u*)(WT + (size_t)(r0 + n) * K + k0 + 8 * c) = o; }
    LDS_WAIT(); asm volatile("" ::: "memory");
}

#define XB_TMO      128
#define XB_XCNT(j)  (256  + 64 * (j))
#define XB_XSUB(j)  (1280 + 64 * (j))
#define XB_XGEN(j)  (2304 + 64 * (j))
#define XB_TOP      3328
#define XB_TOPGEN   3392
#define XCD_BAR_WORDS 3456
#define XB_SPIN_CAP (1u << 18)

__device__ __forceinline__ unsigned xb_ld(unsigned* p)              { return __hip_atomic_load(p, __ATOMIC_RELAXED, __HIP_MEMORY_SCOPE_AGENT); }
__device__ __forceinline__ unsigned xb_add(unsigned* p, unsigned v) { return __hip_atomic_fetch_add(p, v, __ATOMIC_RELAXED, __HIP_MEMORY_SCOPE_AGENT); }
__device__ __forceinline__ unsigned xb_xcc_id() { return (unsigned)__builtin_amdgcn_s_getreg((3 << 11) | 20) & 0xFu; }
#define XB_SPIN(cond, bar) do { unsigned _sp = 0; while (cond) { __builtin_amdgcn_s_sleep(1); \
    if ((++_sp & 255u) == 0u) { if (xb_ld(&(bar)[XB_TMO])) break; if (_sp > XB_SPIN_CAP) { atomicAdd(&(bar)[XB_TMO], 1u); break; } } } } while (0)

struct XcdBarrier {
    unsigned* bar; unsigned x;
    volatile LAS unsigned* st;
};

__device__ __forceinline__ XcdBarrier xcd_barrier_post(unsigned* bar, volatile LAS unsigned* st) {
    XcdBarrier b; b.bar = bar; b.x = xb_xcc_id(); b.st = st;
    if (threadIdx.x == 0) (void)xb_add(&bar[XB_XCNT(b.x)], 1u);
    return b;
}
__device__ __forceinline__ void xcd_barrier_complete(unsigned* bar, unsigned x, unsigned& nloc, unsigned& nx) {
    const unsigned G = gridDim.x * gridDim.y * gridDim.z;
    unsigned sum, cnt, mine, sp = 0u;
    for (;;) {
        sum = 0u; cnt = 0u; mine = 0u;
#pragma unroll
        for (unsigned j = 0; j < 16; ++j) { const unsigned c = xb_ld(&bar[XB_XCNT(j)]); sum += c; cnt += (c > 0u) ? 1u : 0u; mine = (j == x) ? c : mine; }
        if (sum == G) break;
        __builtin_amdgcn_s_sleep(1);
        if ((++sp & 255u) == 0u) { if (xb_ld(&bar[XB_TMO])) break; if (sp > XB_SPIN_CAP) { atomicAdd(&bar[XB_TMO], 1u); break; } }
    }
    nloc = mine > 0u ? mine : 1u; nx = cnt > 0u ? cnt : 1u;
}

__device__ __forceinline__ void xcd_barrier(const XcdBarrier& b) {
    asm volatile("s_waitcnt vmcnt(0)" ::: "memory");
    __syncthreads();
    if (threadIdx.x == 0) {
        unsigned* bar = b.bar;
        __builtin_amdgcn_s_waitcnt(0);
        unsigned nloc = b.st[0], nx = b.st[1];
        if (nloc == 0u) { xcd_barrier_complete(bar, b.x, nloc, nx); b.st[0] = nloc; b.st[1] = nx; }
        const unsigned old = xb_add(&bar[XB_XSUB(b.x)], 1u);
        const unsigned gen = old / nloc;
        if (old + 1u == (gen + 1u) * nloc) {
            __builtin_amdgcn_fence(__ATOMIC_RELEASE, "agent");
            asm volatile("s_waitcnt vmcnt(0)" ::: "memory");
            const unsigned og = xb_add(&bar[XB_TOP], 1u);
            const unsigned tg = og / nx;
            if (og + 1u == (tg + 1u) * nx) xb_add(&bar[XB_TOPGEN], 1u);
            else XB_SPIN(xb_ld(&bar[XB_TOPGEN]) == tg, bar);
            __builtin_amdgcn_fence(__ATOMIC_ACQUIRE, "agent");
            xb_add(&bar[XB_XGEN(b.x)], 1u);
            asm volatile("s_waitcnt vmcnt(0)" ::: "memory");
        } else {
            XB_SPIN(xb_ld(&bar[XB_XGEN(b.x)]) == gen, bar);
            __builtin_amdgcn_fence(__ATOMIC_ACQUIRE, "agent");
            asm volatile("s_waitcnt vmcnt(0)" ::: "memory");
        }
    }
    __syncthreads();
}


struct Args { const float* in[21]; float* out; unsigned char* ws; int ph_lo, ph_hi; };

template <bool GATE, bool FINAL>
__device__ __forceinline__ void ln_phase(const float* Y, float* X, bf16* XB, float* ST, const float* g, const float* b, const float* wf, const float* bfv, float* LF,
                                         LAS unsigned char* lds, int gw, int NGW, int tid, int lane) {
    LAS float* wT = (LAS float*)lds;
    if (GATE) {
        for (int idx = tid; idx < DM * 16; idx += NTHREADS) { const int k = idx >> 4, hh = idx & 15; wT[hh * DM + k] = wf[idx]; }
        __syncthreads();
    }
    f32x4 gv[8], bv[8];
#pragma unroll
    for (int j = 0; j < 8; ++j) { gv[j] = ((const f32x4*)g)[64 * j + lane]; bv[j] = ((const f32x4*)b)[64 * j + lane]; }
    f32x4 nx[8];
    if (gw < M) { const f32x4* yr = (const f32x4*)(Y + (size_t)gw * DM) + lane;
#pragma unroll
        for (int j = 0; j < 8; ++j) nx[j] = yr[64 * j]; }
    for (int m = gw; m < M; m += NGW) {
        f32x4 v[8]; float s = 0.f;
#pragma unroll
        for (int j = 0; j < 8; ++j) { v[j] = nx[j]; s += (v[j].x + v[j].y) + (v[j].z + v[j].w); }
        if (m + NGW < M) { const f32x4* yr = (const f32x4*)(Y + (size_t)(m + NGW) * DM) + lane;
#pragma unroll
            for (int j = 0; j < 8; ++j) nx[j] = yr[64 * j]; }
        const float mean = wave_sum(s) * (1.f / DM); float s2 = 0.f;
#pragma unroll
        for (int j = 0; j < 8; ++j) { v[j] = v[j] - mean; s2 += (v[j].x * v[j].x + v[j].y * v[j].y) + (v[j].z * v[j].z + v[j].w * v[j].w); }
        const float rstd = 1.f / sqrtf(wave_sum(s2) * (1.f / DM) + LN_EPS);
        f32x4* xr = (f32x4*)(X + (size_t)m * DM) + lane;
        v2u* o8 = (v2u*)(XB + (size_t)m * DM) + lane;
#pragma unroll
        for (int j = 0; j < 8; ++j) { v[j] = v[j] * rstd * gv[j] + bv[j];
            if (FINAL) xr[64 * j] = v[j];
            else { v2u w; w.x = pk2(v[j].x, v[j].y); w.y = pk2(v[j].z, v[j].w); o8[64 * j] = w; } }
        if (!FINAL && lane == 0) { ST[2 * (size_t)m] = mean; ST[2 * (size_t)m + 1] = rstd; }
        if (GATE) {
            float zmine = 0.f;
#pragma unroll 1
            for (int hh = 0; hh < 16; ++hh) { float a = 0.f;
#pragma unroll
                for (int j = 0; j < 8; ++j) { const f32x4 w = *(const LAS f32x4*)(wT + hh * DM + 256 * j + 4 * lane);
                    a += (v[j].x * w.x + v[j].y * w.y) + (v[j].z * w.z + v[j].w * w.w); }
                a = wave_sum(a); if (lane == hh) zmine = a; }
            if (lane < 16) { const float z = zmine + bfv[lane];
                const float ls = fminf(z, 0.f) - log1pf(expf(-fabsf(z)));
                LF[(size_t)m * 16 + lane] = ls; }
        }
    }
    if (GATE) __syncthreads();
}

__device__ __forceinline__ void cumsum_unit(const float* LF, float* C, int bh, LAS unsigned char* lds, int tid) {
    const int b = bh >> 4, hh = bh & 15; LAS double* sd = (LAS double*)lds;
    const float* src = LF + ((size_t)b * SEQ + 32 * tid) * 16 + hh;
    double t = 0.0;
    for (int i = 0; i < 32; ++i) t += (double)src[(size_t)i * 16];
    const int ln_ = tid & 63, wv_ = tid >> 6;
    double inc = t;
#pragma unroll
    for (int o = 1; o < 64; o <<= 1) { const double y = __shfl_up(inc, o); if (ln_ >= o) inc += y; }
    if (ln_ == 63) sd[wv_] = inc;
    __syncthreads();
    double pre = inc - t;
    for (int w = 0; w < wv_; ++w) pre += sd[w];
    float* dst = C + (size_t)bh * SEQ + 32 * tid;
    for (int i = 0; i < 32; ++i) { pre += (double)src[(size_t)i * 16]; dst[i] = (float)pre; }
    __syncthreads();
}

__device__ __forceinline__ void diff_combine(const bf16* OP, bf16* OB, const float* lq1, const float* lk1, const float* lq2, const float* lk2, const float* subg, float lam_init,
                                             int gw, int NGW, int lane) {
    const float d1 = wave_sum(lq1[lane] * lk1[lane] + lq1[lane + 64] * lk1[lane + 64]);
    const float d2 = wave_sum(lq2[lane] * lk2[lane] + lq2[lane + 64] * lk2[lane + 64]);
    const float lam = expf(d1) - expf(d2) + lam_init;
    const float osc = 1.f - lam_init;
    const int h = lane >> 3, e0 = (lane & 7) * 32;
    f32x4 sg[8];
#pragma unroll
    for (int i = 0; i < 8; ++i) sg[i] = ((const f32x4*)(subg + e0))[i];
    v4u na[4], nc[4];
    if (gw < M) { const v4u* pa_ = (const v4u*)(OP + (size_t)gw * 4096 + (h * 2 + 0) * 256 + e0); const v4u* pc_ = (const v4u*)(OP + (size_t)gw * 4096 + (h * 2 + 1) * 256 + e0);
#pragma unroll
        for (int i = 0; i < 4; ++i) { na[i] = pa_[i]; nc[i] = pc_[i]; } }
    for (int m = gw; m < M; m += NGW) {
        v4u a[4], c[4];
#pragma unroll
        for (int i = 0; i < 4; ++i) { a[i] = na[i]; c[i] = nc[i]; }
        if (m + NGW < M) { const v4u* pa_ = (const v4u*)(OP + (size_t)(m + NGW) * 4096 + (h * 2 + 0) * 256 + e0); const v4u* pc_ = (const v4u*)(OP + (size_t)(m + NGW) * 4096 + (h * 2 + 1) * 256 + e0);
#pragma unroll
            for (int i = 0; i < 4; ++i) { na[i] = pa_[i]; nc[i] = pc_[i]; } }
        float o[32]; float ss = 0.f;
#pragma unroll
        for (int i = 0; i < 4; ++i) {
            const unsigned aw[4] = {a[i].x, a[i].y, a[i].z, a[i].w}, cw[4] = {c[i].x, c[i].y, c[i].z, c[i].w};
#pragma unroll
            for (int j = 0; j < 4; ++j) {
                const float x0 = bf2f((unsigned short)(aw[j] & 0xffff)) - lam * bf2f((unsigned short)(cw[j] & 0xffff));
                const float x1 = bf2f((unsigned short)(aw[j] >> 16)) - lam * bf2f((unsigned short)(cw[j] >> 16));
                o[8 * i + 2 * j] = x0; o[8 * i + 2 * j + 1] = x1; ss += x0 * x0 + x1 * x1; } }
        ss += __shfl_xor(ss, 1); ss += __shfl_xor(ss, 2); ss += __shfl_xor(ss, 4);
        const float r = osc / sqrtf(ss * (1.f / 256.f) + LN_EPS);
        v4u* po = (v4u*)(OB + (size_t)m * DM + h * 256 + e0);
#pragma unroll
        for (int i = 0; i < 4; ++i) { const f32x4 g0 = sg[2 * i], g1 = sg[2 * i + 1]; v4u w;
            w.x = pk2(o[8 * i] * r * g0.x, o[8 * i + 1] * r * g0.y); w.y = pk2(o[8 * i + 2] * r * g0.z, o[8 * i + 3] * r * g0.w);
            w.z = pk2(o[8 * i + 4] * r * g1.x, o[8 * i + 5] * r * g1.y); w.w = pk2(o[8 * i + 6] * r * g1.z, o[8 * i + 7] * r * g1.w); po[i] = w; }
    }
}

template <int MODE>
__device__ __forceinline__ att::BlockRef attn_ref(int bh, int qb, const bf16* QKV, bf16* O, const float* C) {
    att::BlockRef r;
    if (MODE == 0) { const int b = bh >> 5, vh = bh & 31, h = vh >> 2, mp = (vh >> 1) & 1, e = vh & 1;
        const bf16* base = QKV + (size_t)b * SEQ * NQKV;
        r.Q = (const att::bf16*)(base + h * 256 + mp * 128 + (size_t)qb * 256 * NQKV);
        r.K = (const att::bf16*)(base + DM + h * 256 + mp * 128);
        r.V = (const att::bf16*)(base + 2 * DM + h * 256 + e * 128);
        r.O = (att::bf16*)(O + ((size_t)b * SEQ + (size_t)qb * 256) * 4096 + (h * 2 + mp) * 256 + e * 128);
        r.C = nullptr; r.bt = att::OFF_BT + h * 512;
    } else { const int b = bh >> 4, hh = bh & 15;
        const bf16* base = QKV + (size_t)b * SEQ * NQKV;
        r.Q = (const att::bf16*)(base + hh * 128 + (size_t)qb * 256 * NQKV);
        r.K = (const att::bf16*)(base + DM + hh * 128);
        r.V = (const att::bf16*)(base + 2 * DM + hh * 128);
        r.O = (att::bf16*)(O + ((size_t)b * SEQ + (size_t)qb * 256) * DM + hh * 128);
        r.C = C + (size_t)bh * SEQ; r.bt = 0;
    }
    r.P0 = qb * 256; r.jlo = 0;
    return r;
}
__device__ __forceinline__ void attn_decode(int L, int& bh, int& x) { const int xcd = L & 7, k = L >> 3, gi = k >> 5, r = k & 31; bh = gi * 8 + xcd; x = r; }
template <int MODE>
__device__ __forceinline__ void attn_phase(const bf16* QKV, bf16* O, const float* C, const float* rel_table, char* lds, int tid) {
    constexpr int NBH = MODE == 0 ? 64 : 32, NQB = SEQ / 256, total = NBH * 32;
    if (MODE == 0) {
        float* btab = (float*)(lds + att::OFF_BT);
        for (int i = tid; i < 8 * 128; i += NTHREADS) { const int h = i >> 7, n = i & 127;
            int bk = n; if (n >= 16) { bk = 16 + (int)(logf((float)n * (1.f / 16.f)) / 2.0794415416798357f * 16.f); bk = bk > 31 ? 31 : bk; }
            btab[i] = (rel_table[bk * 8 + h] - rel_table[31 * 8 + h]) * att::LOG2E; }
        __syncthreads();
    }
    const int stride = gridDim.x; int L = blockIdx.x; if (L >= total) return;
    int bh, x; attn_decode(L, bh, x); int pass = 0;
    att::BlockRef cur = attn_ref<MODE>(bh, NQB - 1 - x, QKV, O, C);
    att::Seam S;
    att::attn_prime<MODE>(cur, lds, S);
    for (;;) {
        const bool more_pass = pass == 0, more_item = L + stride < total, last = !more_pass && !more_item;
        int bhn = bh, xn = x, passn = pass + 1, Ln = L;
        if (!more_pass) { passn = 0; Ln = more_item ? L + stride : L; attn_decode(Ln, bhn, xn); }
        const att::BlockRef nxt = last ? cur : attn_ref<MODE>(bhn, passn ? xn : NQB - 1 - xn, QKV, O, C);
        att::attn_block<MODE, (MODE == 0 ? 4096 : DM)>(cur, nxt, lds, S);
        if (last) break;
        cur = nxt; bh = bhn; x = xn; pass = passn; L = Ln;
    }
}
__device__ __forceinline__ void diff_phase(const bf16* QKV, bf16* OP, const float* rel_table, char* lds, int tid) {
    {   float* btab = (float*)(lds + att::D_BT);
        for (int i = tid; i < 8 * 128; i += NTHREADS) { const int h = i >> 7, n = i & 127;
            int bk = n; if (n >= 16) { bk = 16 + (int)(logf((float)n * (1.f / 16.f)) / 2.0794415416798357f * 16.f); bk = bk > 31 ? 31 : bk; }
            btab[i] = (rel_table[bk * 8 + h] - rel_table[31 * 8 + h]) * att::LOG2E; }
        __syncthreads(); }
    const int wid = __builtin_amdgcn_readfirstlane(tid >> 6);
#pragma unroll 1
    for (int L = blockIdx.x; L < 2048; L += gridDim.x) {
        const int xcd = L & 7, k = L >> 3, gi = k >> 6, x = k & 63, bhm = gi * 8 + xcd;
        const int b = bhm >> 4, h = (bhm >> 1) & 7, mp = bhm & 1;
        const bf16* base = QKV + (size_t)b * SEQ * NQKV;
#pragma unroll 1
        for (int pass = 0; pass < 2; ++pass) {
            const int qb = pass ? x : 127 - x;
            att::DUnit u; u.P0 = qb * 128;
            u.Q = (const att::bf16*)(base + h * 256 + mp * 128 + (size_t)u.P0 * NQKV);
            u.K = (const att::bf16*)(base + DM + h * 256 + mp * 128);
            u.V = (const att::bf16*)(base + 2 * DM + h * 256);
            u.O = (att::bf16*)(OP + ((size_t)b * SEQ + u.P0) * 4096 + (h * 2 + mp) * 256);
            u.bt = att::D_BT + h * 512;
            int tid2 = tid; asm volatile("" : "+v"(tid2));
            if (wid < 4) att::diff_producer(u, lds, tid2); else att::diff_consumer(u, lds, tid2);
        }
    }
}
constexpr int OFF_MB = att::LDS_BYTES;
__device__ __forceinline__ void fox_fetch(unsigned* CNT, const float* NR, const float* C, int* mb, int lane) {
    asm volatile("" : "+v"(lane));
    const int x = blockIdx.x & 7; int v = -1, tgt = 0;
    if (lane == 0) { const unsigned r = __hip_atomic_fetch_add(CNT, 1u, __ATOMIC_RELAXED, __HIP_MEMORY_SCOPE_AGENT); if (r < 2048u) { v = (int)r; tgt = 0; } (void)x; }
    v = __shfl(v, 0); tgt = __shfl(tgt, 0);
    if (v < 0) { if (lane == 0) mb[3] = 0; return; }
    const int bh = tgt + (v & 31), qb = 63 - (v >> 5);
    const float* qn = NR + bh * 256 + 4 * qb; const float* kn = NR + 8192 + bh * 256; const float* Cb = C + (size_t)bh * SEQ;
    const float Qm = fmaxf(fmaxf(qn[0], qn[1]), fmaxf(qn[2], qn[3])), Kd = fmaxf(fmaxf(kn[4 * qb], kn[4 * qb + 1]), fmaxf(kn[4 * qb + 2], kn[4 * qb + 3]));
    const float rhs = -(Qm * Kd) - 36.f, cref = Cb[256 * qb];
    const int nvalid = 4 * qb; float carry = 0.f; int jlo = 0;
    float knv[4], cjv[4];
#pragma unroll
    for (int c_ = 0; c_ < 4; ++c_) { const int j = 64 * c_ + lane; const bool ok = j < nvalid; knv[c_] = ok ? kn[j] : 0.f; cjv[c_] = ok ? Cb[64 * j + 63] : 0.f; }
#pragma unroll
    for (int c_ = 0; c_ < 4; ++c_) { const int base = 64 * c_; if (base >= nvalid) break;
        const int j = base + lane; const bool ok = j < nvalid;
        float k = knv[c_];
#pragma unroll
        for (int o = 1; o < 64; o <<= 1) { const float t = __shfl_up(k, o); if (lane >= o) k = fmaxf(k, t); }
        k = fmaxf(k, carry);
        const float cj = cjv[c_];
        const bool skip = ok && (Qm * k + (cref - cj) * att::LOG2E < rhs);
        const unsigned long long m = __ballot(skip);
        const int cnt = (~m == 0ull) ? 64 : __builtin_ctzll(~m);
        jlo += cnt;
        if (cnt < 64) break;
        carry = __shfl(k, 63);
    }
    if (lane == 0) { mb[0] = bh; mb[1] = qb; mb[2] = jlo; mb[3] = 1; }
}
__device__ __forceinline__ void fox_phase(const bf16* QKV, bf16* O, const float* C, const float* NR, unsigned* CNT, char* lds, int tid) {
    const int lane = tid & 63, wid = __builtin_amdgcn_readfirstlane(tid >> 6);
    int* mb = (int*)(lds + OFF_MB);
    if (wid == 0) fox_fetch(CNT, NR, C, mb, lane);
    __syncthreads();
    if (__builtin_amdgcn_readfirstlane(mb[3]) == 0) return;
    if (wid >= 4) __builtin_amdgcn_s_setprio(1);
    att::BlockRef cur = attn_ref<1>(__builtin_amdgcn_readfirstlane(mb[0]), __builtin_amdgcn_readfirstlane(mb[1]), QKV, O, C); cur.jlo = __builtin_amdgcn_readfirstlane(mb[2]);
    __syncthreads();
    att::Seam S;
    att::attn_prime<1>(cur, lds, S);
    for (;;) {
        if (wid == 0) fox_fetch(CNT, NR, C, mb, lane);
        __syncthreads();
        const bool has = __builtin_amdgcn_readfirstlane(mb[3]) != 0;
        att::BlockRef nxt = cur; if (has) { nxt = attn_ref<1>(__builtin_amdgcn_readfirstlane(mb[0]), __builtin_amdgcn_readfirstlane(mb[1]), QKV, O, C); nxt.jlo = __builtin_amdgcn_readfirstlane(mb[2]); }
        att::attn_block<1, DM>(cur, nxt, lds, S);
        if (!has) break;
        cur = nxt;
    }
    __builtin_amdgcn_s_setprio(0);
}
__device__ __forceinline__ void norm_phase(const bf16* QKV, float* NR, int gw, int NGW, int lane) {
    for (int w = gw; w < 2 * 32 * 256; w += NGW) {
        const int which = w >> 13, bh = (w >> 8) & 31, chunk = w & 255, b = bh >> 4, hh = bh & 15;
        const v4u* p = (const v4u*)(QKV + ((size_t)b * SEQ + chunk * 64 + lane) * NQKV + which * DM + hh * 128);
        float ss = 0.f;
#pragma unroll 4
        for (int i = 0; i < 16; ++i) { const v4u v = p[i];
            const float a0 = bf2f((unsigned short)(v.x & 0xffff)), a1 = bf2f((unsigned short)(v.x >> 16)), a2 = bf2f((unsigned short)(v.y & 0xffff)), a3 = bf2f((unsigned short)(v.y >> 16));
            const float a4 = bf2f((unsigned short)(v.z & 0xffff)), a5 = bf2f((unsigned short)(v.z >> 16)), a6 = bf2f((unsigned short)(v.w & 0xffff)), a7 = bf2f((unsigned short)(v.w >> 16));
            ss += (a0 * a0 + a1 * a1) + (a2 * a2 + a3 * a3) + (a4 * a4 + a5 * a5) + (a6 * a6 + a7 * a7); }
        float nrm = sqrtf(ss) * 1.0001f;
#pragma unroll
        for (int o = 1; o < 64; o <<= 1) nrm = fmaxf(nrm, __shfl_xor(nrm, o));
        if (lane == 0) NR[w] = nrm;
    }
}

#define PHASE_BEGIN if (ph >= lo && ph < hi) {
#if defined(PROBE_A)
#define PROBE_STAMP(i) do { if (blockIdx.x == 0 && threadIdx.x == 0) ((unsigned long long*)(args.ws + WS_END))[(i)] = __builtin_amdgcn_s_memrealtime(); } while (0)
#else
#define PROBE_STAMP(i) do { } while (0)
#endif
#define PHASE_END   if (ph + 1 < hi && ph != 12) { if (lo < 0) grid.sync(); xcd_barrier(xbar); }     PROBE_STAMP(ph + 1); } ++ph;
template <int layer>
__device__ __forceinline__ void layer_body(const Args& args, cg::grid_group& grid, const XcdBarrier& xbar, unsigned char* lds, int& ph) {
    LAS unsigned char* ldsl = (LAS unsigned char*)lds;
    const int tid = threadIdx.x, lane = tid & 63, wave = __builtin_amdgcn_readfirstlane(tid >> 6);
    const int G = gridDim.x; const int bx = blockIdx.x;
    const int vcu = (G % 8 == 0) ? (bx % 8) * (G / 8) + bx / 8 : bx;
    const int gw = vcu * NWAVES + wave, NGW = G * NWAVES;
    unsigned char* ws = args.ws;
    const float* x_in = args.in[0]; float* X = args.out;
    bf16* Wgu1 = (bf16*)(ws + WS_WGU1); bf16* Wd1 = (bf16*)(ws + WS_WD1); bf16* Wgu2 = (bf16*)(ws + WS_WGU2); bf16* Wd2 = (bf16*)(ws + WS_WD2);
    bf16* Wqkv = (bf16*)(ws + WS_WQKV); bf16* Wo = (bf16*)(ws + WS_WO);
    bf16* XB = (bf16*)(ws + WS_XB); bf16* HB = (bf16*)(ws + WS_BIG); bf16* QKV = (bf16*)(ws + WS_BIG); bf16* OP = (bf16*)(ws + WS_OP);
    float* LF = (float*)(ws + WS_LF); float* CC = (float*)(ws + WS_C); float* NR = (float*)(ws + WS_NR); unsigned* CNT = (unsigned*)(ws + WS_CNT); float* ST = (float*)(ws + WS_ST);
    const int lo = args.ph_lo, hi = args.ph_hi;
        constexpr bool fox = (layer & 1) != 0;
        const float* w1g = args.in[2] + (size_t)layer * DM * FF; const float* w1u = args.in[3] + (size_t)layer * DM * FF; const float* w1d = args.in[4] + (size_t)layer * DM * FF;
        const float* w2g = args.in[5] + (size_t)layer * DM * FF; const float* w2u = args.in[6] + (size_t)layer * DM * FF; const float* w2d = args.in[7] + (size_t)layer * DM * FF;
        const float* lng = args.in[8] + (size_t)layer * 3 * DM; const float* lnb = args.in[9] + (size_t)layer * 3 * DM;
        const float* wqkv_f = fox ? args.in[17] : args.in[10]; const float* wo_f = fox ? args.in[18] : args.in[11];

        PHASE_BEGIN
            LAS float* scr = (LAS float*)(ldsl + wave * 16384);
            constexpr int I_F = (DM / 64) * (FF / 32), I_D = (FF / 64) * (DM / 32), I_Q = (DM / 64) * (NQKV / 32), I_O = (DM / 64) * (DM / 32);
            constexpr int NITEMS = 4 * I_F + 2 * I_D + I_Q + I_O;
            for (int it = gw; it < NITEMS; it += NGW) {
                int r = it;
                if (r < I_F) { transpose_item(w1g, DM, FF, Wgu1, 1, scr, r, lane); continue; } r -= I_F;
                if (r < I_F) { transpose_item(w1u, DM, FF, Wgu1, 2, scr, r, lane); continue; } r -= I_F;
                if (r < I_D) { transpose_item(w1d, FF, DM, Wd1, 0, scr, r, lane); continue; } r -= I_D;
                if (r < I_F) { transpose_item(w2g, DM, FF, Wgu2, 1, scr, r, lane); continue; } r -= I_F;
                if (r < I_F) { transpose_item(w2u, DM, FF, Wgu2, 2, scr, r, lane); continue; } r -= I_F;
                if (r < I_D) { transpose_item(w2d, FF, DM, Wd2, 0, scr, r, lane); continue; } r -= I_D;
                if (r < I_Q) { transpose_item(wqkv_f, DM, NQKV, Wqkv, 0, scr, r, lane); continue; } r -= I_Q;
                transpose_item(wo_f, DM, DM, Wo, 0, scr, r, lane);
            }
            if (fox && bx == 0 && tid < 8) CNT[tid * 64] = 0u;
            if (layer == 0) {
                for (int m = gw; m < M; m += NGW) { const f32x4* xr = (const f32x4*)(x_in + (size_t)m * DM) + lane; v2u* o8 = (v2u*)(XB + (size_t)m * DM) + lane;
#pragma unroll
                    for (int j = 0; j < 8; ++j) { const f32x4 v = xr[64 * j]; v2u w; w.x = pk2(v.x, v.y); w.y = pk2(v.z, v.w); o8[64 * j] = w; } }
            }
            __syncthreads();
        PHASE_END

        PHASE_BEGIN
            pg8::Gemm g{XB, Wgu1, M, 2 * FF, DM}; pg8::StaticOrder S; S.init(M, 2 * FF, G, bx);
            pg8::EpiSwiGLU E{HB, FF};
#ifndef NO_GEMM_SW
            pg8::gemm_phase<pg8::EpiSwiGLU, pg8::StaticOrder, true, true>(ldsl, g, S, E);
#endif
        PHASE_END
        PHASE_BEGIN
            pg8::Gemm g{HB, Wd1, M, DM, FF}; pg8::StaticOrder S; S.init(M, DM, G, bx);
#ifndef NO_GEMM_RES
            if constexpr (layer == 0) { pg8::EpiRes<false> E{x_in, X, DM, ALPHA, 0.5f, nullptr, nullptr, nullptr};
                pg8::gemm_phase<pg8::EpiRes<false>, pg8::StaticOrder, true, true>(ldsl, g, S, E); }
            else { pg8::EpiRes<true> E{X, X, DM, ALPHA, 0.5f, (const pg8::f32x2*)ST, lng - DM, lnb - DM};
                pg8::gemm_phase<pg8::EpiRes<true>, pg8::StaticOrder, true, true>(ldsl, g, S, E); }
#endif
        PHASE_END
        PHASE_BEGIN
            if (fox) ln_phase<true, false>(X, X, XB, ST, lng, lnb, args.in[19], args.in[20], LF, ldsl, gw, NGW, tid, lane);
            else ln_phase<false, false>(X, X, XB, ST, lng, lnb, nullptr, nullptr, nullptr, ldsl, gw, NGW, tid, lane);
        PHASE_END
        PHASE_BEGIN
            if (fox && bx < 32) cumsum_unit(LF, CC, bx, ldsl, tid);
            pg8::Gemm g{XB, Wqkv, M, NQKV, DM}; pg8::StaticOrder S; S.init(M, NQKV, G, bx);
            pg8::EpiBf16S E{QKV, NQKV, DM, QSCALE};
#ifndef NO_GEMM_QKV
            pg8::gemm_phase<pg8::EpiBf16S, pg8::StaticOrder, true, true>(ldsl, g, S, E);
#endif
        PHASE_END
        if (fox) {
        PHASE_BEGIN
            norm_phase(QKV, NR, gw, NGW, lane);
        PHASE_END
        } else { ++ph; }
        PHASE_BEGIN
#ifndef NO_ATT1
            if (fox) fox_phase(QKV, XB, CC, NR, CNT, (char*)lds, tid);
#endif
#ifndef NO_ATT0
            if (!fox) diff_phase(QKV, OP, args.in[1], (char*)lds, tid);
#endif
            __syncthreads();
        PHASE_END
        if (!fox) {
        PHASE_BEGIN
            const float lam_init = 0.8f - 0.6f * expf(-0.3f * (float)layer);
            diff_combine(OP, XB, args.in[12], args.in[13], args.in[14], args.in[15], args.in[16], lam_init, gw, NGW, lane);
        PHASE_END
        } else { ++ph; }
        PHASE_BEGIN
            pg8::Gemm g{XB, Wo, M, DM, DM}; pg8::StaticOrder S; S.init(M, DM, G, bx);
            pg8::EpiRes<true> E{X, X, DM, ALPHA, 1.0f, (const pg8::f32x2*)ST, lng, lnb};
#ifndef NO_GEMM_RES
            pg8::gemm_phase<pg8::EpiRes<true>, pg8::StaticOrder, true, true>(ldsl, g, S, E);
#endif
        PHASE_END
        PHASE_BEGIN
            ln_phase<false, false>(X, X, XB, ST, lng + DM, lnb + DM, nullptr, nullptr, nullptr, ldsl, gw, NGW, tid, lane);
        PHASE_END
        PHASE_BEGIN
            pg8::Gemm g{XB, Wgu2, M, 2 * FF, DM}; pg8::StaticOrder S; S.init(M, 2 * FF, G, bx);
            pg8::EpiSwiGLU E{HB, FF};
#ifndef NO_GEMM_SW
            pg8::gemm_phase<pg8::EpiSwiGLU, pg8::StaticOrder, true, true>(ldsl, g, S, E);
#endif
        PHASE_END
        PHASE_BEGIN
            pg8::Gemm g{HB, Wd2, M, DM, FF}; pg8::StaticOrder S; S.init(M, DM, G, bx);
            pg8::EpiRes<true> E{X, X, DM, ALPHA, 0.5f, (const pg8::f32x2*)ST, lng + DM, lnb + DM};
#ifndef NO_GEMM_RES
            pg8::gemm_phase<pg8::EpiRes<true>, pg8::StaticOrder, true, true>(ldsl, g, S, E);
#endif
        PHASE_END
        PHASE_BEGIN
            ln_phase<false, (layer == DEPTH - 1)>(X, X, XB, ST, lng + 2 * DM, lnb + 2 * DM, nullptr, nullptr, nullptr, ldsl, gw, NGW, tid, lane);
        PHASE_END
    }
#undef PHASE_BEGIN
#undef PHASE_END
__global__ void __launch_bounds__(NTHREADS, 2) fwd_megakernel(Args args) {
    extern __shared__ __attribute__((aligned(16))) unsigned char lds[];
    cg::grid_group grid = cg::this_grid();
    int ph = 0;
    PROBE_STAMP(0);
    volatile LAS unsigned* xst = (volatile LAS unsigned*)((LAS unsigned char*)lds + (LDS_BYTES - 64));
    if (threadIdx.x < 2) xst[threadIdx.x] = 0u;
    __syncthreads();
    const XcdBarrier xbar = xcd_barrier_post((unsigned*)(args.ws + WS_BAR), xst);
    layer_body<0>(args, grid, xbar, lds, ph);
    layer_body<1>(args, grid, xbar, lds, ph);
#if defined(PROBE_A)
    {
        const unsigned long long* ts = (const unsigned long long*)(args.ws + WS_END);
        float* o = args.out + (size_t)blockIdx.x * (size_t)(M / 256) * DM;
        for (int i = threadIdx.x; i < (M / 256) * DM; i += NTHREADS) o[i] = 1000.f;
        __syncthreads();
        if (blockIdx.x == 0 && threadIdx.x == 0) o[0] = (float)(ts[PROBE_A + 1] - ts[PROBE_S]) * 1e-2f;
    }
#endif
}

extern "C" void kernel_launch(void* const* d_in, const int* in_sizes, int n_in, void* d_out, int out_size, void* d_ws, size_t ws_size, hipStream_t stream) {
    static int grid = 0;
    if (grid == 0) {
        if (n_in != 21 || in_sizes[0] != M * DM || out_size != M * DM || ws_size < WS_END) {
            fprintf(stderr, "kernel_launch: unexpected shapes (n_in %d, in0 %d, out %d, ws %zu < %zu); nothing launched\n", n_in, n_in > 0 ? in_sizes[0] : -1, out_size, ws_size, (size_t)WS_END); grid = -1; return; }
        int dev = 0, cus = 0, per_cu = 0;
        (void)hipGetDevice(&dev); (void)hipDeviceGetAttribute(&cus, hipDeviceAttributeMultiprocessorCount, dev);
        if (hipFuncSetAttribute((const void*)fwd_megakernel, hipFuncAttributeMaxDynamicSharedMemorySize, LDS_BYTES) != hipSuccess) { fprintf(stderr, "kernel_launch: hipFuncSetAttribute failed\n"); grid = -1; return; }
        if (hipOccupancyMaxActiveBlocksPerMultiprocessor(&per_cu, (const void*)fwd_megakernel, NTHREADS, LDS_BYTES) != hipSuccess || per_cu < 1) { fprintf(stderr, "kernel_launch: occupancy query says %d\n", per_cu); per_cu = 1; }
        (void)hipGetLastError();
        grid = cus * 1;
        if (grid <= 0) grid = 256;
    }
    if (grid < 0) return;
    Args a{};
    for (int i = 0; i < 21; ++i) a.in[i] = (const float*)d_in[i];
    a.out = (float*)d_out; a.ws = (unsigned char*)d_ws; a.ph_lo = 0; a.ph_hi = 26;
    (void)hipMemsetAsync((unsigned char*)d_ws + WS_BAR, 0, XCD_BAR_WORDS * sizeof(unsigned), stream);
    void* kargs[] = {&a};
    hipError_t e = hipLaunchCooperativeKernel((const void*)fwd_megakernel, dim3(grid), dim3(NTHREADS), kargs, LDS_BYTES, stream);
    if (e != hipSuccess) fprintf(stderr, "kernel_launch: cooperative launch failed: %s (grid %d)\n", hipGetErrorString(e), grid);
}
```

```cpp
#include <hip/hip_runtime.h>
#include <hip/hip_cooperative_groups.h>
#include <hip/hip_bf16.h>
#include <cstdio>
#include <cstdint>
#include <cmath>
namespace pg8 {
#define PG8_LAS __attribute__((address_space(3)))
typedef unsigned short bf16_t;
typedef short bf16x8 __attribute__((ext_vector_type(8)));
typedef float f32x4 __attribute__((ext_vector_type(4)));
typedef unsigned u32x4 __attribute__((ext_vector_type(4)));
constexpr int BM = 256, BK = 64, HALF = 128, HTB = HALF * BK * 2  , STAGE_BYTES = 8 * HTB, NXCD = 8, WGM = 8;

__host__ __device__ __forceinline__ int lds_byte(int r, int c) { const int st = (r >> 4) * 2 + (c >> 5), rr = r & 15, cc = c & 31, ob = rr * 64 + cc * 2; return st * 1024 + (ob ^ (((ob >> 9) & 1) << 5)); }
__host__ __device__ __forceinline__ void stage_rc(int b, int& R, int& C) { const int st = b / 1024, sb = b % 1024, swz = sb ^ (((sb >> 9) & 1) << 5); R = (st >> 1) * 16 + swz / 64; C = (st & 1) * 32 + (swz % 64) / 2; }
__host__ __device__ __forceinline__ int perm32(int rho) { const int n = rho >> 4, i = rho & 15; return 8 * (i >> 2) + 4 * n + (i & 3); }

struct Unit { int pm, pn; };
struct Gemm { const bf16_t* A; const bf16_t* Bt; int M, N, K; };

struct StaticOrder {
    int nM, nN, nwg, G, c;
    __host__ __device__ void init(int M, int N, int G_, int c_) { nM = M / BM; nN = N / BM; nwg = nM * nN; G = G_; c = c_; }
    __host__ __device__ bool next(int i, Unit& u) const {
        const long L = (long)i * G + c; if (L >= nwg) return false;
        int wgid = (int)L; { const int q = nwg / NXCD, r = nwg % NXCD, xcd = wgid % NXCD, off = wgid / NXCD; wgid = (xcd < r ? xcd * (q + 1) : r * (q + 1) + (xcd - r) * q) + off; }
        const int nig = WGM * nN, gid = wgid / nig, fm = gid * WGM, gsz = (nM - fm) < WGM ? (nM - fm) : WGM;
        u.pm = fm + ((wgid % nig) % gsz); u.pn = (wgid % nig) / gsz; return true;
    }
    __device__ __forceinline__ void a_ready(const Unit&) const {}
    __device__ __forceinline__ void done(const Unit&) const {}
};

__device__ __forceinline__ unsigned cvt_pk_bf16(float lo, float hi) { unsigned r; asm volatile("v_cvt_pk_bf16_f32 %0, %1, %2" : "=v"(r) : "v"(lo), "v"(hi)); return r; }
typedef float f32x2 __attribute__((ext_vector_type(2)));
struct EpiBf16S {
    static constexpr bool PERM = true, AFTER_DRAIN = false;
    bf16_t* O; int ldc; int scale_cols; float scale0;
    __device__ __forceinline__ void operator()(const f32x4 (&acc)[2][2][4][2], const Unit& u, int wr, int wc, int fr, int fq) const {
        const int row0 = u.pm * BM + wr * 64 + fr; const int colt = u.pn * BM;
        const float sc = (colt < scale_cols) ? scale0 : 1.f;
        const int col0 = colt + wc * 32 + 8 * fq;
#pragma unroll
        for (int ai = 0; ai < 2; ++ai)
#pragma unroll
            for (int m = 0; m < 4; ++m) { bf16_t* rowp = O + (size_t)(row0 + ai * HALF + m * 16) * ldc + col0;
#pragma unroll
                for (int bj = 0; bj < 2; ++bj) { f32x4 v0 = acc[ai][bj][m][0] * sc, v1 = acc[ai][bj][m][1] * sc;
                    u32x4 w; w.x = cvt_pk_bf16(v0[0], v0[1]); w.y = cvt_pk_bf16(v0[2], v0[3]); w.z = cvt_pk_bf16(v1[0], v1[1]); w.w = cvt_pk_bf16(v1[2], v1[3]);
                    *(u32x4*)(rowp + bj * HALF) = w; } }
    }
};
__device__ __forceinline__ float silu_mul(float g, float u) { return g * __builtin_amdgcn_rcpf(1.f + __builtin_amdgcn_exp2f(-1.4426950408889634f * g)) * u; }
struct EpiSwiGLU {
    static constexpr bool PERM = true, AFTER_DRAIN = false;
    bf16_t* H; int ldh;
    __device__ __forceinline__ void operator()(const f32x4 (&acc)[2][2][4][2], const Unit& u, int wr, int wc, int fr, int fq) const {
        const int row0 = u.pm * BM + wr * 64 + fr; const int col0 = u.pn * HALF + wc * 32 + 8 * fq;
#pragma unroll
        for (int ai = 0; ai < 2; ++ai)
#pragma unroll
            for (int m = 0; m < 4; ++m) { bf16_t* rowp = H + (size_t)(row0 + ai * HALF + m * 16) * ldh + col0;
                const f32x4 g0 = acc[ai][0][m][0], g1 = acc[ai][0][m][1], u0 = acc[ai][1][m][0], u1 = acc[ai][1][m][1];
                u32x4 w;
                w.x = cvt_pk_bf16(silu_mul(g0[0], u0[0]), silu_mul(g0[1], u0[1])); w.y = cvt_pk_bf16(silu_mul(g0[2], u0[2]), silu_mul(g0[3], u0[3]));
                w.z = cvt_pk_bf16(silu_mul(g1[0], u1[0]), silu_mul(g1[1], u1[1])); w.w = cvt_pk_bf16(silu_mul(g1[2], u1[2]), silu_mul(g1[3], u1[3]));
                *(u32x4*)rowp = w; }
    }
};
template <bool LNB> struct EpiRes {
    static constexpr bool PERM = false, AFTER_DRAIN = false;
    const float* base; float* out; int ldc; float alpha, s; const f32x2* st; const float* g; const float* b;
    __device__ __forceinline__ void operator()(const f32x4 (&acc)[2][2][4][2], const Unit& u, int wr, int wc, int fr, int fq) const {
        const int row0 = u.pm * BM + wr * 64 + fr; const int col0 = u.pn * BM + wc * 32 + 4 * fq;
        f32x2 mr[2][4];
        if (LNB) {
#pragma unroll
            for (int ai = 0; ai < 2; ++ai)
#pragma unroll
                for (int m = 0; m < 4; ++m) mr[ai][m] = st[row0 + ai * HALF + m * 16];
        }
#pragma unroll
        for (int bj = 0; bj < 2; ++bj)
#pragma unroll
            for (int n = 0; n < 2; ++n) { const int cc = col0 + bj * HALF + n * 16;
                f32x4 gv = {1.f, 1.f, 1.f, 1.f}, bv = {0.f, 0.f, 0.f, 0.f}; if (LNB) { gv = *(const f32x4*)(g + cc); bv = *(const f32x4*)(b + cc); }
#pragma unroll
                for (int ai = 0; ai < 2; ++ai)
#pragma unroll
                    for (int m = 0; m < 4; ++m) { const size_t off = (size_t)(row0 + ai * HALF + m * 16) * ldc + cc;
                        f32x4 y = *(const f32x4*)(base + off);
                        if (LNB) y = (y - mr[ai][m].x) * mr[ai][m].y * gv + bv;
                        const f32x4 o = y * alpha + acc[ai][bj][m][n] * s; *(f32x4*)(out + off) = o; }
                asm volatile("" ::: "memory"); }
    }
};
template <class Epi, class Sched, bool ALIGN_EPI = false, bool SP2 = false>
__device__ __forceinline__ void gemm_phase(PG8_LAS unsigned char* lds, const Gemm g, const Sched& S, const Epi& E) {
    const int tid = threadIdx.x, wid = __builtin_amdgcn_readfirstlane(tid >> 6), lane = tid & 63, wr = wid >> 2, wc = wid & 3, fr = lane & 15, fq = lane >> 4;
    const int K = g.K, nt = K / BK;
    unsigned voffA[2], voffB[2];
#pragma unroll
    for (int i = 0; i < 2; ++i) { int R, C; stage_rc(tid * 16 + i * 8192, R, C); const int Rb = Epi::PERM ? ((R & ~31) + perm32(R & 31)) : R;
        voffA[i] = (unsigned)(R * K + C) * 2u; voffB[i] = (unsigned)(Rb * K + C) * 2u; }
    const size_t kstep = (size_t)(BK * 2);
    const size_t hstep = (size_t)HALF * K * 2;
    const size_t tstep = 2 * hstep;
    const unsigned ldsw = (unsigned)wid * 1024u;
    const int aoff = lds_byte(wr * 64 + fr, fq * 8), boff = lds_byte(wc * 32 + fr, fq * 8);
#define PG8_SA(b, h) (((b) * 2 + (h)) * HTB)
#define PG8_SB(b, h) ((4 + (b) * 2 + (h)) * HTB)
#define PG8_STAGE(bufoff, gbase, voff) do { _Pragma("unroll") for (int _i = 0; _i < 2; ++_i) \
        __builtin_amdgcn_global_load_lds((const unsigned*)((const char*)(gbase) + (voff)[_i]), (PG8_LAS unsigned*)(lds + (bufoff) + ldsw + _i * 8192), 16, 0, 0); } while (0)
#define PG8_LDA(dst, b, h) do { _Pragma("unroll") for (int m = 0; m < 4; ++m) _Pragma("unroll") for (int k = 0; k < 2; ++k) dst[m][k] = *(const PG8_LAS bf16x8*)(lds + PG8_SA(b, h) + aoff + m * 2048 + k * 1024); } while (0)
#define PG8_LDB(dst, b, h) do { _Pragma("unroll") for (int n = 0; n < 2; ++n) _Pragma("unroll") for (int k = 0; k < 2; ++k) dst[n][k] = *(const PG8_LAS bf16x8*)(lds + PG8_SB(b, h) + boff + n * 2048 + k * 1024); } while (0)
#define PG8_MMA(ai, bj, At, Bt) do { __builtin_amdgcn_s_setprio(1); _Pragma("unroll") for (int m = 0; m < 4; ++m) _Pragma("unroll") for (int n = 0; n < 2; ++n) _Pragma("unroll") for (int k = 0; k < 2; ++k) \
        acc[ai][bj][m][n] = __builtin_amdgcn_mfma_f32_16x16x32_bf16(Bt[n][k], At[m][k], acc[ai][bj][m][n], 0, 0, 0); __builtin_amdgcn_s_setprio(0); } while (0)
#define PG8_WAIT_V(n) asm volatile("s_waitcnt vmcnt(" #n ")" ::: "memory")
#define PG8_WAIT_L(n) asm volatile("s_waitcnt lgkmcnt(" #n ")" ::: "memory")
#define PG8_BAR __builtin_amdgcn_s_barrier()
#define PG8_SCHED __builtin_amdgcn_sched_barrier(0)
    Unit cur, nxt; int ui = 0;
    if (!S.next(0, cur)) return;
    f32x4 acc[2][2][4][2];
#pragma unroll
    for (int a = 0; a < 2; ++a)
#pragma unroll
        for (int b = 0; b < 2; ++b)
#pragma unroll
            for (int m = 0; m < 4; ++m)
#pragma unroll
                for (int n = 0; n < 2; ++n) acc[a][b][m][n] = (f32x4){0.f, 0.f, 0.f, 0.f};
    bf16x8 At[4][2], B0[2][2], B1[2][2];
    const char* cA = (const char*)g.A + (size_t)cur.pm * tstep; const char* cB = (const char*)g.Bt + (size_t)cur.pn * tstep;
    S.a_ready(cur);
    if constexpr (SP2) {
        PG8_STAGE(PG8_SB(0, 0), cB, voffB); PG8_STAGE(PG8_SB(0, 1), cB + hstep, voffB); PG8_STAGE(PG8_SA(0, 0), cA, voffA); PG8_STAGE(PG8_SA(0, 1), cA + hstep, voffA);
        if (wr == 1) PG8_BAR;
        PG8_WAIT_V(2); PG8_BAR;
        PG8_STAGE(PG8_SB(1, 0), cB + kstep, voffB); PG8_STAGE(PG8_SA(1, 0), cA + kstep, voffA); PG8_STAGE(PG8_SB(1, 1), cB + hstep + kstep, voffB);
        PG8_WAIT_V(6); PG8_BAR;
    } else {
        PG8_STAGE(PG8_SB(0, 0), cB, voffB); PG8_STAGE(PG8_SA(0, 0), cA, voffA); PG8_STAGE(PG8_SB(0, 1), cB + hstep, voffB); PG8_STAGE(PG8_SA(0, 1), cA + hstep, voffA);
        if (wr == 1) PG8_BAR;
        PG8_WAIT_V(4); PG8_BAR;
        PG8_STAGE(PG8_SB(1, 0), cB + kstep, voffB); PG8_STAGE(PG8_SA(1, 0), cA + kstep, voffA); PG8_STAGE(PG8_SB(1, 1), cB + hstep + kstep, voffB);
        PG8_WAIT_V(6); PG8_BAR;
    }
    for (;;) {
        const bool has_next = S.next(ui + 1, nxt);
        const char* nA = has_next ? (const char*)g.A + (size_t)nxt.pm * tstep : cA; const char* nB = has_next ? (const char*)g.Bt + (size_t)nxt.pn * tstep : cB;
        for (int t = 0; t < nt; t += 2) {
            const bool last = (t == nt - 2);
            const char* a1 = cA + (size_t)(t + 1) * kstep;
            const char* a2 = last ? nA : cA + (size_t)(t + 2) * kstep; const char* b2 = last ? nB : cB + (size_t)(t + 2) * kstep;
            const char* a3 = a2 + kstep; const char* b3 = b2 + kstep;
            if (last && has_next) S.a_ready(nxt);
            if constexpr (SP2) {
            PG8_LDB(B0, 0, 0); PG8_LDB(B1, 0, 1); PG8_SCHED; PG8_LDA(At, 0, 0); PG8_STAGE(PG8_SA(1, 1), a1 + hstep, voffA);
            PG8_WAIT_V(8); PG8_WAIT_L(0); PG8_BAR; PG8_MMA(0, 0, At, B0); PG8_MMA(0, 1, At, B1); PG8_BAR; PG8_SCHED;
            PG8_LDA(At, 0, 1); PG8_STAGE(PG8_SB(0, 0), b2, voffB); PG8_STAGE(PG8_SB(0, 1), b2 + hstep, voffB); PG8_STAGE(PG8_SA(0, 0), a2, voffA);
            PG8_WAIT_V(8); PG8_WAIT_L(0); PG8_BAR; PG8_MMA(1, 0, At, B0); PG8_MMA(1, 1, At, B1); PG8_BAR; PG8_SCHED;
            PG8_LDB(B0, 1, 0); PG8_LDB(B1, 1, 1); PG8_SCHED; PG8_LDA(At, 1, 0); PG8_STAGE(PG8_SA(0, 1), a2 + hstep, voffA);
            PG8_WAIT_V(8); PG8_WAIT_L(0); PG8_BAR; PG8_MMA(0, 0, At, B0); PG8_MMA(0, 1, At, B1); PG8_BAR; PG8_SCHED;
            PG8_LDA(At, 1, 1); PG8_STAGE(PG8_SB(1, 0), b3, voffB); PG8_STAGE(PG8_SB(1, 1), b3 + hstep, voffB); PG8_STAGE(PG8_SA(1, 0), a3, voffA);
            PG8_WAIT_V(8); PG8_WAIT_L(0); PG8_BAR; PG8_MMA(1, 0, At, B0); PG8_MMA(1, 1, At, B1); PG8_BAR; PG8_SCHED;
            } else {
            PG8_LDB(B0, 0, 0); PG8_SCHED; PG8_LDA(At, 0, 0); PG8_STAGE(PG8_SA(1, 1), a1 + hstep, voffA);
            PG8_WAIT_L(8); PG8_BAR; PG8_WAIT_L(0); PG8_MMA(0, 0, At, B0); PG8_BAR; PG8_SCHED;
            PG8_LDB(B1, 0, 1); PG8_STAGE(PG8_SB(0, 0), b2, voffB);
            PG8_BAR; PG8_WAIT_L(0); PG8_MMA(0, 1, At, B1); PG8_BAR;
            PG8_LDA(At, 0, 1); PG8_STAGE(PG8_SA(0, 0), a2, voffA);
            PG8_BAR; PG8_WAIT_L(0); PG8_MMA(1, 0, At, B0); PG8_BAR; PG8_SCHED;
            PG8_STAGE(PG8_SB(0, 1), b2 + hstep, voffB);
            PG8_WAIT_V(6); PG8_BAR; PG8_MMA(1, 1, At, B1); PG8_BAR;
            PG8_LDB(B0, 1, 0); PG8_SCHED; PG8_LDA(At, 1, 0); PG8_STAGE(PG8_SA(0, 1), a2 + hstep, voffA);
            PG8_WAIT_L(8); PG8_BAR; PG8_WAIT_L(0); PG8_MMA(0, 0, At, B0); PG8_BAR; PG8_SCHED;
            PG8_LDB(B1, 1, 1); PG8_STAGE(PG8_SB(1, 0), b3, voffB);
            PG8_BAR; PG8_WAIT_L(0); PG8_MMA(0, 1, At, B1); PG8_BAR;
            PG8_LDA(At, 1, 1); PG8_STAGE(PG8_SA(1, 0), a3, voffA);
            PG8_BAR; PG8_WAIT_L(0); PG8_MMA(1, 0, At, B0); PG8_BAR; PG8_SCHED;
            PG8_STAGE(PG8_SB(1, 1), b3 + hstep, voffB);
            PG8_WAIT_V(6); PG8_BAR; PG8_MMA(1, 1, At, B1); PG8_BAR;
            }
        }
        if constexpr (ALIGN_EPI) { if (wr == 0) PG8_BAR; }
        if constexpr (!Epi::AFTER_DRAIN) { E(acc, cur, wr, wc, fr, fq); S.done(cur); }
        if (!has_next) break;
#pragma unroll
        for (int a = 0; a < 2; ++a)
#pragma unroll
            for (int b = 0; b < 2; ++b)
#pragma unroll
                for (int m = 0; m < 4; ++m)
#pragma unroll
                    for (int n = 0; n < 2; ++n) acc[a][b][m][n] = (f32x4){0.f, 0.f, 0.f, 0.f};
        cur = nxt; cA = nA; cB = nB; ++ui;
        if constexpr (ALIGN_EPI) { if (wr == 1) PG8_BAR; }
    }
    PG8_WAIT_V(0);
    if constexpr (!ALIGN_EPI) { if (wr == 0) PG8_BAR; }
    PG8_BAR;
    if constexpr (Epi::AFTER_DRAIN) { E.fused(acc, cur, wr, wc, fr, fq, lds, wid, lane); S.done(cur); }
#undef PG8_SA
#undef PG8_SB
#undef PG8_STAGE
#undef PG8_LDA
#undef PG8_LDB
#undef PG8_MMA
#undef PG8_WAIT_V
#undef PG8_WAIT_L
#undef PG8_BAR
#undef PG8_SCHED
}
}
namespace att {
using bf16 = __hip_bfloat16;
typedef short bf16x8 __attribute__((ext_vector_type(8)));
typedef short s16x4 __attribute__((ext_vector_type(4)));
typedef float f32x16 __attribute__((ext_vector_type(16)));
typedef float f32x4 __attribute__((ext_vector_type(4)));
typedef unsigned u32x4 __attribute__((ext_vector_type(4)));
constexpr int D = 128, NW = 8, QBLK = 32, KVBLK = 64, QB = NW * QBLK;
constexpr int SHM_V = KVBLK * D * 2, SHM_K = KVBLK * D * 2;
constexpr int OFF_WS = 2 * SHM_V + 2 * SHM_K;
constexpr int OFF_CK = OFF_WS + NW * 64 * 4;
constexpr int OFF_BT = OFF_CK + 512;
constexpr int LDS_BYTES = OFF_BT + 8 * 128 * 4;
constexpr int LDQ = 6144;
constexpr float THR2 = 11.5f;
constexpr float LOG2E = 1.4426950408889634f;
constexpr unsigned WBIG = 1u << 30;

#define KSWZ(row, colB) ((row) * 256 + ((colB) ^ (((row) & 7) << 4)))
#define SBAR() __builtin_amdgcn_sched_barrier(0)
__device__ __forceinline__ int v_st(int k, int c) { const int kk = (k & ~0xC) | ((k & 4) << 1) | ((k & 8) >> 1); return ((kk >> 3) * 4 + (c >> 5)) * 512 + ((kk & 7) * 32 + (c & 31)) * 2; }
__device__ __forceinline__ int v_rd_base(int lane) { return ((lane & 3) << 3) | (((lane >> 2) & 3) << 6) | (((lane >> 4) & 1) << 5) | (((lane >> 5) & 1) << 8); }
constexpr int v_rd_off(int d0, int ks, int half) { return d0 * 512 + ks * 4096 + half * 2048; }
__device__ __forceinline__ int crow(int r, int hi) { return (r & 3) + 8 * (r >> 2) + 4 * hi; }
__device__ __forceinline__ unsigned cvtpk(float lo, float hi) { unsigned r; asm volatile("v_cvt_pk_bf16_f32 %0, %1, %2" : "=v"(r) : "v"(lo), "v"(hi)); return r; }
__device__ __forceinline__ bf16x8 load8(const bf16* p) { return *reinterpret_cast<const bf16x8*>(p); }
__device__ __forceinline__ void mask_tile(f32x16& p0, f32x16& p1, int dq, unsigned W) {
    const float NEG = -__builtin_inff();
#pragma unroll
    for (int r = 0; r < 16; ++r) {
        const int c = (r & 3) + 8 * (r >> 2);
        if ((unsigned)(dq - c) >= W) p0[r] = NEG;
        if ((unsigned)(dq - c - 32) >= W) p1[r] = NEG;
    }
}
__device__ __forceinline__ void partialSM(f32x16& p0, f32x16& p1, float& m_reg, float& mn, float& alpha) {
    float mx0 = fmaxf(p0[0], p1[0]), mx1 = fmaxf(p0[1], p1[1]), mx2 = fmaxf(p0[2], p1[2]), mx3 = fmaxf(p0[3], p1[3]);
    for (int r = 4; r < 16; r += 4) { mx0 = fmaxf(mx0, fmaxf(p0[r], p1[r])); mx1 = fmaxf(mx1, fmaxf(p0[r + 1], p1[r + 1])); mx2 = fmaxf(mx2, fmaxf(p0[r + 2], p1[r + 2])); mx3 = fmaxf(mx3, fmaxf(p0[r + 3], p1[r + 3])); }
    float pmax = fmaxf(fmaxf(mx0, mx1), fmaxf(mx2, mx3));
    { auto rr = __builtin_amdgcn_permlane32_swap(__float_as_uint(pmax), __float_as_uint(pmax), false, false);
      pmax = fmaxf(__uint_as_float(rr[0]), __uint_as_float(rr[1])); }
    if (__builtin_expect(__all((pmax - m_reg) <= THR2), 1)) { mn = m_reg; alpha = 1.f; }
    else { mn = fmaxf(m_reg, pmax); alpha = __builtin_amdgcn_exp2f(m_reg - mn); m_reg = mn; }
    for (int r = 0; r < 16; ++r) p0[r] = p0[r] - mn; for (int r = 0; r < 16; ++r) p1[r] = p1[r] - mn;
    for (int r = 0; r < 16; ++r) p0[r] = __builtin_amdgcn_exp2f(p0[r]);
}
__device__ __forceinline__ void finishSM(f32x16& p0, f32x16& p1, float alpha, float& l_reg, bf16x8& pa0, bf16x8& pa1, bf16x8& pa2, bf16x8& pa3) {
    for (int r = 0; r < 16; ++r) p1[r] = __builtin_amdgcn_exp2f(p1[r]);
    float ps0 = p0[0] + p1[0], ps1 = p0[1] + p1[1], ps2 = p0[2] + p1[2], ps3 = p0[3] + p1[3];
    for (int r = 4; r < 16; r += 4) { ps0 += p0[r] + p1[r]; ps1 += p0[r + 1] + p1[r + 1]; ps2 += p0[r + 2] + p1[r + 2]; ps3 += p0[r + 3] + p1[r + 3]; }
    float ps = (ps0 + ps1) + (ps2 + ps3);
    { auto rr = __builtin_amdgcn_permlane32_swap(__float_as_uint(ps), __float_as_uint(ps), false, false);
      ps = __uint_as_float(rr[0]) + __uint_as_float(rr[1]); }
    l_reg = l_reg * alpha + ps;
#define PK4(P, B_, OUT) do { unsigned a0 = cvtpk(P[B_+0], P[B_+1]), a1 = cvtpk(P[B_+2], P[B_+3]);                          \
        unsigned b0 = cvtpk(P[B_+4], P[B_+5]), b1 = cvtpk(P[B_+6], P[B_+7]);                                             \
        auto r0 = __builtin_amdgcn_permlane32_swap(a0, b0, false, false); auto r1 = __builtin_amdgcn_permlane32_swap(a1, b1, false, false); \
        u32x4 w = {r0[0], r1[0], r0[1], r1[1]}; OUT = *reinterpret_cast<bf16x8*>(&w); } while (0)
    PK4(p0, 0, pa0); PK4(p0, 8, pa1); PK4(p1, 0, pa2); PK4(p1, 8, pa3);
#undef PK4
}
template <int KB, int MODE>
__device__ __forceinline__ void qkt(f32x16& p0, f32x16& p1, const char* K_lds, const char* lds, int r32, int hi, const bf16x8* qr, bool near, int dq, int bt) {
    if constexpr (MODE == 1) {
        const f32x4* cp = (const f32x4*)(lds + OFF_CK + KB * 256 + hi * 16);
#pragma unroll
        for (int i = 0; i < 4; ++i) { const f32x4 a = cp[2 * i], b = cp[2 * i + 8];
            p0[4 * i] = a[0]; p0[4 * i + 1] = a[1]; p0[4 * i + 2] = a[2]; p0[4 * i + 3] = a[3];
            p1[4 * i] = b[0]; p1[4 * i + 1] = b[1]; p1[4 * i + 2] = b[2]; p1[4 * i + 3] = b[3]; }
    } else {
        if (near) { const float* btp = (const float*)(lds + bt);
#pragma unroll
            for (int r = 0; r < 16; ++r) { const int c = (r & 3) + 8 * (r >> 2); int d0 = dq - c, d1 = dq - c - 32;
                d0 = d0 < 0 ? 0 : (d0 > 127 ? 127 : d0); d1 = d1 < 0 ? 0 : (d1 > 127 ? 127 : d1);
                p0[r] = btp[d0]; p1[r] = btp[d1]; } }
        else { p0 = f32x16{}; p1 = f32x16{}; }
    }
    const char* kb[4];
#pragma unroll
    for (int dd = 0; dd < 4; ++dd) kb[dd] = K_lds + KB * SHM_K + KSWZ(r32, (dd * 16 + hi * 8) * 2);
#pragma unroll
    for (int d0 = 0; d0 < 8; ++d0) { const char* a = kb[d0 & 3] + (d0 >> 2) * 128;
        bf16x8 b0 = *reinterpret_cast<const bf16x8*>(a);
        bf16x8 b1 = *reinterpret_cast<const bf16x8*>(a + 32 * 256);
        p0 = __builtin_amdgcn_mfma_f32_32x32x16_bf16(b0, qr[d0], p0, 0, 0, 0);
        p1 = __builtin_amdgcn_mfma_f32_32x32x16_bf16(b1, qr[d0], p1, 0, 0, 0); }
}
template <int VB>
__device__ __forceinline__ void pv_tile(f32x16* o, int vb0, bf16x8 pa0, bf16x8 pa1, bf16x8 pa2, bf16x8 pa3) {
#define TRRD(dst, off) asm volatile("ds_read_b64_tr_b16 %0, %1 offset:%2" : "=&v"(dst) : "v"(vb0), "i"(off) : "memory")
#define PV_D0(d0) do { s16x4 l0, l1, l2, l3, h0, h1, h2, h3; constexpr int b_ = VB * SHM_V + v_rd_off(d0, 0, 0); \
        TRRD(l0, b_); TRRD(h0, b_ + 2048); TRRD(l1, b_ + 4096); TRRD(h1, b_ + 6144); TRRD(l2, b_ + 8192); TRRD(h2, b_ + 10240); TRRD(l3, b_ + 12288); TRRD(h3, b_ + 14336); \
        asm volatile("s_waitcnt lgkmcnt(0)" ::: "memory"); SBAR();   \
        o[d0] = __builtin_amdgcn_mfma_f32_32x32x16_bf16(pa0, (bf16x8){l0[0], l0[1], l0[2], l0[3], h0[0], h0[1], h0[2], h0[3]}, o[d0], 0, 0, 0);   \
        o[d0] = __builtin_amdgcn_mfma_f32_32x32x16_bf16(pa1, (bf16x8){l1[0], l1[1], l1[2], l1[3], h1[0], h1[1], h1[2], h1[3]}, o[d0], 0, 0, 0);   \
        o[d0] = __builtin_amdgcn_mfma_f32_32x32x16_bf16(pa2, (bf16x8){l2[0], l2[1], l2[2], l2[3], h2[0], h2[1], h2[2], h2[3]}, o[d0], 0, 0, 0);   \
        o[d0] = __builtin_amdgcn_mfma_f32_32x32x16_bf16(pa3, (bf16x8){l3[0], l3[1], l3[2], l3[3], h3[0], h3[1], h3[2], h3[3]}, o[d0], 0, 0, 0); } while (0)
    PV_D0(0); PV_D0(1); PV_D0(2); PV_D0(3);
#undef PV_D0
#undef TRRD
}

struct BlockRef { const bf16* Q; const bf16* K; const bf16* V; bf16* O; const float* C; int P0; int bt; int jlo; };
struct Seam { bf16x8 qr[8]; bf16x8 st_v0, st_v1, st_k0, st_k1; float st_c; };
#define ROW(p, k0, rr) ((p) + (unsigned)(((k0) + (rr)) * LDQ + sc))
#define VMW() asm volatile("s_waitcnt vmcnt(0)" ::: "memory")
#define VMWN(n) asm volatile("s_waitcnt vmcnt(%0)" :: "i"(n) : "memory")
#define SLOAD_H(Kp, Vp, Cp, k0) do { S.st_v0 = load8(ROW(Vp, k0, sr)); S.st_v1 = load8(ROW(Vp, k0, 32 + sr));              \
                         S.st_k0 = load8(ROW(Kp, k0, sr)); S.st_k1 = load8(ROW(Kp, k0, 32 + sr));                        \
                         if (MODE == 1 && wid == 0) S.st_c = (Cp)[(k0) + lane]; } while (0)
#define SWRITE_HK(bf, cr) do { *(bf16x8*)(K_lds + (bf) * SHM_K + kws) = S.st_k0; *(bf16x8*)(K_lds + (bf) * SHM_K + kws + 32 * 256) = S.st_k1; \
                         if (MODE == 1 && wid == 0) ((float*)(lds + OFF_CK))[(bf) * 64 + lane] = ((cr) - S.st_c) * LOG2E; } while (0)
#define SWRITE_HV(bf) do { *(bf16x8*)(V_lds + (bf) * SHM_V + vst0) = S.st_v0; *(bf16x8*)(V_lds + (bf) * SHM_V + vst0 + 8192) = S.st_v1; } while (0)
#define SWRITE_H(bf, cr) do { SWRITE_HV(bf); SWRITE_HK(bf, cr); } while (0)
template <int MODE>
__device__ __forceinline__ void attn_prime(const BlockRef& cur, char* lds, Seam& S) {
    const int tid = threadIdx.x, wid = __builtin_amdgcn_readfirstlane(tid >> 6), lane = tid & 63, r32 = lane & 31, hi = lane >> 5;
    const int sr = tid >> 4, sc = (tid & 15) * 8, kws = KSWZ(sr, sc * 2); char* K_lds = lds + 2 * SHM_V;
    float cref = 0.f; if (MODE == 1) cref = cur.C[cur.P0];
    for (int d0 = 0; d0 < 8; ++d0) S.qr[d0] = load8(cur.Q + (size_t)(wid * QBLK + r32) * LDQ + d0 * 16 + hi * 8);
    SLOAD_H(cur.K, cur.V, cur.C, cur.jlo * KVBLK); VMW(); SWRITE_HK(0, cref);
    __syncthreads();
}
template <int MODE, int LDO>
__device__ __forceinline__ void attn_block(const BlockRef& cur, const BlockRef& nxt, char* lds, Seam& S) {
    const int tid = threadIdx.x, wid = __builtin_amdgcn_readfirstlane(tid >> 6), lane = tid & 63, r32 = lane & 31, hi = lane >> 5;
    const int j_lo = cur.jlo, NT = (cur.P0 + QB - 1) / KVBLK + 1 - j_lo;
    const int kbn = nxt.jlo * KVBLK;
    const int qlo = cur.P0 + wid * QBLK, qm = qlo + r32 - 4 * hi;
    char* V_lds = lds; char* K_lds = lds + 2 * SHM_V;
    float* ws = (float*)(lds + OFF_WS) + wid * 64; float* li_l = ws, * al_l = ws + 32;
    float m_reg = -1e30f, l_reg = 0; f32x16 o[4] = {};
    const int sr = tid >> 4, sc = (tid & 15) * 8, vst0 = v_st(sr, sc), kws = KSWZ(sr, sc * 2);
    const int vb0 = (int)(uintptr_t)V_lds + v_rd_base(lane);
    const bf16* Kh = cur.K; const bf16* Vh = cur.V; const float* Ch = cur.C;
    float cref = 0.f, crefn = 0.f; if (MODE == 1) { cref = cur.C[cur.P0]; crefn = nxt.C[nxt.P0]; }
    const int bt = cur.bt;
#define RESC(a) do { if (__any((a) < 1.f)) { if (hi == 0) al_l[r32] = (a); asm volatile("s_waitcnt lgkmcnt(0)" ::: "memory");              \
                     for (int d_ = 0; d_ < 4; ++d_) for (int r = 0; r < 16; ++r) o[d_][r] *= al_l[crow(r, hi)]; } } while (0)
#define KBASE(t) ((j_lo + (t)) * KVBLK)
#define NEAR(t) (KBASE(t) + 191 > qlo)
#define MASKT(P0_, P1_, t) do { const int kb_ = KBASE(t); if (kb_ + KVBLK - 1 > qlo) mask_tile(P0_, P1_, qm - kb_, WBIG); } while (0)
#define QKT(KB, PX0, PX1, t) qkt<KB, MODE>(PX0, PX1, K_lds, lds, r32, hi, S.qr, NEAR(t), qm - KBASE(t), bt)
    constexpr int NQL = 8;
#define SEAM_K0() do { VMWN(NQL); SWRITE_HK(0, crefn); SBAR(); } while (0)
    f32x16 pA0, pA1, pB0, pB1; float mnA, mnB, alA, alB; bf16x8 pa0, pa1, pa2, pa3;
    SWRITE_HV(0); SBAR();
    if (NT > 1) { SLOAD_H(Kh, Vh, Ch, KBASE(1)); }
    SBAR(); QKT(0, pA0, pA1, 0);
    MASKT(pA0, pA1, 0); partialSM(pA0, pA1, m_reg, mnA, alA);
    if (NT > 1) { VMW(); SWRITE_H(1, cref); }
    __syncthreads();
#define HALF_STEP(PX0, PX1, mnX, alX, PY0, PY1, alY, t, KB, VB, SB) do {                                                      \
        SBAR(); QKT(KB, PX0, PX1, t);                                                                                         \
        finishSM(PY0, PY1, alY, l_reg, pa0, pa1, pa2, pa3); SBAR();                                                           \
        if ((t) + 1 < NT) { SLOAD_H(Kh, Vh, Ch, KBASE((t) + 1)); SBAR(); }                                                    \
        pv_tile<VB>(o, vb0, pa0, pa1, pa2, pa3); MASKT(PX0, PX1, (t)); partialSM(PX0, PX1, m_reg, mnX, alX);                  \
        __syncthreads();                                                                                                      \
        if ((t) + 1 < NT) { VMW(); SWRITE_H(SB, cref); }                                                                      \
        RESC(alX); __syncthreads(); } while (0)
    for (int t = 1; t + 1 < NT; t += 2) {
        HALF_STEP(pB0, pB1, mnB, alB, pA0, pA1, alA, t, 1, 0, 0);
        HALF_STEP(pA0, pA1, mnA, alA, pB0, pB1, alB, t + 1, 0, 1, 1);
    }
    const bool even = (NT & 1) == 0;
    if (even) { SBAR(); QKT(1, pB0, pB1, NT - 1); SBAR(); }
    SLOAD_H(nxt.K, nxt.V, nxt.C, kbn); SBAR();
#pragma unroll
    for (int d0 = 0; d0 < 8; ++d0) S.qr[d0] = load8(nxt.Q + (size_t)(wid * QBLK + r32) * LDQ + d0 * 16 + hi * 8);
    SBAR();
    finishSM(pA0, pA1, alA, l_reg, pa0, pa1, pa2, pa3); SBAR();
    pv_tile<0>(o, vb0, pa0, pa1, pa2, pa3);
    if (even) { MASKT(pB0, pB1, NT - 1); partialSM(pB0, pB1, m_reg, mnB, alB); __syncthreads(); RESC(alB);
        finishSM(pB0, pB1, alB, l_reg, pa0, pa1, pa2, pa3); SBAR(); pv_tile<1>(o, vb0, pa0, pa1, pa2, pa3); }
    SBAR(); SEAM_K0();
    if (hi == 0) li_l[r32] = l_reg; asm volatile("s_waitcnt lgkmcnt(0)" ::: "memory");
    float rli[16];
#pragma unroll
    for (int r = 0; r < 16; ++r) rli[r] = __builtin_amdgcn_rcpf(li_l[crow(r, hi)]);
    int lane2 = lane; asm volatile("" : "+v"(lane2));
    const int r32b = lane2 & 31, hib = lane2 >> 5;
    bf16* Ow = cur.O + (size_t)(wid * QBLK) * LDO + (unsigned)(hib * 4 * LDO + r32b);
#pragma unroll
    for (int r = 0; r < 16; ++r) { const int orow = (r & 3) + 8 * (r >> 2);
#pragma unroll
        for (int d0 = 0; d0 < 4; ++d0) { const float v = o[d0][r] * rli[r];
            const float vn = __shfl_xor(v, 1);
            if ((r32b & 1) == 0) *(unsigned*)(Ow + orow * LDO + d0 * 32) = cvtpk(v, vn); } }
    __syncthreads();
#undef RESC
#undef KBASE
#undef NEAR
#undef MASKT
#undef QKT
#undef SEAM_K0
#undef HALF_STEP
}
constexpr int D_V = 0, D_K = 65536, D_PS = 98304, D_PSW = 4608, D_SLOT = 4 * D_PSW, D_BT = D_PS + 2 * D_SLOT, D_LDS_BYTES = D_BT + 4096;
template <int KB>
__device__ __forceinline__ void qkt_ref(f32x16& p0, f32x16& p1, const char* K_lds, const char* lds, int r32, int hi, const bf16x8* qr, bool near, int dq, int bt, const f32x16& negm, float mhat) {
    const char* kb[4];
#pragma unroll
    for (int dd = 0; dd < 4; ++dd) kb[dd] = K_lds + KB * SHM_K + KSWZ(r32, (dd * 16 + hi * 8) * 2);
    if (near) { const float* btp = (const float*)(lds + bt);
#pragma unroll
        for (int r = 0; r < 16; ++r) { const int c = (r & 3) + 8 * (r >> 2); int d0 = dq - c, d1 = dq - c - 32;
            d0 = d0 < 0 ? 0 : (d0 > 127 ? 127 : d0); d1 = d1 < 0 ? 0 : (d1 > 127 ? 127 : d1);
            p0[r] = btp[d0] - mhat; p1[r] = btp[d1] - mhat; }
#pragma unroll
        for (int d0 = 0; d0 < 8; ++d0) { const char* a = kb[d0 & 3] + (d0 >> 2) * 128;
            bf16x8 b0 = *reinterpret_cast<const bf16x8*>(a); bf16x8 b1 = *reinterpret_cast<const bf16x8*>(a + 32 * 256);
            p0 = __builtin_amdgcn_mfma_f32_32x32x16_bf16(b0, qr[d0], p0, 0, 0, 0); p1 = __builtin_amdgcn_mfma_f32_32x32x16_bf16(b1, qr[d0], p1, 0, 0, 0); }
    } else {
#pragma unroll
        for (int d0 = 0; d0 < 8; ++d0) { const char* a = kb[d0 & 3] + (d0 >> 2) * 128;
            bf16x8 b0 = *reinterpret_cast<const bf16x8*>(a); bf16x8 b1 = *reinterpret_cast<const bf16x8*>(a + 32 * 256);
            if (d0 == 0) { p0 = __builtin_amdgcn_mfma_f32_32x32x16_bf16(b0, qr[0], negm, 0, 0, 0); p1 = __builtin_amdgcn_mfma_f32_32x32x16_bf16(b1, qr[0], negm, 0, 0, 0); }
            else { p0 = __builtin_amdgcn_mfma_f32_32x32x16_bf16(b0, qr[d0], p0, 0, 0, 0); p1 = __builtin_amdgcn_mfma_f32_32x32x16_bf16(b1, qr[d0], p1, 0, 0, 0); } }
    }
}
#define D_MX3(a, b, c) __builtin_fmaxf(__builtin_fmaxf((a), (b)), (c))
template <bool FIRST>
__device__ __forceinline__ void sm_head(f32x16& p0, f32x16& p1, float& mhat, f32x16& negm, float& alpha, bool& rs) {
    float a = D_MX3(p0[0], p0[1], p1[0]), b = D_MX3(p0[2], p0[3], p1[1]); a = D_MX3(a, p1[2], p1[3]);
#pragma unroll
    for (int r = 4; r < 16; r += 4) { a = D_MX3(a, p0[r], p0[r + 1]); b = D_MX3(b, p0[r + 2], p0[r + 3]); a = D_MX3(a, p1[r], p1[r + 1]); b = D_MX3(b, p1[r + 2], p1[r + 3]); }
    float rm = __builtin_fmaxf(a, b);
    { auto rr = __builtin_amdgcn_permlane32_swap(__float_as_uint(rm), __float_as_uint(rm), false, false); rm = __builtin_fmaxf(__uint_as_float(rr[0]), __uint_as_float(rr[1])); }
    alpha = 1.f; rs = false;
    if (FIRST || __any(rm > THR2)) {
        const float dl = FIRST ? rm : __builtin_fmaxf(rm, 0.f);
        mhat += dl;
#pragma unroll
        for (int r = 0; r < 16; ++r) { p0[r] -= dl; p1[r] -= dl; }
#pragma unroll
        for (int r = 0; r < 16; ++r) negm[r] = -mhat;
        if (!FIRST) { alpha = __builtin_amdgcn_exp2f(-dl); rs = true; }
    }
#pragma unroll
    for (int r = 0; r < 16; ++r) p0[r] = __builtin_amdgcn_exp2f(p0[r]);
}
__device__ __forceinline__ void sm_tail(f32x16& p0, f32x16& p1, bf16x8& pa0, bf16x8& pa1, bf16x8& pa2, bf16x8& pa3) {
#pragma unroll
    for (int r = 0; r < 16; ++r) p1[r] = __builtin_amdgcn_exp2f(p1[r]);
#define PK4(P, B_, OUT) do { unsigned a0 = cvtpk(P[B_+0], P[B_+1]), a1 = cvtpk(P[B_+2], P[B_+3]);                          \
        unsigned b0 = cvtpk(P[B_+4], P[B_+5]), b1 = cvtpk(P[B_+6], P[B_+7]);                                             \
        auto r0 = __builtin_amdgcn_permlane32_swap(a0, b0, false, false); auto r1 = __builtin_amdgcn_permlane32_swap(a1, b1, false, false); \
        u32x4 w = {r0[0], r1[0], r0[1], r1[1]}; OUT = *reinterpret_cast<bf16x8*>(&w); } while (0)
    PK4(p0, 0, pa0); PK4(p0, 8, pa1); PK4(p1, 0, pa2); PK4(p1, 8, pa3);
#undef PK4
}
__device__ __forceinline__ void glds16s(const void* gbase, unsigned voff, unsigned lds_dst) { unsigned keep;
    asm volatile("s_mov_b32 %0, m0\n\ts_mov_b32 m0, %3\n\ts_nop 0\n\tglobal_load_lds_dwordx4 %1, %2\n\ts_mov_b32 m0, %0" : "=&s"(keep) : "v"(voff), "s"(gbase), "s"(lds_dst) : "memory"); }
struct DUnit { const bf16* Q; const bf16* K; const bf16* V; bf16* O; int P0; int bt; };
#define D_BAR() asm volatile("s_waitcnt lgkmcnt(0)\n\ts_barrier" ::: "memory")
#define D_VMW() asm volatile("s_waitcnt vmcnt(0)" ::: "memory")
#define D_LGKM(n) asm volatile("s_waitcnt lgkmcnt(" #n ")" ::: "memory")
#define D_TRRD(dst, off) asm volatile("ds_read_b64_tr_b16 %0, %1 offset:%2" : "=&v"(dst) : "v"(vb0), "i"(off) : "memory")
#define D_RD8(S, d0, VB) do { constexpr int b_ = D_V + (VB) * 32768 + ((d0) >> 2) * 16384 + ((d0) & 3) * 512; \
        D_TRRD(S##l0, b_); D_TRRD(S##h0, b_ + 2048); D_TRRD(S##l1, b_ + 4096); D_TRRD(S##h1, b_ + 6144); D_TRRD(S##l2, b_ + 8192); D_TRRD(S##h2, b_ + 10240); D_TRRD(S##l3, b_ + 12288); D_TRRD(S##h3, b_ + 14336); } while (0)
#define D_MM4(OACC, S) do { \
        OACC = __builtin_amdgcn_mfma_f32_32x32x16_bf16(pa0, (bf16x8){S##l0[0], S##l0[1], S##l0[2], S##l0[3], S##h0[0], S##h0[1], S##h0[2], S##h0[3]}, OACC, 0, 0, 0);   \
        OACC = __builtin_amdgcn_mfma_f32_32x32x16_bf16(pa1, (bf16x8){S##l1[0], S##l1[1], S##l1[2], S##l1[3], S##h1[0], S##h1[1], S##h1[2], S##h1[3]}, OACC, 0, 0, 0);   \
        OACC = __builtin_amdgcn_mfma_f32_32x32x16_bf16(pa2, (bf16x8){S##l2[0], S##l2[1], S##l2[2], S##l2[3], S##h2[0], S##h2[1], S##h2[2], S##h2[3]}, OACC, 0, 0, 0);   \
        OACC = __builtin_amdgcn_mfma_f32_32x32x16_bf16(pa3, (bf16x8){S##l3[0], S##l3[1], S##l3[2], S##l3[3], S##h3[0], S##h3[1], S##h3[2], S##h3[3]}, OACC, 0, 0, 0); } while (0)
#define D_STORE_O(OACC, colb) do { _Pragma("unroll") for (int r = 0; r < 16; ++r) { const int orow = (r & 3) + 8 * (r >> 2); const float v = OACC[r] * rli[r]; const float vn = __shfl_xor(v, 1); \
        if ((r32b & 1) == 0) *(unsigned*)(Ow + orow * 4096 + (colb)) = cvtpk(v, vn); } } while (0)

#define D_DMA_SETUP(w4)                                                     \
    const unsigned ldsb = (unsigned)(uintptr_t)lds;                                                                            \
    const int dw4 = (w4);                                                                                                      \
    const int krow = 4 * dw4 + (lane >> 4);                                                                                    \
    const unsigned koff = (unsigned)((krow * LDQ + (((lane & 15) ^ (krow & 7)) * 8)) * 2);                                     \
    const int kkl = (lane & 31) >> 2, vsub = lane >> 5, vj = dw4 & 1, ve = dw4 >> 1;                                            \
    const unsigned voff = (unsigned)((((8 * (kkl >> 2) + (kkl & 3)) * LDQ) + ve * 128 + (2 * vj + vsub) * 32 + (lane & 3) * 8) * 2); \
    const char* Kb = (const char*)u.K; const char* Vb = (const char*)u.V;
#define D_DMAK(t, buf) do { _Pragma("unroll") for (int i_ = 0; i_ < 4; ++i_) \
        glds16s(Kb + (size_t)((t) * KVBLK + 16 * i_) * (LDQ * 2), koff, (unsigned)__builtin_amdgcn_readfirstlane(ldsb + D_K + (buf) * 16384 + (dw4 + 4 * i_) * 1024)); } while (0)
#define D_DMAV(t, buf) do { _Pragma("unroll") for (int q_ = 0; q_ < 8; ++q_) \
        glds16s(Vb + (size_t)((t) * KVBLK + 16 * (q_ >> 1) + 4 * (q_ & 1)) * (LDQ * 2), voff, (unsigned)__builtin_amdgcn_readfirstlane(ldsb + D_V + (buf) * 32768 + ve * 16384 + (q_ * 2 + vj) * 1024)); } while (0)
__device__ __forceinline__ void diff_producer(const DUnit& u, char* lds, int tid) {
    const int lane = tid & 63, wq = __builtin_amdgcn_readfirstlane(tid >> 6), r32 = lane & 31, hi = lane >> 5;
    const int NT = (u.P0 + 127) / KVBLK + 1;
    const int qlo = u.P0 + wq * QBLK, qm = qlo + r32 - 4 * hi;
    const char* K_lds = lds + D_K;
    char* psb = lds + D_PS + wq * D_PSW + lane * 16;
    float* psf = (float*)(lds + D_PS + wq * D_PSW + 4096);
    const int bt = u.bt;
    bf16x8 qr[8];
    D_DMA_SETUP(wq);
#pragma unroll
    for (int d0 = 0; d0 < 8; ++d0) qr[d0] = load8(u.Q + (unsigned)((wq * QBLK + r32) * LDQ + d0 * 16 + hi * 8));
    D_DMAK(0, 0); D_VMW();
    __builtin_amdgcn_s_setprio(2);
    D_BAR();
    D_DMAK(1, 1);
    float mhat = 0.f; f32x16 negm = {};
    f32x16 pA0, pA1, pB0, pB1; float alA, alB; bool rsA, rsB = false; bf16x8 pa0, pa1, pa2, pa3;
#define D_NEAR(t) ((t) * KVBLK + 191 > qlo)
#define D_MASKT(P0_, P1_, t) do { const int kb_ = (t) * KVBLK; if (kb_ + KVBLK - 1 > qlo) mask_tile(P0_, P1_, qm - kb_, WBIG); } while (0)
#define D_QKT(KB, PX0, PX1, t) qkt_ref<KB>(PX0, PX1, K_lds, lds, r32, hi, qr, D_NEAR(t), qm - (t) * KVBLK, bt, negm, mhat)
    SBAR(); D_QKT(0, pA0, pA1, 0); D_MASKT(pA0, pA1, 0); sm_head<true>(pA0, pA1, mhat, negm, alA, rsA);
    D_VMW();
    D_BAR();
#define D_PSTEP(PX0, PX1, alX, rsX, PY0, PY1, alY, rsY, t, KBX, SLOT) do {                                                     \
        SBAR(); if ((t) + 1 < NT) D_QKT(KBX, PX0, PX1, (t) + 1);                                                               \
        if ((t) + 2 < NT) D_DMAK((t) + 2, SLOT);                                   \
        sm_tail(PY0, PY1, pa0, pa1, pa2, pa3); SBAR();                                                                         \
        { char* s_ = psb + (SLOT) * D_SLOT; *(bf16x8*)(s_) = pa0; *(bf16x8*)(s_ + 1024) = pa1; *(bf16x8*)(s_ + 2048) = pa2; *(bf16x8*)(s_ + 3072) = pa3; \
          float* f_ = psf + (SLOT) * (D_SLOT / 4); if (hi == 0) { f_[r32] = (alY); } if (lane == 0) ((int*)f_)[32] = (rsY) ? 1 : 0; } \
        if ((t) + 1 < NT) { D_MASKT(PX0, PX1, (t) + 1); sm_head<false>(PX0, PX1, mhat, negm, alX, rsX); }                       \
        D_VMW();                                                                                                               \
        D_BAR();                                                                                                               \
    } while (0)
    for (int t = 0; t + 1 < NT; t += 2) {
        D_PSTEP(pB0, pB1, alB, rsB, pA0, pA1, alA, rsA, t, 1, 0);
        D_PSTEP(pA0, pA1, alA, rsA, pB0, pB1, alB, rsB, t + 1, 0, 1);
    }
    D_BAR();
    __builtin_amdgcn_s_setprio(0);
#undef D_PSTEP
#undef D_QKT
#undef D_MASKT
#undef D_NEAR
}
__device__ __forceinline__ void diff_consumer(const DUnit& u, char* lds, int tid) {
    const int lane = tid & 63, wq = __builtin_amdgcn_readfirstlane((tid >> 6) & 3), hi = lane >> 5;
    const int NT = (u.P0 + 127) / KVBLK + 1;
    const float* psf = (const float*)(lds + D_PS + wq * D_PSW + 4096);
    const int psa = (int)(uintptr_t)lds + D_PS + wq * D_PSW + lane * 16;
    const int vb0 = (int)(uintptr_t)lds + v_rd_base(lane);
    D_DMA_SETUP(wq);
    D_BAR();
    f32x16 o0 = {}, o1 = {}, o2 = {}, o3 = {}, o4 = {}, o5 = {}, o6 = {}, o7 = {}, ol = {}; bf16x8 pa0, pa1, pa2, pa3;
    const bf16x8 ones = {0x3F80, 0x3F80, 0x3F80, 0x3F80, 0x3F80, 0x3F80, 0x3F80, 0x3F80};
#define D_MML() do { ol = __builtin_amdgcn_mfma_f32_32x32x16_bf16(pa0, ones, ol, 0, 0, 0); ol = __builtin_amdgcn_mfma_f32_32x32x16_bf16(pa1, ones, ol, 0, 0, 0); \
        ol = __builtin_amdgcn_mfma_f32_32x32x16_bf16(pa2, ones, ol, 0, 0, 0); ol = __builtin_amdgcn_mfma_f32_32x32x16_bf16(pa3, ones, ol, 0, 0, 0); } while (0)
    s16x4 Al0, Al1, Al2, Al3, Ah0, Ah1, Ah2, Ah3, Bl0, Bl1, Bl2, Bl3, Bh0, Bh1, Bh2, Bh3;
    D_VMW();
    D_BAR();
#define D_STAGE_UNUSED(t, SLOT) do { D_VMW(); if ((t) + 2 < NT) D_WRITEK(SLOT); D_WRITEV(SLOT);     \
        if ((t) + 3 < NT) D_LOADK((t) + 3); if ((t) + 1 < NT) D_LOADV((t) + 1); } while (0)
    D_DMAV(0, 0);
    D_VMW();
    D_BAR();
#define D_RDPA(SLOT) do { asm volatile("ds_read_b128 %0, %1 offset:%2" : "=&v"(pa0) : "v"(psa), "i"((SLOT) * D_SLOT) : "memory"); asm volatile("ds_read_b128 %0, %1 offset:%2" : "=&v"(pa1) : "v"(psa), "i"((SLOT) * D_SLOT + 1024) : "memory"); \
        asm volatile("ds_read_b128 %0, %1 offset:%2" : "=&v"(pa2) : "v"(psa), "i"((SLOT) * D_SLOT + 2048) : "memory"); asm volatile("ds_read_b128 %0, %1 offset:%2" : "=&v"(pa3) : "v"(psa), "i"((SLOT) * D_SLOT + 3072) : "memory"); } while (0)
#define D_CPV(VB) do { D_LGKM(0); SBAR();                                        \
        D_MM4(o0, A); D_RD8(A, 2, VB); D_MM4(o1, B); D_RD8(B, 3, VB); D_MML();                                                 \
        D_LGKM(8); SBAR(); D_MM4(o2, A); D_RD8(A, 4, VB);                                                                      \
        D_LGKM(8); SBAR(); D_MM4(o3, B); D_RD8(B, 5, VB);                                                                      \
        D_LGKM(8); SBAR(); D_MM4(o4, A); D_RD8(A, 6, VB);                                                                      \
        D_LGKM(8); SBAR(); D_MM4(o5, B); D_RD8(B, 7, VB);                                                                      \
        D_LGKM(8); SBAR(); D_MM4(o6, A);                                                                                       \
        D_LGKM(0); SBAR(); D_MM4(o7, B); } while (0)
#define D_CRESC(SLOT) do { const float* f_ = psf + (SLOT) * (D_SLOT / 4); if (__builtin_amdgcn_readfirstlane(((const int*)f_)[32]) != 0) { _Pragma("unroll") for (int r = 0; r < 16; ++r) { const float a_ = f_[crow(r, hi)];  \
            o0[r] *= a_; o1[r] *= a_; o2[r] *= a_; o3[r] *= a_; o4[r] *= a_; o5[r] *= a_; o6[r] *= a_; o7[r] *= a_; ol[r] *= a_; } } } while (0)
#define D_CSTEP(t, VB) do { D_RD8(A, 0, VB); if ((t) < NT) { D_DMAV((t), 1 - (VB)); } D_RD8(B, 1, VB); D_RDPA(VB); D_CRESC(VB); D_CPV(VB); D_VMW(); D_BAR(); } while (0)
    for (int t = 1; t < NT; t += 2) {
        D_CSTEP(t, 0);
        D_CSTEP(t + 1, 1);
    }
    {   unsigned short* stg = (unsigned short*)(lds + D_V + wq * 16384);
        const int r32 = lane & 31;
#define D_STG(OACC, colb) do { _Pragma("unroll") for (int r = 0; r < 16; ++r) stg[crow(r, hi) * 256 + (colb) + r32] = (unsigned short)(cvtpk(OACC[r] * __builtin_amdgcn_rcpf(ol[r]), 0.f) & 0xffffu); } while (0)
        D_STG(o0, 0); D_STG(o1, 32); D_STG(o2, 64); D_STG(o3, 96); D_STG(o4, 128); D_STG(o5, 160); D_STG(o6, 192); D_STG(o7, 224);
#undef D_STG
        asm volatile("s_waitcnt lgkmcnt(0)" ::: "memory");
        bf16* Ow = u.O + (unsigned)((wq * QBLK) * 4096);
#pragma unroll
        for (int i = 0; i < 16; ++i) { const int row = 2 * i + (lane >> 5), ch = lane & 31;
            const u32x4 v = *(const u32x4*)(stg + row * 256 + ch * 8); *(u32x4*)(Ow + row * 4096 + ch * 8) = v; }
        asm volatile("s_waitcnt lgkmcnt(0)" ::: "memory");
    }
#undef D_MML
#undef D_CSTEP
#undef D_STAGE_UNUSED
#undef D_CRESC
#undef D_CPV
#undef D_RDPA
}
#undef D_DMA_SETUP
#undef D_DMAK
#undef D_DMAV
#undef D_BAR
#undef D_VMW
#undef D_LGKM
#undef D_TRRD
#undef D_RD8
#undef D_MM4
#undef D_STORE_O
#undef ROW
#undef VMW
#undef VMWN
#undef SLOAD_H
#undef SWRITE_HK
#undef SWRITE_HV
#undef SWRITE_H
#undef KSWZ
#undef SBAR
}
namespace cg = cooperative_groups;
#define LAS __attribute__((address_space(3)))
typedef unsigned short bf16;
typedef unsigned v4u __attribute__((ext_vector_type(4)));
typedef unsigned v2u __attribute__((ext_vector_type(2)));
typedef float f32x4 __attribute__((ext_vector_type(4)));

constexpr int BATCH = 2, SEQ = 16384, DM = 2048, FF = 5632, DEPTH = 2;
constexpr int M = BATCH * SEQ;
constexpr int NQKV = 3 * DM;
constexpr float LN_EPS = 1e-5f;
constexpr float ALPHA = 1.4142135623730951f;
constexpr float QSCALE = 0.08838834764831845f * 1.4426950408889634f;
constexpr int NWAVES = 8, NTHREADS = 512;
constexpr int LDS_BYTES = 147456;

constexpr size_t MiB = 1u << 20;
constexpr size_t WS_WGU1 = 1 * MiB;
constexpr size_t WS_WD1 = WS_WGU1 + 44 * MiB;
constexpr size_t WS_WGU2 = WS_WD1 + 22 * MiB;
constexpr size_t WS_WD2 = WS_WGU2 + 44 * MiB;
constexpr size_t WS_WQKV = WS_WD2 + 22 * MiB;
constexpr size_t WS_WO = WS_WQKV + 24 * MiB;
constexpr size_t WS_XB = WS_WO + 8 * MiB;
constexpr size_t WS_BIG = WS_XB + 128 * MiB;
constexpr size_t WS_OP = WS_BIG + 384 * MiB;
constexpr size_t WS_LF = WS_OP + 256 * MiB;
constexpr size_t WS_C = WS_LF + 2 * MiB;
constexpr size_t WS_NR = WS_C + 2 * MiB;
constexpr size_t WS_CNT = WS_NR + 1 * MiB;
constexpr size_t WS_ST = WS_CNT + 1 * MiB;
constexpr size_t WS_BAR = WS_ST + 1 * MiB;
constexpr size_t WS_END = WS_BAR + 1 * MiB;

__device__ __forceinline__ unsigned f2bf(float f) { unsigned u = __builtin_bit_cast(unsigned, f); return (u + 0x7fffu + ((u >> 16) & 1u)) >> 16; }
__device__ __forceinline__ unsigned pk2(float lo, float hi) { return f2bf(lo) | (f2bf(hi) << 16); }
__device__ __forceinline__ float bf2f(unsigned short b) { return __builtin_bit_cast(float, (unsigned)b << 16); }
__device__ __forceinline__ float wave_sum(float v) {
#pragma unroll
    for (int o = 1; o < 64; o <<= 1) v += __shfl_xor(v, o);
    return v;
}
#define LDS_WAIT() asm volatile("s_waitcnt lgkmcnt(0)" ::: "memory")

__device__ __forceinline__ void transpose_item(const float* W, int K, int N, bf16* WT, int gu, LAS float* scr, int item, int lane) {
    const int nblk = N / 32, kb = item / nblk, nb = item % nblk, k0 = 64 * kb, n0 = 32 * nb;
    const int r0 = gu == 0 ? n0 : ((n0 >> 7) * 256 + (n0 & 127) + (gu == 2 ? 128 : 0));
    float wv[32];
#pragma unroll
    for (int i = 0; i < 32; ++i) { const int kk = 2 * i + (lane >> 5); wv[i] = __builtin_nontemporal_load(&W[(size_t)(k0 + kk) * N + n0 + (lane & 31)]); }
#pragma unroll
    for (int i = 0; i < 32; ++i) { const int kk = 2 * i + (lane >> 5); scr[kk * 33 + (lane & 31)] = wv[i]; }
    LDS_WAIT(); asm volatile("" ::: "memory");
    const int c = lane & 7;
#pragma unroll
    for (int j = 0; j < 4; ++j) { const int n = (lane >> 3) + 8 * j; const LAS float* s = scr + (8 * c) * 33 + n;
        v4u o; o.x = pk2(s[0 * 33], s[1 * 33]); o.y = pk2(s[2 * 33], s[3 * 33]); o.z = pk2(s[4 * 33], s[5 * 33]); o.w = pk2(s[6 * 33], s[7 * 33]);
        *(v4u*)(WT + (size_t)(r0 + n) * K + k0 + 8 * c) = o; }
    LDS_WAIT(); asm volatile("" ::: "memory");
}

#define XB_TMO      128
#define XB_XCNT(j)  (256  + 64 * (j))
#define XB_XSUB(j)  (1280 + 64 * (j))
#define XB_XGEN(j)  (2304 + 64 * (j))
#define XB_TOP      3328
#define XB_TOPGEN   3392
#define XCD_BAR_WORDS 3456
#define XB_SPIN_CAP (1u << 18)

__device__ __forceinline__ unsigned xb_ld(unsigned* p)              { return __hip_atomic_load(p, __ATOMIC_RELAXED, __HIP_MEMORY_SCOPE_AGENT); }
__device__ __forceinline__ unsigned xb_add(unsigned* p, unsigned v) { return __hip_atomic_fetch_add(p, v, __ATOMIC_RELAXED, __HIP_MEMORY_SCOPE_AGENT); }
__device__ __forceinline__ unsigned xb_xcc_id() { return (unsigned)__builtin_amdgcn_s_getreg((3 << 11) | 20) & 0xFu; }
#define XB_SPIN(cond, bar) do { unsigned _sp = 0; while (cond) { __builtin_amdgcn_s_sleep(1); \
    if ((++_sp & 255u) == 0u) { if (xb_ld(&(bar)[XB_TMO])) break; if (_sp > XB_SPIN_CAP) { atomicAdd(&(bar)[XB_TMO], 1u); break; } } } } while (0)

struct XcdBarrier {
    unsigned* bar; unsigned x;
    volatile LAS unsigned* st;
};

__device__ __forceinline__ XcdBarrier xcd_barrier_post(unsigned* bar, volatile LAS unsigned* st) {
    XcdBarrier b; b.bar = bar; b.x = xb_xcc_id(); b.st = st;
    if (threadIdx.x == 0) (void)xb_add(&bar[XB_XCNT(b.x)], 1u);
    return b;
}
__device__ __forceinline__ void xcd_barrier_complete(unsigned* bar, unsigned x, unsigned& nloc, unsigned& nx) {
    const unsigned G = gridDim.x * gridDim.y * gridDim.z;
    unsigned sum, cnt, mine, sp = 0u;
    for (;;) {
        sum = 0u; cnt = 0u; mine = 0u;
#pragma unroll
        for (unsigned j = 0; j < 16; ++j) { const unsigned c = xb_ld(&bar[XB_XCNT(j)]); sum += c; cnt += (c > 0u) ? 1u : 0u; mine = (j == x) ? c : mine; }
        if (sum == G) break;
        __builtin_amdgcn_s_sleep(1);
        if ((++sp & 255u) == 0u) { if (xb_ld(&bar[XB_TMO])) break; if (sp > XB_SPIN_CAP) { atomicAdd(&bar[XB_TMO], 1u); break; } }
    }
    nloc = mine > 0u ? mine : 1u; nx = cnt > 0u ? cnt : 1u;
}

__device__ __forceinline__ void xcd_barrier(const XcdBarrier& b) {
    asm volatile("s_waitcnt vmcnt(0)" ::: "memory");
    __syncthreads();
    if (threadIdx.x == 0) {
        unsigned* bar = b.bar;
        __builtin_amdgcn_s_waitcnt(0);
        unsigned nloc = b.st[0], nx = b.st[1];
        if (nloc == 0u) { xcd_barrier_complete(bar, b.x, nloc, nx); b.st[0] = nloc; b.st[1] = nx; }
        const unsigned old = xb_add(&bar[XB_XSUB(b.x)], 1u);
        const unsigned gen = old / nloc;
        if (old + 1u == (gen + 1u) * nloc) {
            __builtin_amdgcn_fence(__ATOMIC_RELEASE, "agent");
            asm volatile("s_waitcnt vmcnt(0)" ::: "memory");
            const unsigned og = xb_add(&bar[XB_TOP], 1u);
            const unsigned tg = og / nx;
            if (og + 1u == (tg + 1u) * nx) xb_add(&bar[XB_TOPGEN], 1u);
            else XB_SPIN(xb_ld(&bar[XB_TOPGEN]) == tg, bar);
            __builtin_amdgcn_fence(__ATOMIC_ACQUIRE, "agent");
            xb_add(&bar[XB_XGEN(b.x)], 1u);
            asm volatile("s_waitcnt vmcnt(0)" ::: "memory");
        } else {
            XB_SPIN(xb_ld(&bar[XB_XGEN(b.x)]) == gen, bar);
            __builtin_amdgcn_fence(__ATOMIC_ACQUIRE, "agent");
            asm volatile("s_waitcnt vmcnt(0)" ::: "memory");
        }
    }
    __syncthreads();
}


struct Args { const float* in[21]; float* out; unsigned char* ws; int ph_lo, ph_hi; };

template <bool GATE, bool FINAL>
__device__ __forceinline__ void ln_phase(const float* Y, float* X, bf16* XB, float* ST, const float* g, const float* b, const float* wf, const float* bfv, float* LF,
                                         LAS unsigned char* lds, int gw, int NGW, int tid, int lane) {
    LAS float* wT = (LAS float*)lds;
    if (GATE) {
        for (int idx = tid; idx < DM * 16; idx += NTHREADS) { const int k = idx >> 4, hh = idx & 15; wT[hh * DM + k] = wf[idx]; }
        __syncthreads();
    }
    f32x4 gv[8], bv[8];
#pragma unroll
    for (int j = 0; j < 8; ++j) { gv[j] = ((const f32x4*)g)[64 * j + lane]; bv[j] = ((const f32x4*)b)[64 * j + lane]; }
    f32x4 nx[8];
    if (gw < M) { const f32x4* yr = (const f32x4*)(Y + (size_t)gw * DM) + lane;
#pragma unroll
        for (int j = 0; j < 8; ++j) nx[j] = yr[64 * j]; }
    for (int m = gw; m < M; m += NGW) {
        f32x4 v[8]; float s = 0.f;
#pragma unroll
        for (int j = 0; j < 8; ++j) { v[j] = nx[j]; s += (v[j].x + v[j].y) + (v[j].z + v[j].w); }
        if (m + NGW < M) { const f32x4* yr = (const f32x4*)(Y + (size_t)(m + NGW) * DM) + lane;
#pragma unroll
            for (int j = 0; j < 8; ++j) nx[j] = yr[64 * j]; }
        const float mean = wave_sum(s) * (1.f / DM); float s2 = 0.f;
#pragma unroll
        for (int j = 0; j < 8; ++j) { v[j] = v[j] - mean; s2 += (v[j].x * v[j].x + v[j].y * v[j].y) + (v[j].z * v[j].z + v[j].w * v[j].w); }
        const float rstd = 1.f / sqrtf(wave_sum(s2) * (1.f / DM) + LN_EPS);
        f32x4* xr = (f32x4*)(X + (size_t)m * DM) + lane;
        v2u* o8 = (v2u*)(XB + (size_t)m * DM) + lane;
#pragma unroll
        for (int j = 0; j < 8; ++j) { v[j] = v[j] * rstd * gv[j] + bv[j];
            if (FINAL) xr[64 * j] = v[j];
            else { v2u w; w.x = pk2(v[j].x, v[j].y); w.y = pk2(v[j].z, v[j].w); o8[64 * j] = w; } }
        if (!FINAL && lane == 0) { ST[2 * (size_t)m] = mean; ST[2 * (size_t)m + 1] = rstd; }
        if (GATE) {
            float zmine = 0.f;
#pragma unroll 1
            for (int hh = 0; hh < 16; ++hh) { float a = 0.f;
#pragma unroll
                for (int j = 0; j < 8; ++j) { const f32x4 w = *(const LAS f32x4*)(wT + hh * DM + 256 * j + 4 * lane);
                    a += (v[j].x * w.x + v[j].y * w.y) + (v[j].z * w.z + v[j].w * w.w); }
                a = wave_sum(a); if (lane == hh) zmine = a; }
            if (lane < 16) { const float z = zmine + bfv[lane];
                const float ls = fminf(z, 0.f) - log1pf(expf(-fabsf(z)));
                LF[(size_t)m * 16 + lane] = ls; }
        }
    }
    if (GATE) __syncthreads();
}

__device__ __forceinline__ void cumsum_unit(const float* LF, float* C, int bh, LAS unsigned char* lds, int tid) {
    const int b = bh >> 4, hh = bh & 15; LAS double* sd = (LAS double*)lds;
    const float* src = LF + ((size_t)b * SEQ + 32 * tid) * 16 + hh;
    double t = 0.0;
    for (int i = 0; i < 32; ++i) t += (double)src[(size_t)i * 16];
    const int ln_ = tid & 63, wv_ = tid >> 6;
    double inc = t;
#pragma unroll
    for (int o = 1; o < 64; o <<= 1) { const double y = __shfl_up(inc, o); if (ln_ >= o) inc += y; }
    if (ln_ == 63) sd[wv_] = inc;
    __syncthreads();
    double pre = inc - t;
    for (int w = 0; w < wv_; ++w) pre += sd[w];
    float* dst = C + (size_t)bh * SEQ + 32 * tid;
    for (int i = 0; i < 32; ++i) { pre += (double)src[(size_t)i * 16]; dst[i] = (float)pre; }
    __syncthreads();
}

__device__ __forceinline__ void diff_combine(const bf16* OP, bf16* OB, const float* lq1, const float* lk1, const float* lq2, const float* lk2, const float* subg, float lam_init,
                                             int gw, int NGW, int lane) {
    const float d1 = wave_sum(lq1[lane] * lk1[lane] + lq1[lane + 64] * lk1[lane + 64]);
    const float d2 = wave_sum(lq2[lane] * lk2[lane] + lq2[lane + 64] * lk2[lane + 64]);
    const float lam = expf(d1) - expf(d2) + lam_init;
    const float osc = 1.f - lam_init;
    const int h = lane >> 3, e0 = (lane & 7) * 32;
    f32x4 sg[8];
#pragma unroll
    for (int i = 0; i < 8; ++i) sg[i] = ((const f32x4*)(subg + e0))[i];
    v4u na[4], nc[4];
    if (gw < M) { const v4u* pa_ = (const v4u*)(OP + (size_t)gw * 4096 + (h * 2 + 0) * 256 + e0); const v4u* pc_ = (const v4u*)(OP + (size_t)gw * 4096 + (h * 2 + 1) * 256 + e0);
#pragma unroll
        for (int i = 0; i < 4; ++i) { na[i] = pa_[i]; nc[i] = pc_[i]; } }
    for (int m = gw; m < M; m += NGW) {
        v4u a[4], c[4];
#pragma unroll
        for (int i = 0; i < 4; ++i) { a[i] = na[i]; c[i] = nc[i]; }
        if (m + NGW < M) { const v4u* pa_ = (const v4u*)(OP + (size_t)(m + NGW) * 4096 + (h * 2 + 0) * 256 + e0); const v4u* pc_ = (const v4u*)(OP + (size_t)(m + NGW) * 4096 + (h * 2 + 1) * 256 + e0);
#pragma unroll
            for (int i = 0; i < 4; ++i) { na[i] = pa_[i]; nc[i] = pc_[i]; } }
        float o[32]; float ss = 0.f;
#pragma unroll
        for (int i = 0; i < 4; ++i) {
            const unsigned aw[4] = {a[i].x, a[i].y, a[i].z, a[i].w}, cw[4] = {c[i].x, c[i].y, c[i].z, c[i].w};
#pragma unroll
            for (int j = 0; j < 4; ++j) {
                const float x0 = bf2f((unsigned short)(aw[j] & 0xffff)) - lam * bf2f((unsigned short)(cw[j] & 0xffff));
                const float x1 = bf2f((unsigned short)(aw[j] >> 16)) - lam * bf2f((unsigned short)(cw[j] >> 16));
                o[8 * i + 2 * j] = x0; o[8 * i + 2 * j + 1] = x1; ss += x0 * x0 + x1 * x1; } }
        ss += __shfl_xor(ss, 1); ss += __shfl_xor(ss, 2); ss += __shfl_xor(ss, 4);
        const float r = osc / sqrtf(ss * (1.f / 256.f) + LN_EPS);
        v4u* po = (v4u*)(OB + (size_t)m * DM + h * 256 + e0);
#pragma unroll
        for (int i = 0; i < 4; ++i) { const f32x4 g0 = sg[2 * i], g1 = sg[2 * i + 1]; v4u w;
            w.x = pk2(o[8 * i] * r * g0.x, o[8 * i + 1] * r * g0.y); w.y = pk2(o[8 * i + 2] * r * g0.z, o[8 * i + 3] * r * g0.w);
            w.z = pk2(o[8 * i + 4] * r * g1.x, o[8 * i + 5] * r * g1.y); w.w = pk2(o[8 * i + 6] * r * g1.z, o[8 * i + 7] * r * g1.w); po[i] = w; }
    }
}

template <int MODE>
__device__ __forceinline__ att::BlockRef attn_ref(int bh, int qb, const bf16* QKV, bf16* O, const float* C) {
    att::BlockRef r;
    if (MODE == 0) { const int b = bh >> 5, vh = bh & 31, h = vh >> 2, mp = (vh >> 1) & 1, e = vh & 1;
        const bf16* base = QKV + (size_t)b * SEQ * NQKV;
        r.Q = (const att::bf16*)(base + h * 256 + mp * 128 + (size_t)qb * 256 * NQKV);
        r.K = (const att::bf16*)(base + DM + h * 256 + mp * 128);
        r.V = (const att::bf16*)(base + 2 * DM + h * 256 + e * 128);
        r.O = (att::bf16*)(O + ((size_t)b * SEQ + (size_t)qb * 256) * 4096 + (h * 2 + mp) * 256 + e * 128);
        r.C = nullptr; r.bt = att::OFF_BT + h * 512;
    } else { const int b = bh >> 4, hh = bh & 15;
        const bf16* base = QKV + (size_t)b * SEQ * NQKV;
        r.Q = (const att::bf16*)(base + hh * 128 + (size_t)qb * 256 * NQKV);
        r.K = (const att::bf16*)(base + DM + hh * 128);
        r.V = (const att::bf16*)(base + 2 * DM + hh * 128);
        r.O = (att::bf16*)(O + ((size_t)b * SEQ + (size_t)qb * 256) * DM + hh * 128);
        r.C = C + (size_t)bh * SEQ; r.bt = 0;
    }
    r.P0 = qb * 256; r.jlo = 0;
    return r;
}
__device__ __forceinline__ void attn_decode(int L, int& bh, int& x) { const int xcd = L & 7, k = L >> 3, gi = k >> 5, r = k & 31; bh = gi * 8 + xcd; x = r; }
template <int MODE>
__device__ __forceinline__ void attn_phase(const bf16* QKV, bf16* O, const float* C, const float* rel_table, char* lds, int tid) {
    constexpr int NBH = MODE == 0 ? 64 : 32, NQB = SEQ / 256, total = NBH * 32;
    if (MODE == 0) {
        float* btab = (float*)(lds + att::OFF_BT);
        for (int i = tid; i < 8 * 128; i += NTHREADS) { const int h = i >> 7, n = i & 127;
            int bk = n; if (n >= 16) { bk = 16 + (int)(logf((float)n * (1.f / 16.f)) / 2.0794415416798357f * 16.f); bk = bk > 31 ? 31 : bk; }
            btab[i] = (rel_table[bk * 8 + h] - rel_table[31 * 8 + h]) * att::LOG2E; }
        __syncthreads();
    }
    const int stride = gridDim.x; int L = blockIdx.x; if (L >= total) return;
    int bh, x; attn_decode(L, bh, x); int pass = 0;
    att::BlockRef cur = attn_ref<MODE>(bh, NQB - 1 - x, QKV, O, C);
    att::Seam S;
    att::attn_prime<MODE>(cur, lds, S);
    for (;;) {
        const bool more_pass = pass == 0, more_item = L + stride < total, last = !more_pass && !more_item;
        int bhn = bh, xn = x, passn = pass + 1, Ln = L;
        if (!more_pass) { passn = 0; Ln = more_item ? L + stride : L; attn_decode(Ln, bhn, xn); }
        const att::BlockRef nxt = last ? cur : attn_ref<MODE>(bhn, passn ? xn : NQB - 1 - xn, QKV, O, C);
        att::attn_block<MODE, (MODE == 0 ? 4096 : DM)>(cur, nxt, lds, S);
        if (last) break;
        cur = nxt; bh = bhn; x = xn; pass = passn; L = Ln;
    }
}
__device__ __forceinline__ void diff_phase(const bf16* QKV, bf16* OP, const float* rel_table, char* lds, int tid) {
    {   float* btab = (float*)(lds + att::D_BT);
        for (int i = tid; i < 8 * 128; i += NTHREADS) { const int h = i >> 7, n = i & 127;
            int bk = n; if (n >= 16) { bk = 16 + (int)(logf((float)n * (1.f / 16.f)) / 2.0794415416798357f * 16.f); bk = bk > 31 ? 31 : bk; }
            btab[i] = (rel_table[bk * 8 + h] - rel_table[31 * 8 + h]) * att::LOG2E; }
        __syncthreads(); }
    const int wid = __builtin_amdgcn_readfirstlane(tid >> 6);
#pragma unroll 1
    for (int L = blockIdx.x; L < 2048; L += gridDim.x) {
        const int xcd = L & 7, k = L >> 3, gi = k >> 6, x = k & 63, bhm = gi * 8 + xcd;
        const int b = bhm >> 4, h = (bhm >> 1) & 7, mp = bhm & 1;
        const bf16* base = QKV + (size_t)b * SEQ * NQKV;
#pragma unroll 1
        for (int pass = 0; pass < 2; ++pass) {
            const int qb = pass ? x : 127 - x;
            att::DUnit u; u.P0 = qb * 128;
            u.Q = (const att::bf16*)(base + h * 256 + mp * 128 + (size_t)u.P0 * NQKV);
            u.K = (const att::bf16*)(base + DM + h * 256 + mp * 128);
            u.V = (const att::bf16*)(base + 2 * DM + h * 256);
            u.O = (att::bf16*)(OP + ((size_t)b * SEQ + u.P0) * 4096 + (h * 2 + mp) * 256);
            u.bt = att::D_BT + h * 512;
            int tid2 = tid; asm volatile("" : "+v"(tid2));
            if (wid < 4) att::diff_producer(u, lds, tid2); else att::diff_consumer(u, lds, tid2);
        }
    }
}
constexpr int OFF_MB = att::LDS_BYTES;
__device__ __forceinline__ void fox_fetch(unsigned* CNT, const float* NR, const float* C, int* mb, int lane) {
    asm volatile("" : "+v"(lane));
    const int x = blockIdx.x & 7; int v = -1, tgt = 0;
    if (lane == 0) { const unsigned r = __hip_atomic_fetch_add(CNT, 1u, __ATOMIC_RELAXED, __HIP_MEMORY_SCOPE_AGENT); if (r < 2048u) { v = (int)r; tgt = 0; } (void)x; }
    v = __shfl(v, 0); tgt = __shfl(tgt, 0);
    if (v < 0) { if (lane == 0) mb[3] = 0; return; }
    const int bh = tgt + (v & 31), qb = 63 - (v >> 5);
    const float* qn = NR + bh * 256 + 4 * qb; const float* kn = NR + 8192 + bh * 256; const float* Cb = C + (size_t)bh * SEQ;
    const float Qm = fmaxf(fmaxf(qn[0], qn[1]), fmaxf(qn[2], qn[3])), Kd = fmaxf(fmaxf(kn[4 * qb], kn[4 * qb + 1]), fmaxf(kn[4 * qb + 2], kn[4 * qb + 3]));
    const float rhs = -(Qm * Kd) - 36.f, cref = Cb[256 * qb];
    const int nvalid = 4 * qb; float carry = 0.f; int jlo = 0;
    float knv[4], cjv[4];
#pragma unroll
    for (int c_ = 0; c_ < 4; ++c_) { const int j = 64 * c_ + lane; const bool ok = j < nvalid; knv[c_] = ok ? kn[j] : 0.f; cjv[c_] = ok ? Cb[64 * j + 63] : 0.f; }
#pragma unroll
    for (int c_ = 0; c_ < 4; ++c_) { const int base = 64 * c_; if (base >= nvalid) break;
        const int j = base + lane; const bool ok = j < nvalid;
        float k = knv[c_];
#pragma unroll
        for (int o = 1; o < 64; o <<= 1) { const float t = __shfl_up(k, o); if (lane >= o) k = fmaxf(k, t); }
        k = fmaxf(k, carry);
        const float cj = cjv[c_];
        const bool skip = ok && (Qm * k + (cref - cj) * att::LOG2E < rhs);
        const unsigned long long m = __ballot(skip);
        const int cnt = (~m == 0ull) ? 64 : __builtin_ctzll(~m);
        jlo += cnt;
        if (cnt < 64) break;
        carry = __shfl(k, 63);
    }
    if (lane == 0) { mb[0] = bh; mb[1] = qb; mb[2] = jlo; mb[3] = 1; }
}
__device__ __forceinline__ void fox_phase(const bf16* QKV, bf16* O, const float* C, const float* NR, unsigned* CNT, char* lds, int tid) {
    const int lane = tid & 63, wid = __builtin_amdgcn_readfirstlane(tid >> 6);
    int* mb = (int*)(lds + OFF_MB);
    if (wid == 0) fox_fetch(CNT, NR, C, mb, lane);
    __syncthreads();
    if (__builtin_amdgcn_readfirstlane(mb[3]) == 0) return;
    if (wid >= 4) __builtin_amdgcn_s_setprio(1);
    att::BlockRef cur = attn_ref<1>(__builtin_amdgcn_readfirstlane(mb[0]), __builtin_amdgcn_readfirstlane(mb[1]), QKV, O, C); cur.jlo = __builtin_amdgcn_readfirstlane(mb[2]);
    __syncthreads();
    att::Seam S;
    att::attn_prime<1>(cur, lds, S);
    for (;;) {
        if (wid == 0) fox_fetch(CNT, NR, C, mb, lane);
        __syncthreads();
        const bool has = __builtin_amdgcn_readfirstlane(mb[3]) != 0;
        att::BlockRef nxt = cur; if (has) { nxt = attn_ref<1>(__builtin_amdgcn_readfirstlane(mb[0]), __builtin_amdgcn_readfirstlane(mb[1]), QKV, O, C); nxt.jlo = __builtin_amdgcn_readfirstlane(mb[2]); }
        att::attn_block<1, DM>(cur, nxt, lds, S);
        if (!has) break;
        cur = nxt;
    }
    __builtin_amdgcn_s_setprio(0);
}
__device__ __forceinline__ void norm_phase(const bf16* QKV, float* NR, int gw, int NGW, int lane) {
    for (int w = gw; w < 2 * 32 * 256; w += NGW) {
        const int which = w >> 13, bh = (w >> 8) & 31, chunk = w & 255, b = bh >> 4, hh = bh & 15;
        const v4u* p = (const v4u*)(QKV + ((size_t)b * SEQ + chunk * 64 + lane) * NQKV + which * DM + hh * 128);
        float ss = 0.f;
#pragma unroll 4
        for (int i = 0; i < 16; ++i) { const v4u v = p[i];
            const float a0 = bf2f((unsigned short)(v.x & 0xffff)), a1 = bf2f((unsigned short)(v.x >> 16)), a2 = bf2f((unsigned short)(v.y & 0xffff)), a3 = bf2f((unsigned short)(v.y >> 16));
            const float a4 = bf2f((unsigned short)(v.z & 0xffff)), a5 = bf2f((unsigned short)(v.z >> 16)), a6 = bf2f((unsigned short)(v.w & 0xffff)), a7 = bf2f((unsigned short)(v.w >> 16));
            ss += (a0 * a0 + a1 * a1) + (a2 * a2 + a3 * a3) + (a4 * a4 + a5 * a5) + (a6 * a6 + a7 * a7); }
        float nrm = sqrtf(ss) * 1.0001f;
#pragma unroll
        for (int o = 1; o < 64; o <<= 1) nrm = fmaxf(nrm, __shfl_xor(nrm, o));
        if (lane == 0) NR[w] = nrm;
    }
}

#define PHASE_BEGIN if (ph >= lo && ph < hi) {
#if defined(PROBE_A)
#define PROBE_STAMP(i) do { if (blockIdx.x == 0 && threadIdx.x == 0) ((unsigned long long*)(args.ws + WS_END))[(i)] = __builtin_amdgcn_s_memrealtime(); } while (0)
#else
#define PROBE_STAMP(i) do { } while (0)
#endif
#define PHASE_END   if (ph + 1 < hi && ph != 12) { if (lo < 0) grid.sync(); xcd_barrier(xbar); }     PROBE_STAMP(ph + 1); } ++ph;
template <int layer>
__device__ __forceinline__ void layer_body(const Args& args, cg::grid_group& grid, const XcdBarrier& xbar, unsigned char* lds, int& ph) {
    LAS unsigned char* ldsl = (LAS unsigned char*)lds;
    const int tid = threadIdx.x, lane = tid & 63, wave = __builtin_amdgcn_readfirstlane(tid >> 6);
    const int G = gridDim.x; const int bx = blockIdx.x;
    const int vcu = (G % 8 == 0) ? (bx % 8) * (G / 8) + bx / 8 : bx;
    const int gw = vcu * NWAVES + wave, NGW = G * NWAVES;
    unsigned char* ws = args.ws;
    const float* x_in = args.in[0]; float* X = args.out;
    bf16* Wgu1 = (bf16*)(ws + WS_WGU1); bf16* Wd1 = (bf16*)(ws + WS_WD1); bf16* Wgu2 = (bf16*)(ws + WS_WGU2); bf16* Wd2 = (bf16*)(ws + WS_WD2);
    bf16* Wqkv = (bf16*)(ws + WS_WQKV); bf16* Wo = (bf16*)(ws + WS_WO);
    bf16* XB = (bf16*)(ws + WS_XB); bf16* HB = (bf16*)(ws + WS_BIG); bf16* QKV = (bf16*)(ws + WS_BIG); bf16* OP = (bf16*)(ws + WS_OP);
    float* LF = (float*)(ws + WS_LF); float* CC = (float*)(ws + WS_C); float* NR = (float*)(ws + WS_NR); unsigned* CNT = (unsigned*)(ws + WS_CNT); float* ST = (float*)(ws + WS_ST);
    const int lo = args.ph_lo, hi = args.ph_hi;
        constexpr bool fox = (layer & 1) != 0;
        const float* w1g = args.in[2] + (size_t)layer * DM * FF; const float* w1u = args.in[3] + (size_t)layer * DM * FF; const float* w1d = args.in[4] + (size_t)layer * DM * FF;
        const float* w2g = args.in[5] + (size_t)layer * DM * FF; const float* w2u = args.in[6] + (size_t)layer * DM * FF; const float* w2d = args.in[7] + (size_t)layer * DM * FF;
        const float* lng = args.in[8] + (size_t)layer * 3 * DM; const float* lnb = args.in[9] + (size_t)layer * 3 * DM;
        const float* wqkv_f = fox ? args.in[17] : args.in[10]; const float* wo_f = fox ? args.in[18] : args.in[11];

        PHASE_BEGIN
            LAS float* scr = (LAS float*)(ldsl + wave * 16384);
            constexpr int I_F = (DM / 64) * (FF / 32), I_D = (FF / 64) * (DM / 32), I_Q = (DM / 64) * (NQKV / 32), I_O = (DM / 64) * (DM / 32);
            constexpr int NITEMS = 4 * I_F + 2 * I_D + I_Q + I_O;
            for (int it = gw; it < NITEMS; it += NGW) {
                int r = it;
                if (r < I_F) { transpose_item(w1g, DM, FF, Wgu1, 1, scr, r, lane); continue; } r -= I_F;
                if (r < I_F) { transpose_item(w1u, DM, FF, Wgu1, 2, scr, r, lane); continue; } r -= I_F;
                if (r < I_D) { transpose_item(w1d, FF, DM, Wd1, 0, scr, r, lane); continue; } r -= I_D;
                if (r < I_F) { transpose_item(w2g, DM, FF, Wgu2, 1, scr, r, lane); continue; } r -= I_F;
                if (r < I_F) { transpose_item(w2u, DM, FF, Wgu2, 2, scr, r, lane); continue; } r -= I_F;
                if (r < I_D) { transpose_item(w2d, FF, DM, Wd2, 0, scr, r, lane); continue; } r -= I_D;
                if (r < I_Q) { transpose_item(wqkv_f, DM, NQKV, Wqkv, 0, scr, r, lane); continue; } r -= I_Q;
                transpose_item(wo_f, DM, DM, Wo, 0, scr, r, lane);
            }
            if (fox && bx == 0 && tid < 8) CNT[tid * 64] = 0u;
            if (layer == 0) {
                for (int m = gw; m < M; m += NGW) { const f32x4* xr = (const f32x4*)(x_in + (size_t)m * DM) + lane; v2u* o8 = (v2u*)(XB + (size_t)m * DM) + lane;
#pragma unroll
                    for (int j = 0; j < 8; ++j) { const f32x4 v = __builtin_nontemporal_load(&xr[64 * j]); v2u w; w.x = pk2(v.x, v.y); w.y = pk2(v.z, v.w); o8[64 * j] = w; } }
            }
            __syncthreads();
        PHASE_END

        PHASE_BEGIN
            pg8::Gemm g{XB, Wgu1, M, 2 * FF, DM}; pg8::StaticOrder S; S.init(M, 2 * FF, G, bx);
            pg8::EpiSwiGLU E{HB, FF};
#ifndef NO_GEMM_SW
            pg8::gemm_phase<pg8::EpiSwiGLU, pg8::StaticOrder, true, true>(ldsl, g, S, E);
#endif
        PHASE_END
        PHASE_BEGIN
            pg8::Gemm g{HB, Wd1, M, DM, FF}; pg8::StaticOrder S; S.init(M, DM, G, bx);
#ifndef NO_GEMM_RES
            if constexpr (layer == 0) { pg8::EpiRes<false> E{x_in, X, DM, ALPHA, 0.5f, nullptr, nullptr, nullptr};
                pg8::gemm_phase<pg8::EpiRes<false>, pg8::StaticOrder, true, true>(ldsl, g, S, E); }
            else { pg8::EpiRes<true> E{X, X, DM, ALPHA, 0.5f, (const pg8::f32x2*)ST, lng - DM, lnb - DM};
                pg8::gemm_phase<pg8::EpiRes<true>, pg8::StaticOrder, true, true>(ldsl, g, S, E); }
#endif
        PHASE_END
        PHASE_BEGIN
            if (fox) ln_phase<true, false>(X, X, XB, ST, lng, lnb, args.in[19], args.in[20], LF, ldsl, gw, NGW, tid, lane);
            else ln_phase<false, false>(X, X, XB, ST, lng, lnb, nullptr, nullptr, nullptr, ldsl, gw, NGW, tid, lane);
        PHASE_END
        PHASE_BEGIN
            if (fox && bx < 32) cumsum_unit(LF, CC, bx, ldsl, tid);
            pg8::Gemm g{XB, Wqkv, M, NQKV, DM}; pg8::StaticOrder S; S.init(M, NQKV, G, bx);
            pg8::EpiBf16S E{QKV, NQKV, DM, QSCALE};
#ifndef NO_GEMM_QKV
            pg8::gemm_phase<pg8::EpiBf16S, pg8::StaticOrder, true, true>(ldsl, g, S, E);
#endif
        PHASE_END
        if (fox) {
        PHASE_BEGIN
            norm_phase(QKV, NR, gw, NGW, lane);
        PHASE_END
        } else { ++ph; }
        PHASE_BEGIN
#ifndef NO_ATT1
            if (fox) fox_phase(QKV, XB, CC, NR, CNT, (char*)lds, tid);
#endif
#ifndef NO_ATT0
            if (!fox) diff_phase(QKV, OP, args.in[1], (char*)lds, tid);
#endif
            __syncthreads();
        PHASE_END
        if (!fox) {
        PHASE_BEGIN
            const float lam_init = 0.8f - 0.6f * expf(-0.3f * (float)layer);
            diff_combine(OP, XB, args.in[12], args.in[13], args.in[14], args.in[15], args.in[16], lam_init, gw, NGW, lane);
        PHASE_END
        } else { ++ph; }
        PHASE_BEGIN
            pg8::Gemm g{XB, Wo, M, DM, DM}; pg8::StaticOrder S; S.init(M, DM, G, bx);
            pg8::EpiRes<true> E{X, X, DM, ALPHA, 1.0f, (const pg8::f32x2*)ST, lng, lnb};
#ifndef NO_GEMM_RES
            pg8::gemm_phase<pg8::EpiRes<true>, pg8::StaticOrder, true, true>(ldsl, g, S, E);
#endif
        PHASE_END
        PHASE_BEGIN
            ln_phase<false, false>(X, X, XB, ST, lng + DM, lnb + DM, nullptr, nullptr, nullptr, ldsl, gw, NGW, tid, lane);
        PHASE_END
        PHASE_BEGIN
            pg8::Gemm g{XB, Wgu2, M, 2 * FF, DM}; pg8::StaticOrder S; S.init(M, 2 * FF, G, bx);
            pg8::EpiSwiGLU E{HB, FF};
#ifndef NO_GEMM_SW
            pg8::gemm_phase<pg8::EpiSwiGLU, pg8::StaticOrder, true, true>(ldsl, g, S, E);
#endif
        PHASE_END
        PHASE_BEGIN
            pg8::Gemm g{HB, Wd2, M, DM, FF}; pg8::StaticOrder S; S.init(M, DM, G, bx);
            pg8::EpiRes<true> E{X, X, DM, ALPHA, 0.5f, (const pg8::f32x2*)ST, lng + DM, lnb + DM};
#ifndef NO_GEMM_RES
            pg8::gemm_phase<pg8::EpiRes<true>, pg8::StaticOrder, true, true>(ldsl, g, S, E);
#endif
        PHASE_END
        PHASE_BEGIN
            ln_phase<false, (layer == DEPTH - 1)>(X, X, XB, ST, lng + 2 * DM, lnb + 2 * DM, nullptr, nullptr, nullptr, ldsl, gw, NGW, tid, lane);
        PHASE_END
    }
#undef PHASE_BEGIN
#undef PHASE_END
__global__ void __launch_bounds__(NTHREADS, 2) fwd_megakernel(Args args) {
    extern __shared__ __attribute__((aligned(16))) unsigned char lds[];
    cg::grid_group grid = cg::this_grid();
    int ph = 0;
    PROBE_STAMP(0);
    volatile LAS unsigned* xst = (volatile LAS unsigned*)((LAS unsigned char*)lds + (LDS_BYTES - 64));
    if (threadIdx.x < 2) xst[threadIdx.x] = 0u;
    __syncthreads();
    const XcdBarrier xbar = xcd_barrier_post((unsigned*)(args.ws + WS_BAR), xst);
    layer_body<0>(args, grid, xbar, lds, ph);
    layer_body<1>(args, grid, xbar, lds, ph);
#if defined(PROBE_A)
    {
        const unsigned long long* ts = (const unsigned long long*)(args.ws + WS_END);
        float* o = args.out + (size_t)blockIdx.x * (size_t)(M / 256) * DM;
        for (int i = threadIdx.x; i < (M / 256) * DM; i += NTHREADS) o[i] = 1000.f;
        __syncthreads();
        if (blockIdx.x == 0 && threadIdx.x == 0) o[0] = (float)(ts[PROBE_A + 1] - ts[PROBE_S]) * 1e-2f;
    }
#endif
}

extern "C" void kernel_launch(void* const* d_in, const int* in_sizes, int n_in, void* d_out, int out_size, void* d_ws, size_t ws_size, hipStream_t stream) {
    static int grid = 0;
    if (grid == 0) {
        if (n_in != 21 || in_sizes[0] != M * DM || out_size != M * DM || ws_size < WS_END) {
            fprintf(stderr, "kernel_launch: unexpected shapes (n_in %d, in0 %d, out %d, ws %zu < %zu); nothing launched\n", n_in, n_in > 0 ? in_sizes[0] : -1, out_size, ws_size, (size_t)WS_END); grid = -1; return; }
        int dev = 0, cus = 0, per_cu = 0;
        (void)hipGetDevice(&dev); (void)hipDeviceGetAttribute(&cus, hipDeviceAttributeMultiprocessorCount, dev);
        if (hipFuncSetAttribute((const void*)fwd_megakernel, hipFuncAttributeMaxDynamicSharedMemorySize, LDS_BYTES) != hipSuccess) { fprintf(stderr, "kernel_launch: hipFuncSetAttribute failed\n"); grid = -1; return; }
        if (hipOccupancyMaxActiveBlocksPerMultiprocessor(&per_cu, (const void*)fwd_megakernel, NTHREADS, LDS_BYTES) != hipSuccess || per_cu < 1) { fprintf(stderr, "kernel_launch: occupancy query says %d\n", per_cu); per_cu = 1; }
        (void)hipGetLastError();
        grid = cus * 1;
        if (grid <= 0) grid = 256;
    }
    if (grid < 0) return;
    Args a{};
    for (int i = 0; i < 21; ++i) a.in[i] = (const float*)d_in[i];
    a.out = (float*)d_out; a.ws = (unsigned char*)d_ws; a.ph_lo = 0; a.ph_hi = 26;
    (void)hipMemsetAsync((unsigned char*)d_ws + WS_BAR, 0, XCD_BAR_WORDS * sizeof(unsigned), stream);
    void* kargs[] = {&a};
    hipError_t e = hipLaunchCooperativeKernel((const void*)fwd_megakernel, dim3(grid), dim3(NTHREADS), kargs, LDS_BYTES, stream);
    if (e != hipSuccess) fprintf(stderr, "kernel_launch: cooperative launch failed: %s (grid %d)\n", hipGetErrorString(e), grid);
}
```

```cpp
#include <hip/hip_runtime.h>
#include <hip/hip_cooperative_groups.h>
#include <hip/hip_bf16.h>
#include <cstdio>
#include <cstdint>
#include <cmath>
namespace pg8 {
#define PG8_LAS __attribute__((address_space(3)))
typedef unsigned short bf16_t;
typedef short bf16x8 __attribute__((ext_vector_type(8)));
typedef float f32x4 __attribute__((ext_vector_type(4)));
typedef unsigned u32x4 __attribute__((ext_vector_type(4)));
constexpr int BM = 256, BK = 64, HALF = 128, HTB = HALF * BK * 2  , STAGE_BYTES = 8 * HTB, NXCD = 8, WGM = 8;

__host__ __device__ __forceinline__ int lds_byte(int r, int c) { const int st = (r >> 4) * 2 + (c >> 5), rr = r & 15, cc = c & 31, ob = rr * 64 + cc * 2; return st * 1024 + (ob ^ (((ob >> 9) & 1) << 5)); }
__host__ __device__ __forceinline__ void stage_rc(int b, int& R, int& C) { const int st = b / 1024, sb = b % 1024, swz = sb ^ (((sb >> 9) & 1) << 5); R = (st >> 1) * 16 + swz / 64; C = (st & 1) * 32 + (swz % 64) / 2; }
__host__ __device__ __forceinline__ int perm32(int rho) { const int n = rho >> 4, i = rho & 15; return 8 * (i >> 2) + 4 * n + (i & 3); }

struct Unit { int pm, pn; };
struct Gemm { const bf16_t* A; const bf16_t* Bt; int M, N, K; };

struct StaticOrder {
    int nM, nN, nwg, G, c;
    __host__ __device__ void init(int M, int N, int G_, int c_) { nM = M / BM; nN = N / BM; nwg = nM * nN; G = G_; c = c_; }
    __host__ __device__ bool next(int i, Unit& u) const {
        const long L = (long)i * G + c; if (L >= nwg) return false;
        int wgid = (int)L; { const int q = nwg / NXCD, r = nwg % NXCD, xcd = wgid % NXCD, off = wgid / NXCD; wgid = (xcd < r ? xcd * (q + 1) : r * (q + 1) + (xcd - r) * q) + off; }
        const int nig = WGM * nN, gid = wgid / nig, fm = gid * WGM, gsz = (nM - fm) < WGM ? (nM - fm) : WGM;
        u.pm = fm + ((wgid % nig) % gsz); u.pn = (wgid % nig) / gsz; return true;
    }
    __device__ __forceinline__ void a_ready(const Unit&) const {}
    __device__ __forceinline__ void done(const Unit&) const {}
};

__device__ __forceinline__ unsigned cvt_pk_bf16(float lo, float hi) { unsigned r; asm volatile("v_cvt_pk_bf16_f32 %0, %1, %2" : "=v"(r) : "v"(lo), "v"(hi)); return r; }
typedef float f32x2 __attribute__((ext_vector_type(2)));
struct EpiBf16S {
    static constexpr bool PERM = true, AFTER_DRAIN = false;
    bf16_t* O; int ldc; int scale_cols; float scale0;
    __device__ __forceinline__ void operator()(const f32x4 (&acc)[2][2][4][2], const Unit& u, int wr, int wc, int fr, int fq) const {
        const int row0 = u.pm * BM + wr * 64 + fr; const int colt = u.pn * BM;
        const float sc = (colt < scale_cols) ? scale0 : 1.f;
        const int col0 = colt + wc * 32 + 8 * fq;
#pragma unroll
        for (int ai = 0; ai < 2; ++ai)
#pragma unroll
            for (int m = 0; m < 4; ++m) { bf16_t* rowp = O + (size_t)(row0 + ai * HALF + m * 16) * ldc + col0;
#pragma unroll
                for (int bj = 0; bj < 2; ++bj) { f32x4 v0 = acc[ai][bj][m][0] * sc, v1 = acc[ai][bj][m][1] * sc;
                    u32x4 w; w.x = cvt_pk_bf16(v0[0], v0[1]); w.y = cvt_pk_bf16(v0[2], v0[3]); w.z = cvt_pk_bf16(v1[0], v1[1]); w.w = cvt_pk_bf16(v1[2], v1[3]);
                    *(u32x4*)(rowp + bj * HALF) = w; } }
    }
};
__device__ __forceinline__ float silu_mul(float g, float u) { return g * __builtin_amdgcn_rcpf(1.f + __builtin_amdgcn_exp2f(-1.4426950408889634f * g)) * u; }
struct EpiSwiGLU {
    static constexpr bool PERM = true, AFTER_DRAIN = false;
    bf16_t* H; int ldh;
    __device__ __forceinline__ void operator()(const f32x4 (&acc)[2][2][4][2], const Unit& u, int wr, int wc, int fr, int fq) const {
        const int row0 = u.pm * BM + wr * 64 + fr; const int col0 = u.pn * HALF + wc * 32 + 8 * fq;
#pragma unroll
        for (int ai = 0; ai < 2; ++ai)
#pragma unroll
            for (int m = 0; m < 4; ++m) { bf16_t* rowp = H + (size_t)(row0 + ai * HALF + m * 16) * ldh + col0;
                const f32x4 g0 = acc[ai][0][m][0], g1 = acc[ai][0][m][1], u0 = acc[ai][1][m][0], u1 = acc[ai][1][m][1];
                u32x4 w;
                w.x = cvt_pk_bf16(silu_mul(g0[0], u0[0]), silu_mul(g0[1], u0[1])); w.y = cvt_pk_bf16(silu_mul(g0[2], u0[2]), silu_mul(g0[3], u0[3]));
                w.z = cvt_pk_bf16(silu_mul(g1[0], u1[0]), silu_mul(g1[1], u1[1])); w.w = cvt_pk_bf16(silu_mul(g1[2], u1[2]), silu_mul(g1[3], u1[3]));
                *(u32x4*)rowp = w; }
    }
};
template <bool LNB> struct EpiRes {
    static constexpr bool PERM = false, AFTER_DRAIN = false;
    const float* base; float* out; int ldc; float alpha, s; const f32x2* st; const float* g; const float* b;
    __device__ __forceinline__ void operator()(const f32x4 (&acc)[2][2][4][2], const Unit& u, int wr, int wc, int fr, int fq) const {
        const int row0 = u.pm * BM + wr * 64 + fr; const int col0 = u.pn * BM + wc * 32 + 4 * fq;
        f32x2 mr[2][4];
        if (LNB) {
#pragma unroll
            for (int ai = 0; ai < 2; ++ai)
#pragma unroll
                for (int m = 0; m < 4; ++m) mr[ai][m] = st[row0 + ai * HALF + m * 16];
        }
#pragma unroll
        for (int bj = 0; bj < 2; ++bj)
#pragma unroll
            for (int n = 0; n < 2; ++n) { const int cc = col0 + bj * HALF + n * 16;
                f32x4 gv = {1.f, 1.f, 1.f, 1.f}, bv = {0.f, 0.f, 0.f, 0.f}; if (LNB) { gv = *(const f32x4*)(g + cc); bv = *(const f32x4*)(b + cc); }
#pragma unroll
                for (int ai = 0; ai < 2; ++ai)
#pragma unroll
                    for (int m = 0; m < 4; ++m) { const size_t off = (size_t)(row0 + ai * HALF + m * 16) * ldc + cc;
                        f32x4 y = *(const f32x4*)(base + off);
                        if (LNB) y = (y - mr[ai][m].x) * mr[ai][m].y * gv + bv;
                        const f32x4 o = y * alpha + acc[ai][bj][m][n] * s; *(f32x4*)(out + off) = o; }
                asm volatile("" ::: "memory"); }
    }
};
template <class Epi, class Sched, bool ALIGN_EPI = false, bool SP2 = false>
__device__ __forceinline__ void gemm_phase(PG8_LAS unsigned char* lds, const Gemm g, const Sched& S, const Epi& E) {
    const int tid = threadIdx.x, wid = __builtin_amdgcn_readfirstlane(tid >> 6), lane = tid & 63, wr = wid >> 2, wc = wid & 3, fr = lane & 15, fq = lane >> 4;
    const int K = g.K, nt = K / BK;
    unsigned voffA[2], voffB[2];
#pragma unroll
    for (int i = 0; i < 2; ++i) { int R, C; stage_rc(tid * 16 + i * 8192, R, C); const int Rb = Epi::PERM ? ((R & ~31) + perm32(R & 31)) : R;
        voffA[i] = (unsigned)(R * K + C) * 2u; voffB[i] = (unsigned)(Rb * K + C) * 2u; }
    const size_t kstep = (size_t)(BK * 2);
    const size_t hstep = (size_t)HALF * K * 2;
    const size_t tstep = 2 * hstep;
    const unsigned ldsw = (unsigned)wid * 1024u;
    const int aoff = lds_byte(wr * 64 + fr, fq * 8), boff = lds_byte(wc * 32 + fr, fq * 8);
#define PG8_SA(b, h) (((b) * 2 + (h)) * HTB)
#define PG8_SB(b, h) ((4 + (b) * 2 + (h)) * HTB)
#define PG8_STAGE(bufoff, gbase, voff) do { _Pragma("unroll") for (int _i = 0; _i < 2; ++_i) \
        __builtin_amdgcn_global_load_lds((const unsigned*)((const char*)(gbase) + (voff)[_i]), (PG8_LAS unsigned*)(lds + (bufoff) + ldsw + _i * 8192), 16, 0, 0); } while (0)
#define PG8_LDA(dst, b, h) do { _Pragma("unroll") for (int m = 0; m < 4; ++m) _Pragma("unroll") for (int k = 0; k < 2; ++k) dst[m][k] = *(const PG8_LAS bf16x8*)(lds + PG8_SA(b, h) + aoff + m * 2048 + k * 1024); } while (0)
#define PG8_LDB(dst, b, h) do { _Pragma("unroll") for (int n = 0; n < 2; ++n) _Pragma("unroll") for (int k = 0; k < 2; ++k) dst[n][k] = *(const PG8_LAS bf16x8*)(lds + PG8_SB(b, h) + boff + n * 2048 + k * 1024); } while (0)
#define PG8_MMA(ai, bj, At, Bt) do { __builtin_amdgcn_s_setprio(1); _Pragma("unroll") for (int m = 0; m < 4; ++m) _Pragma("unroll") for (int n = 0; n < 2; ++n) _Pragma("unroll") for (int k = 0; k < 2; ++k) \
        acc[ai][bj][m][n] = __builtin_amdgcn_mfma_f32_16x16x32_bf16(Bt[n][k], At[m][k], acc[ai][bj][m][n], 0, 0, 0); __builtin_amdgcn_s_setprio(0); } while (0)
#define PG8_WAIT_V(n) asm volatile("s_waitcnt vmcnt(" #n ")" ::: "memory")
#define PG8_WAIT_L(n) asm volatile("s_waitcnt lgkmcnt(" #n ")" ::: "memory")
#define PG8_BAR __builtin_amdgcn_s_barrier()
#define PG8_SCHED __builtin_amdgcn_sched_barrier(0)
    Unit cur, nxt; int ui = 0;
    if (!S.next(0, cur)) return;
    f32x4 acc[2][2][4][2];
#pragma unroll
    for (int a = 0; a < 2; ++a)
#pragma unroll
        for (int b = 0; b < 2; ++b)
#pragma unroll
            for (int m = 0; m < 4; ++m)
#pragma unroll
                for (int n = 0; n < 2; ++n) acc[a][b][m][n] = (f32x4){0.f, 0.f, 0.f, 0.f};
    bf16x8 At[4][2], B0[2][2], B1[2][2];
    const char* cA = (const char*)g.A + (size_t)cur.pm * tstep; const char* cB = (const char*)g.Bt + (size_t)cur.pn * tstep;
    S.a_ready(cur);
    if constexpr (SP2) {
        PG8_STAGE(PG8_SB(0, 0), cB, voffB); PG8_STAGE(PG8_SB(0, 1), cB + hstep, voffB); PG8_STAGE(PG8_SA(0, 0), cA, voffA); PG8_STAGE(PG8_SA(0, 1), cA + hstep, voffA);
        if (wr == 1) PG8_BAR;
        PG8_WAIT_V(2); PG8_BAR;
        PG8_STAGE(PG8_SB(1, 0), cB + kstep, voffB); PG8_STAGE(PG8_SA(1, 0), cA + kstep, voffA); PG8_STAGE(PG8_SB(1, 1), cB + hstep + kstep, voffB);
        PG8_WAIT_V(6); PG8_BAR;
    } else {
        PG8_STAGE(PG8_SB(0, 0), cB, voffB); PG8_STAGE(PG8_SA(0, 0), cA, voffA); PG8_STAGE(PG8_SB(0, 1), cB + hstep, voffB); PG8_STAGE(PG8_SA(0, 1), cA + hstep, voffA);
        if (wr == 1) PG8_BAR;
        PG8_WAIT_V(4); PG8_BAR;
        PG8_STAGE(PG8_SB(1, 0), cB + kstep, voffB); PG8_STAGE(PG8_SA(1, 0), cA + kstep, voffA); PG8_STAGE(PG8_SB(1, 1), cB + hstep + kstep, voffB);
        PG8_WAIT_V(6); PG8_BAR;
    }
    for (;;) {
        const bool has_next = S.next(ui + 1, nxt);
        const char* nA = has_next ? (const char*)g.A + (size_t)nxt.pm * tstep : cA; const char* nB = has_next ? (const char*)g.Bt + (size_t)nxt.pn * tstep : cB;
        for (int t = 0; t < nt; t += 2) {
            const bool last = (t == nt - 2);
            const char* a1 = cA + (size_t)(t + 1) * kstep;
            const char* a2 = last ? nA : cA + (size_t)(t + 2) * kstep; const char* b2 = last ? nB : cB + (size_t)(t + 2) * kstep;
            const char* a3 = a2 + kstep; const char* b3 = b2 + kstep;
            if (last && has_next) S.a_ready(nxt);
            if constexpr (SP2) {
            PG8_LDB(B0, 0, 0); PG8_LDB(B1, 0, 1); PG8_SCHED; PG8_LDA(At, 0, 0); PG8_STAGE(PG8_SA(1, 1), a1 + hstep, voffA);
            PG8_WAIT_V(8); PG8_WAIT_L(0); PG8_BAR; PG8_MMA(0, 0, At, B0); PG8_MMA(0, 1, At, B1); PG8_BAR; PG8_SCHED;
            PG8_LDA(At, 0, 1); PG8_STAGE(PG8_SB(0, 0), b2, voffB); PG8_STAGE(PG8_SB(0, 1), b2 + hstep, voffB); PG8_STAGE(PG8_SA(0, 0), a2, voffA);
            PG8_WAIT_V(8); PG8_WAIT_L(0); PG8_BAR; PG8_MMA(1, 0, At, B0); PG8_MMA(1, 1, At, B1); PG8_BAR; PG8_SCHED;
            PG8_LDB(B0, 1, 0); PG8_LDB(B1, 1, 1); PG8_SCHED; PG8_LDA(At, 1, 0); PG8_STAGE(PG8_SA(0, 1), a2 + hstep, voffA);
            PG8_WAIT_V(8); PG8_WAIT_L(0); PG8_BAR; PG8_MMA(0, 0, At, B0); PG8_MMA(0, 1, At, B1); PG8_BAR; PG8_SCHED;
            PG8_LDA(At, 1, 1); PG8_STAGE(PG8_SB(1, 0), b3, voffB); PG8_STAGE(PG8_SB(1, 1), b3 + hstep, voffB); PG8_STAGE(PG8_SA(1, 0), a3, voffA);
            PG8_WAIT_V(8); PG8_WAIT_L(0); PG8_BAR; PG8_MMA(1, 0, At, B0); PG8_MMA(1, 1, At, B1); PG8_BAR; PG8_SCHED;
            } else {
            PG8_LDB(B0, 0, 0); PG8_SCHED; PG8_LDA(At, 0, 0); PG8_STAGE(PG8_SA(1, 1), a1 + hstep, voffA);
            PG8_WAIT_L(8); PG8_BAR; PG8_WAIT_L(0); PG8_MMA(0, 0, At, B0); PG8_BAR; PG8_SCHED;
            PG8_LDB(B1, 0, 1); PG8_STAGE(PG8_SB(0, 0), b2, voffB);
            PG8_BAR; PG8_WAIT_L(0); PG8_MMA(0, 1, At, B1); PG8_BAR;
            PG8_LDA(At, 0, 1); PG8_STAGE(PG8_SA(0, 0), a2, voffA);
            PG8_BAR; PG8_WAIT_L(0); PG8_MMA(1, 0, At, B0); PG8_BAR; PG8_SCHED;
            PG8_STAGE(PG8_SB(0, 1), b2 + hstep, voffB);
            PG8_WAIT_V(6); PG8_BAR; PG8_MMA(1, 1, At, B1); PG8_BAR;
            PG8_LDB(B0, 1, 0); PG8_SCHED; PG8_LDA(At, 1, 0); PG8_STAGE(PG8_SA(0, 1), a2 + hstep, voffA);
            PG8_WAIT_L(8); PG8_BAR; PG8_WAIT_L(0); PG8_MMA(0, 0, At, B0); PG8_BAR; PG8_SCHED;
            PG8_LDB(B1, 1, 1); PG8_STAGE(PG8_SB(1, 0), b3, voffB);
            PG8_BAR; PG8_WAIT_L(0); PG8_MMA(0, 1, At, B1); PG8_BAR;
            PG8_LDA(At, 1, 1); PG8_STAGE(PG8_SA(1, 0), a3, voffA);
            PG8_BAR; PG8_WAIT_L(0); PG8_MMA(1, 0, At, B0); PG8_BAR; PG8_SCHED;
            PG8_STAGE(PG8_SB(1, 1), b3 + hstep, voffB);
            PG8_WAIT_V(6); PG8_BAR; PG8_MMA(1, 1, At, B1); PG8_BAR;
            }
        }
        if constexpr (ALIGN_EPI) { if (wr == 0) PG8_BAR; }
        if constexpr (!Epi::AFTER_DRAIN) { E(acc, cur, wr, wc, fr, fq); S.done(cur); }
        if (!has_next) break;
#pragma unroll
        for (int a = 0; a < 2; ++a)
#pragma unroll
            for (int b = 0; b < 2; ++b)
#pragma unroll
                for (int m = 0; m < 4; ++m)
#pragma unroll
                    for (int n = 0; n < 2; ++n) acc[a][b][m][n] = (f32x4){0.f, 0.f, 0.f, 0.f};
        cur = nxt; cA = nA; cB = nB; ++ui;
        if constexpr (ALIGN_EPI) { if (wr == 1) PG8_BAR; }
    }
    PG8_WAIT_V(0);
    if constexpr (!ALIGN_EPI) { if (wr == 0) PG8_BAR; }
    PG8_BAR;
    if constexpr (Epi::AFTER_DRAIN) { E.fused(acc, cur, wr, wc, fr, fq, lds, wid, lane); S.done(cur); }
#undef PG8_SA
#undef PG8_SB
#undef PG8_STAGE
#undef PG8_LDA
#undef PG8_LDB
#undef PG8_MMA
#undef PG8_WAIT_V
#undef PG8_WAIT_L
#undef PG8_BAR
#undef PG8_SCHED
}
}
namespace att {
using bf16 = __hip_bfloat16;
typedef short bf16x8 __attribute__((ext_vector_type(8)));
typedef short s16x4 __attribute__((ext_vector_type(4)));
typedef float f32x16 __attribute__((ext_vector_type(16)));
typedef float f32x4 __attribute__((ext_vector_type(4)));
typedef unsigned u32x4 __attribute__((ext_vector_type(4)));
constexpr int D = 128, NW = 8, QBLK = 32, KVBLK = 64, QB = NW * QBLK;
constexpr int SHM_V = KVBLK * D * 2, SHM_K = KVBLK * D * 2;
constexpr int OFF_WS = 2 * SHM_V + 2 * SHM_K;
constexpr int OFF_CK = OFF_WS + NW * 64 * 4;
constexpr int OFF_BT = OFF_CK + 512;
constexpr int LDS_BYTES = OFF_BT + 8 * 128 * 4;
constexpr int LDQ = 6144;
constexpr float THR2 = 11.5f;
constexpr float LOG2E = 1.4426950408889634f;
constexpr unsigned WBIG = 1u << 30;

#define KSWZ(row, colB) ((row) * 256 + ((colB) ^ (((row) & 7) << 4)))
#define SBAR() __builtin_amdgcn_sched_barrier(0)
__device__ __forceinline__ int v_st(int k, int c) { const int kk = (k & ~0xC) | ((k & 4) << 1) | ((k & 8) >> 1); return ((kk >> 3) * 4 + (c >> 5)) * 512 + ((kk & 7) * 32 + (c & 31)) * 2; }
__device__ __forceinline__ int v_rd_base(int lane) { return ((lane & 3) << 3) | (((lane >> 2) & 3) << 6) | (((lane >> 4) & 1) << 5) | (((lane >> 5) & 1) << 8); }
constexpr int v_rd_off(int d0, int ks, int half) { return d0 * 512 + ks * 4096 + half * 2048; }
__device__ __forceinline__ int crow(int r, int hi) { return (r & 3) + 8 * (r >> 2) + 4 * hi; }
__device__ __forceinline__ unsigned cvtpk(float lo, float hi) { unsigned r; asm volatile("v_cvt_pk_bf16_f32 %0, %1, %2" : "=v"(r) : "v"(lo), "v"(hi)); return r; }
__device__ __forceinline__ bf16x8 load8(const bf16* p) { return *reinterpret_cast<const bf16x8*>(p); }
__device__ __forceinline__ void mask_tile(f32x16& p0, f32x16& p1, int dq, unsigned W) {
    const float NEG = -__builtin_inff();
#pragma unroll
    for (int r = 0; r < 16; ++r) {
        const int c = (r & 3) + 8 * (r >> 2);
        if ((unsigned)(dq - c) >= W) p0[r] = NEG;
        if ((unsigned)(dq - c - 32) >= W) p1[r] = NEG;
    }
}
__device__ __forceinline__ void partialSM(f32x16& p0, f32x16& p1, float& m_reg, float& mn, float& alpha) {
    float mx0 = fmaxf(p0[0], p1[0]), mx1 = fmaxf(p0[1], p1[1]), mx2 = fmaxf(p0[2], p1[2]), mx3 = fmaxf(p0[3], p1[3]);
    for (int r = 4; r < 16; r += 4) { mx0 = fmaxf(mx0, fmaxf(p0[r], p1[r])); mx1 = fmaxf(mx1, fmaxf(p0[r + 1], p1[r + 1])); mx2 = fmaxf(mx2, fmaxf(p0[r + 2], p1[r + 2])); mx3 = fmaxf(mx3, fmaxf(p0[r + 3], p1[r + 3])); }
    float pmax = fmaxf(fmaxf(mx0, mx1), fmaxf(mx2, mx3));
    { auto rr = __builtin_amdgcn_permlane32_swap(__float_as_uint(pmax), __float_as_uint(pmax), false, false);
      pmax = fmaxf(__uint_as_float(rr[0]), __uint_as_float(rr[1])); }
    if (__builtin_expect(__all((pmax - m_reg) <= THR2), 1)) { mn = m_reg; alpha = 1.f; }
    else { mn = fmaxf(m_reg, pmax); alpha = __builtin_amdgcn_exp2f(m_reg - mn); m_reg = mn; }
    for (int r = 0; r < 16; ++r) p0[r] = p0[r] - mn; for (int r = 0; r < 16; ++r) p1[r] = p1[r] - mn;
    for (int r = 0; r < 16; ++r) p0[r] = __builtin_amdgcn_exp2f(p0[r]);
}
__device__ __forceinline__ void finishSM(f32x16& p0, f32x16& p1, float alpha, float& l_reg, bf16x8& pa0, bf16x8& pa1, bf16x8& pa2, bf16x8& pa3) {
    for (int r = 0; r < 16; ++r) p1[r] = __builtin_amdgcn_exp2f(p1[r]);
    float ps0 = p0[0] + p1[0], ps1 = p0[1] + p1[1], ps2 = p0[2] + p1[2], ps3 = p0[3] + p1[3];
    for (int r = 4; r < 16; r += 4) { ps0 += p0[r] + p1[r]; ps1 += p0[r + 1] + p1[r + 1]; ps2 += p0[r + 2] + p1[r + 2]; ps3 += p0[r + 3] + p1[r + 3]; }
    float ps = (ps0 + ps1) + (ps2 + ps3);
    { auto rr = __builtin_amdgcn_permlane32_swap(__float_as_uint(ps), __float_as_uint(ps), false, false);
      ps = __uint_as_float(rr[0]) + __uint_as_float(rr[1]); }
    l_reg = l_reg * alpha + ps;
#define PK4(P, B_, OUT) do { unsigned a0 = cvtpk(P[B_+0], P[B_+1]), a1 = cvtpk(P[B_+2], P[B_+3]);                          \
        unsigned b0 = cvtpk(P[B_+4], P[B_+5]), b1 = cvtpk(P[B_+6], P[B_+7]);                                             \
        auto r0 = __builtin_amdgcn_permlane32_swap(a0, b0, false, false); auto r1 = __builtin_amdgcn_permlane32_swap(a1, b1, false, false); \
        u32x4 w = {r0[0], r1[0], r0[1], r1[1]}; OUT = *reinterpret_cast<bf16x8*>(&w); } while (0)
    PK4(p0, 0, pa0); PK4(p0, 8, pa1); PK4(p1, 0, pa2); PK4(p1, 8, pa3);
#undef PK4
}
template <int KB, int MODE>
__device__ __forceinline__ void qkt(f32x16& p0, f32x16& p1, const char* K_lds, const char* lds, int r32, int hi, const bf16x8* qr, bool near, int dq, int bt) {
    if constexpr (MODE == 1) {
        const f32x4* cp = (const f32x4*)(lds + OFF_CK + KB * 256 + hi * 16);
#pragma unroll
        for (int i = 0; i < 4; ++i) { const f32x4 a = cp[2 * i], b = cp[2 * i + 8];
            p0[4 * i] = a[0]; p0[4 * i + 1] = a[1]; p0[4 * i + 2] = a[2]; p0[4 * i + 3] = a[3];
            p1[4 * i] = b[0]; p1[4 * i + 1] = b[1]; p1[4 * i + 2] = b[2]; p1[4 * i + 3] = b[3]; }
    } else {
        if (near) { const float* btp = (const float*)(lds + bt);
#pragma unroll
            for (int r = 0; r < 16; ++r) { const int c = (r & 3) + 8 * (r >> 2); int d0 = dq - c, d1 = dq - c - 32;
                d0 = d0 < 0 ? 0 : (d0 > 127 ? 127 : d0); d1 = d1 < 0 ? 0 : (d1 > 127 ? 127 : d1);
                p0[r] = btp[d0]; p1[r] = btp[d1]; } }
        else { p0 = f32x16{}; p1 = f32x16{}; }
    }
    const char* kb[4];
#pragma unroll
    for (int dd = 0; dd < 4; ++dd) kb[dd] = K_lds + KB * SHM_K + KSWZ(r32, (dd * 16 + hi * 8) * 2);
#pragma unroll
    for (int d0 = 0; d0 < 8; ++d0) { const char* a = kb[d0 & 3] + (d0 >> 2) * 128;
        bf16x8 b0 = *reinterpret_cast<const bf16x8*>(a);
        bf16x8 b1 = *reinterpret_cast<const bf16x8*>(a + 32 * 256);
        p0 = __builtin_amdgcn_mfma_f32_32x32x16_bf16(b0, qr[d0], p0, 0, 0, 0);
        p1 = __builtin_amdgcn_mfma_f32_32x32x16_bf16(b1, qr[d0], p1, 0, 0, 0); }
}
template <int VB>
__device__ __forceinline__ void pv_tile(f32x16* o, int vb0, bf16x8 pa0, bf16x8 pa1, bf16x8 pa2, bf16x8 pa3) {
#define TRRD(dst, off) asm volatile("ds_read_b64_tr_b16 %0, %1 offset:%2" : "=&v"(dst) : "v"(vb0), "i"(off) : "memory")
#define PV_D0(d0) do { s16x4 l0, l1, l2, l3, h0, h1, h2, h3; constexpr int b_ = VB * SHM_V + v_rd_off(d0, 0, 0); \
        TRRD(l0, b_); TRRD(h0, b_ + 2048); TRRD(l1, b_ + 4096); TRRD(h1, b_ + 6144); TRRD(l2, b_ + 8192); TRRD(h2, b_ + 10240); TRRD(l3, b_ + 12288); TRRD(h3, b_ + 14336); \
        asm volatile("s_waitcnt lgkmcnt(0)" ::: "memory"); SBAR();   \
        o[d0] = __builtin_amdgcn_mfma_f32_32x32x16_bf16(pa0, (bf16x8){l0[0], l0[1], l0[2], l0[3], h0[0], h0[1], h0[2], h0[3]}, o[d0], 0, 0, 0);   \
        o[d0] = __builtin_amdgcn_mfma_f32_32x32x16_bf16(pa1, (bf16x8){l1[0], l1[1], l1[2], l1[3], h1[0], h1[1], h1[2], h1[3]}, o[d0], 0, 0, 0);   \
        o[d0] = __builtin_amdgcn_mfma_f32_32x32x16_bf16(pa2, (bf16x8){l2[0], l2[1], l2[2], l2[3], h2[0], h2[1], h2[2], h2[3]}, o[d0], 0, 0, 0);   \
        o[d0] = __builtin_amdgcn_mfma_f32_32x32x16_bf16(pa3, (bf16x8){l3[0], l3[1], l3[2], l3[3], h3[0], h3[1], h3[2], h3[3]}, o[d0], 0, 0, 0); } while (0)
    PV_D0(0); PV_D0(1); PV_D0(2); PV_D0(3);
#undef PV_D0
#undef TRRD
}

struct BlockRef { const bf16* Q; const bf16* K; const bf16* V; bf16* O; const float* C; int P0; int bt; int jlo; };
struct Seam { bf16x8 qr[8]; bf16x8 st_v0, st_v1, st_k0, st_k1; float st_c; };
#define ROW(p, k0, rr) ((p) + (unsigned)(((k0) + (rr)) * LDQ + sc))
#define VMW() asm volatile("s_waitcnt vmcnt(0)" ::: "memory")
#define VMWN(n) asm volatile("s_waitcnt vmcnt(%0)" :: "i"(n) : "memory")
#define SLOAD_H(Kp, Vp, Cp, k0) do { S.st_v0 = load8(ROW(Vp, k0, sr)); S.st_v1 = load8(ROW(Vp, k0, 32 + sr));              \
                         S.st_k0 = load8(ROW(Kp, k0, sr)); S.st_k1 = load8(ROW(Kp, k0, 32 + sr));                        \
                         if (MODE == 1 && wid == 0) S.st_c = (Cp)[(k0) + lane]; } while (0)
#define SWRITE_HK(bf, cr) do { *(bf16x8*)(K_lds + (bf) * SHM_K + kws) = S.st_k0; *(bf16x8*)(K_lds + (bf) * SHM_K + kws + 32 * 256) = S.st_k1; \
                         if (MODE == 1 && wid == 0) ((float*)(lds + OFF_CK))[(bf) * 64 + lane] = ((cr) - S.st_c) * LOG2E; } while (0)
#define SWRITE_HV(bf) do { *(bf16x8*)(V_lds + (bf) * SHM_V + vst0) = S.st_v0; *(bf16x8*)(V_lds + (bf) * SHM_V + vst0 + 8192) = S.st_v1; } while (0)
#define SWRITE_H(bf, cr) do { SWRITE_HV(bf); SWRITE_HK(bf, cr); } while (0)
template <int MODE>
__device__ __forceinline__ void attn_prime(const BlockRef& cur, char* lds, Seam& S) {
    const int tid = threadIdx.x, wid = __builtin_amdgcn_readfirstlane(tid >> 6), lane = tid & 63, r32 = lane & 31, hi = lane >> 5;
    const int sr = tid >> 4, sc = (tid & 15) * 8, kws = KSWZ(sr, sc * 2); char* K_lds = lds + 2 * SHM_V;
    float cref = 0.f; if (MODE == 1) cref = cur.C[cur.P0];
    for (int d0 = 0; d0 < 8; ++d0) S.qr[d0] = load8(cur.Q + (size_t)(wid * QBLK + r32) * LDQ + d0 * 16 + hi * 8);
    SLOAD_H(cur.K, cur.V, cur.C, cur.jlo * KVBLK); VMW(); SWRITE_HK(0, cref);
    __syncthreads();
}
template <int MODE, int LDO>
__device__ __forceinline__ void attn_block(const BlockRef& cur, const BlockRef& nxt, char* lds, Seam& S) {
    const int tid = threadIdx.x, wid = __builtin_amdgcn_readfirstlane(tid >> 6), lane = tid & 63, r32 = lane & 31, hi = lane >> 5;
    const int j_lo = cur.jlo, NT = (cur.P0 + QB - 1) / KVBLK + 1 - j_lo;
    const int kbn = nxt.jlo * KVBLK;
    const int qlo = cur.P0 + wid * QBLK, qm = qlo + r32 - 4 * hi;
    char* V_lds = lds; char* K_lds = lds + 2 * SHM_V;
    float* ws = (float*)(lds + OFF_WS) + wid * 64; float* li_l = ws, * al_l = ws + 32;
    float m_reg = -1e30f, l_reg = 0; f32x16 o[4] = {};
    const int sr = tid >> 4, sc = (tid & 15) * 8, vst0 = v_st(sr, sc), kws = KSWZ(sr, sc * 2);
    const int vb0 = (int)(uintptr_t)V_lds + v_rd_base(lane);
    const bf16* Kh = cur.K; const bf16* Vh = cur.V; const float* Ch = cur.C;
    float cref = 0.f, crefn = 0.f; if (MODE == 1) { cref = cur.C[cur.P0]; crefn = nxt.C[nxt.P0]; }
    const int bt = cur.bt;
#define RESC(a) do { if (__any((a) < 1.f)) { if (hi == 0) al_l[r32] = (a); asm volatile("s_waitcnt lgkmcnt(0)" ::: "memory");              \
                     for (int d_ = 0; d_ < 4; ++d_) for (int r = 0; r < 16; ++r) o[d_][r] *= al_l[crow(r, hi)]; } } while (0)
#define KBASE(t) ((j_lo + (t)) * KVBLK)
#define NEAR(t) (KBASE(t) + 191 > qlo)
#define MASKT(P0_, P1_, t) do { const int kb_ = KBASE(t); if (kb_ + KVBLK - 1 > qlo) mask_tile(P0_, P1_, qm - kb_, WBIG); } while (0)
#define QKT(KB, PX0, PX1, t) qkt<KB, MODE>(PX0, PX1, K_lds, lds, r32, hi, S.qr, NEAR(t), qm - KBASE(t), bt)
    constexpr int NQL = 8;
#define SEAM_K0() do { VMWN(NQL); SWRITE_HK(0, crefn); SBAR(); } while (0)
    f32x16 pA0, pA1, pB0, pB1; float mnA, mnB, alA, alB; bf16x8 pa0, pa1, pa2, pa3;
    SWRITE_HV(0); SBAR();
    if (NT > 1) { SLOAD_H(Kh, Vh, Ch, KBASE(1)); }
    SBAR(); QKT(0, pA0, pA1, 0);
    MASKT(pA0, pA1, 0); partialSM(pA0, pA1, m_reg, mnA, alA);
    if (NT > 1) { VMW(); SWRITE_H(1, cref); }
    __syncthreads();
#define HALF_STEP(PX0, PX1, mnX, alX, PY0, PY1, alY, t, KB, VB, SB) do {                                                      \
        SBAR(); QKT(KB, PX0, PX1, t);                                                                                         \
        finishSM(PY0, PY1, alY, l_reg, pa0, pa1, pa2, pa3); SBAR();                                                           \
        if ((t) + 1 < NT) { SLOAD_H(Kh, Vh, Ch, KBASE((t) + 1)); SBAR(); }                                                    \
        pv_tile<VB>(o, vb0, pa0, pa1, pa2, pa3); MASKT(PX0, PX1, (t)); partialSM(PX0, PX1, m_reg, mnX, alX);                  \
        __syncthreads();                                                                                                      \
        if ((t) + 1 < NT) { VMW(); SWRITE_H(SB, cref); }                                                                      \
        RESC(alX); __syncthreads(); } while (0)
    for (int t = 1; t + 1 < NT; t += 2) {
        HALF_STEP(pB0, pB1, mnB, alB, pA0, pA1, alA, t, 1, 0, 0);
        HALF_STEP(pA0, pA1, mnA, alA, pB0, pB1, alB, t + 1, 0, 1, 1);
    }
    const bool even = (NT & 1) == 0;
    if (even) { SBAR(); QKT(1, pB0, pB1, NT - 1); SBAR(); }
    SLOAD_H(nxt.K, nxt.V, nxt.C, kbn); SBAR();
#pragma unroll
    for (int d0 = 0; d0 < 8; ++d0) S.qr[d0] = load8(nxt.Q + (size_t)(wid * QBLK + r32) * LDQ + d0 * 16 + hi * 8);
    SBAR();
    finishSM(pA0, pA1, alA, l_reg, pa0, pa1, pa2, pa3); SBAR();
    pv_tile<0>(o, vb0, pa0, pa1, pa2, pa3);
    if (even) { MASKT(pB0, pB1, NT - 1); partialSM(pB0, pB1, m_reg, mnB, alB); __syncthreads(); RESC(alB);
        finishSM(pB0, pB1, alB, l_reg, pa0, pa1, pa2, pa3); SBAR(); pv_tile<1>(o, vb0, pa0, pa1, pa2, pa3); }
    SBAR(); SEAM_K0();
    if (hi == 0) li_l[r32] = l_reg; asm volatile("s_waitcnt lgkmcnt(0)" ::: "memory");
    float rli[16];
#pragma unroll
    for (int r = 0; r < 16; ++r) rli[r] = __builtin_amdgcn_rcpf(li_l[crow(r, hi)]);
    int lane2 = lane; asm volatile("" : "+v"(lane2));
    const int r32b = lane2 & 31, hib = lane2 >> 5;
    bf16* Ow = cur.O + (size_t)(wid * QBLK) * LDO + (unsigned)(hib * 4 * LDO + r32b);
#pragma unroll
    for (int r = 0; r < 16; ++r) { const int orow = (r & 3) + 8 * (r >> 2);
#pragma unroll
        for (int d0 = 0; d0 < 4; ++d0) { const float v = o[d0][r] * rli[r];
            const float vn = __shfl_xor(v, 1);
            if ((r32b & 1) == 0) *(unsigned*)(Ow + orow * LDO + d0 * 32) = cvtpk(v, vn); } }
    __syncthreads();
#undef RESC
#undef KBASE
#undef NEAR
#undef MASKT
#undef QKT
#undef SEAM_K0
#undef HALF_STEP
}
constexpr int D_V = 0, D_K = 65536, D_PS = 98304, D_PSW = 4608, D_SLOT = 4 * D_PSW, D_BT = D_PS + 2 * D_SLOT, D_LDS_BYTES = D_BT + 4096;
template <int KB>
__device__ __forceinline__ void qkt_ref(f32x16& p0, f32x16& p1, const char* K_lds, const char* lds, int r32, int hi, const bf16x8* qr, bool near, int dq, int bt, const f32x16& negm, float mhat) {
    const char* kb[4];
#pragma unroll
    for (int dd = 0; dd < 4; ++dd) kb[dd] = K_lds + KB * SHM_K + KSWZ(r32, (dd * 16 + hi * 8) * 2);
    if (near) { const float* btp = (const float*)(lds + bt);
#pragma unroll
        for (int r = 0; r < 16; ++r) { const int c = (r & 3) + 8 * (r >> 2); int d0 = dq - c, d1 = dq - c - 32;
            d0 = d0 < 0 ? 0 : (d0 > 127 ? 127 : d0); d1 = d1 < 0 ? 0 : (d1 > 127 ? 127 : d1);
            p0[r] = btp[d0] - mhat; p1[r] = btp[d1] - mhat; }
#pragma unroll
        for (int d0 = 0; d0 < 8; ++d0) { const char* a = kb[d0 & 3] + (d0 >> 2) * 128;
            bf16x8 b0 = *reinterpret_cast<const bf16x8*>(a); bf16x8 b1 = *reinterpret_cast<const bf16x8*>(a + 32 * 256);
            p0 = __builtin_amdgcn_mfma_f32_32x32x16_bf16(b0, qr[d0], p0, 0, 0, 0); p1 = __builtin_amdgcn_mfma_f32_32x32x16_bf16(b1, qr[d0], p1, 0, 0, 0); }
    } else {
#pragma unroll
        for (int d0 = 0; d0 < 8; ++d0) { const char* a = kb[d0 & 3] + (d0 >> 2) * 128;
            bf16x8 b0 = *reinterpret_cast<const bf16x8*>(a); bf16x8 b1 = *reinterpret_cast<const bf16x8*>(a + 32 * 256);
            if (d0 == 0) { p0 = __builtin_amdgcn_mfma_f32_32x32x16_bf16(b0, qr[0], negm, 0, 0, 0); p1 = __builtin_amdgcn_mfma_f32_32x32x16_bf16(b1, qr[0], negm, 0, 0, 0); }
            else { p0 = __builtin_amdgcn_mfma_f32_32x32x16_bf16(b0, qr[d0], p0, 0, 0, 0); p1 = __builtin_amdgcn_mfma_f32_32x32x16_bf16(b1, qr[d0], p1, 0, 0, 0); } }
    }
}
#define D_MX3(a, b, c) __builtin_fmaxf(__builtin_fmaxf((a), (b)), (c))
template <bool FIRST>
__device__ __forceinline__ void sm_head(f32x16& p0, f32x16& p1, float& mhat, f32x16& negm, float& alpha, bool& rs) {
    float a = D_MX3(p0[0], p0[1], p1[0]), b = D_MX3(p0[2], p0[3], p1[1]); a = D_MX3(a, p1[2], p1[3]);
#pragma unroll
    for (int r = 4; r < 16; r += 4) { a = D_MX3(a, p0[r], p0[r + 1]); b = D_MX3(b, p0[r + 2], p0[r + 3]); a = D_MX3(a, p1[r], p1[r + 1]); b = D_MX3(b, p1[r + 2], p1[r + 3]); }
    float rm = __builtin_fmaxf(a, b);
    { auto rr = __builtin_amdgcn_permlane32_swap(__float_as_uint(rm), __float_as_uint(rm), false, false); rm = __builtin_fmaxf(__uint_as_float(rr[0]), __uint_as_float(rr[1])); }
    alpha = 1.f; rs = false;
    if (FIRST || __any(rm > THR2)) {
        const float dl = FIRST ? rm : __builtin_fmaxf(rm, 0.f);
        mhat += dl;
#pragma unroll
        for (int r = 0; r < 16; ++r) { p0[r] -= dl; p1[r] -= dl; }
#pragma unroll
        for (int r = 0; r < 16; ++r) negm[r] = -mhat;
        if (!FIRST) { alpha = __builtin_amdgcn_exp2f(-dl); rs = true; }
    }
#pragma unroll
    for (int r = 0; r < 16; ++r) p0[r] = __builtin_amdgcn_exp2f(p0[r]);
}
__device__ __forceinline__ void sm_tail(f32x16& p0, f32x16& p1, bf16x8& pa0, bf16x8& pa1, bf16x8& pa2, bf16x8& pa3) {
#pragma unroll
    for (int r = 0; r < 16; ++r) p1[r] = __builtin_amdgcn_exp2f(p1[r]);
#define PK4(P, B_, OUT) do { unsigned a0 = cvtpk(P[B_+0], P[B_+1]), a1 = cvtpk(P[B_+2], P[B_+3]);                          \
        unsigned b0 = cvtpk(P[B_+4], P[B_+5]), b1 = cvtpk(P[B_+6], P[B_+7]);                                             \
        auto r0 = __builtin_amdgcn_permlane32_swap(a0, b0, false, false); auto r1 = __builtin_amdgcn_permlane32_swap(a1, b1, false, false); \
        u32x4 w = {r0[0], r1[0], r0[1], r1[1]}; OUT = *reinterpret_cast<bf16x8*>(&w); } while (0)
    PK4(p0, 0, pa0); PK4(p0, 8, pa1); PK4(p1, 0, pa2); PK4(p1, 8, pa3);
#undef PK4
}
__device__ __forceinline__ void glds16s(const void* gbase, unsigned voff, unsigned lds_dst) { unsigned keep;
    asm volatile("s_mov_b32 %0, m0\n\ts_mov_b32 m0, %3\n\ts_nop 0\n\tglobal_load_lds_dwordx4 %1, %2\n\ts_mov_b32 m0, %0" : "=&s"(keep) : "v"(voff), "s"(gbase), "s"(lds_dst) : "memory"); }
struct DUnit { const bf16* Q; const bf16* K; const bf16* V; bf16* O; int P0; int bt; };
#define D_BAR() asm volatile("s_waitcnt lgkmcnt(0)\n\ts_barrier" ::: "memory")
#define D_VMW() asm volatile("s_waitcnt vmcnt(0)" ::: "memory")
#define D_LGKM(n) asm volatile("s_waitcnt lgkmcnt(" #n ")" ::: "memory")
#define D_TRRD(dst, off) asm volatile("ds_read_b64_tr_b16 %0, %1 offset:%2" : "=&v"(dst) : "v"(vb0), "i"(off) : "memory")
#define D_RD8(S, d0, VB) do { constexpr int b_ = D_V + (VB) * 32768 + ((d0) >> 2) * 16384 + ((d0) & 3) * 512; \
        D_TRRD(S##l0, b_); D_TRRD(S##h0, b_ + 2048); D_TRRD(S##l1, b_ + 4096); D_TRRD(S##h1, b_ + 6144); D_TRRD(S##l2, b_ + 8192); D_TRRD(S##h2, b_ + 10240); D_TRRD(S##l3, b_ + 12288); D_TRRD(S##h3, b_ + 14336); } while (0)
#define D_MM4(OACC, S) do { \
        OACC = __builtin_amdgcn_mfma_f32_32x32x16_bf16(pa0, (bf16x8){S##l0[0], S##l0[1], S##l0[2], S##l0[3], S##h0[0], S##h0[1], S##h0[2], S##h0[3]}, OACC, 0, 0, 0);   \
        OACC = __builtin_amdgcn_mfma_f32_32x32x16_bf16(pa1, (bf16x8){S##l1[0], S##l1[1], S##l1[2], S##l1[3], S##h1[0], S##h1[1], S##h1[2], S##h1[3]}, OACC, 0, 0, 0);   \
        OACC = __builtin_amdgcn_mfma_f32_32x32x16_bf16(pa2, (bf16x8){S##l2[0], S##l2[1], S##l2[2], S##l2[3], S##h2[0], S##h2[1], S##h2[2], S##h2[3]}, OACC, 0, 0, 0);   \
        OACC = __builtin_amdgcn_mfma_f32_32x32x16_bf16(pa3, (bf16x8){S##l3[0], S##l3[1], S##l3[2], S##l3[3], S##h3[0], S##h3[1], S##h3[2], S##h3[3]}, OACC, 0, 0, 0); } while (0)
#define D_STORE_O(OACC, colb) do { _Pragma("unroll") for (int r = 0; r < 16; ++r) { const int orow = (r & 3) + 8 * (r >> 2); const float v = OACC[r] * rli[r]; const float vn = __shfl_xor(v, 1); \
        if ((r32b & 1) == 0) *(unsigned*)(Ow + orow * 4096 + (colb)) = cvtpk(v, vn); } } while (0)

#define D_DMA_SETUP(w4)                                                     \
    const unsigned ldsb = (unsigned)(uintptr_t)lds;                                                                            \
    const int dw4 = (w4);                                                                                                      \
    const int krow = 4 * dw4 + (lane >> 4);                                                                                    \
    const unsigned koff = (unsigned)((krow * LDQ + (((lane & 15) ^ (krow & 7)) * 8)) * 2);                                     \
    const int kkl = (lane & 31) >> 2, vsub = lane >> 5, vj = dw4 & 1, ve = dw4 >> 1;                                            \
    const unsigned voff = (unsigned)((((8 * (kkl >> 2) + (kkl & 3)) * LDQ) + ve * 128 + (2 * vj + vsub) * 32 + (lane & 3) * 8) * 2); \
    const char* Kb = (const char*)u.K; const char* Vb = (const char*)u.V;
#define D_DMAK(t, buf) do { _Pragma("unroll") for (int i_ = 0; i_ < 4; ++i_) \
        glds16s(Kb + (size_t)((t) * KVBLK + 16 * i_) * (LDQ * 2), koff, (unsigned)__builtin_amdgcn_readfirstlane(ldsb + D_K + (buf) * 16384 + (dw4 + 4 * i_) * 1024)); } while (0)
#define D_DMAV(t, buf) do { _Pragma("unroll") for (int q_ = 0; q_ < 8; ++q_) \
        glds16s(Vb + (size_t)((t) * KVBLK + 16 * (q_ >> 1) + 4 * (q_ & 1)) * (LDQ * 2), voff, (unsigned)__builtin_amdgcn_readfirstlane(ldsb + D_V + (buf) * 32768 + ve * 16384 + (q_ * 2 + vj) * 1024)); } while (0)
__device__ __forceinline__ void diff_producer(const DUnit& u, char* lds, int tid) {
    const int lane = tid & 63, wq = __builtin_amdgcn_readfirstlane(tid >> 6), r32 = lane & 31, hi = lane >> 5;
    const int NT = (u.P0 + 127) / KVBLK + 1;
    const int qlo = u.P0 + wq * QBLK, qm = qlo + r32 - 4 * hi;
    const char* K_lds = lds + D_K;
    char* psb = lds + D_PS + wq * D_PSW + lane * 16;
    float* psf = (float*)(lds + D_PS + wq * D_PSW + 4096);
    const int bt = u.bt;
    bf16x8 qr[8];
    D_DMA_SETUP(wq);
#pragma unroll
    for (int d0 = 0; d0 < 8; ++d0) qr[d0] = load8(u.Q + (unsigned)((wq * QBLK + r32) * LDQ + d0 * 16 + hi * 8));
    D_DMAK(0, 0); D_VMW();
    __builtin_amdgcn_s_setprio(2);
    D_BAR();
    D_DMAK(1, 1);
    float mhat = 0.f; f32x16 negm = {};
    f32x16 pA0, pA1, pB0, pB1; float alA, alB; bool rsA, rsB = false; bf16x8 pa0, pa1, pa2, pa3;
#define D_NEAR(t) ((t) * KVBLK + 191 > qlo)
#define D_MASKT(P0_, P1_, t) do { const int kb_ = (t) * KVBLK; if (kb_ + KVBLK - 1 > qlo) mask_tile(P0_, P1_, qm - kb_, WBIG); } while (0)
#define D_QKT(KB, PX0, PX1, t) qkt_ref<KB>(PX0, PX1, K_lds, lds, r32, hi, qr, D_NEAR(t), qm - (t) * KVBLK, bt, negm, mhat)
    SBAR(); D_QKT(0, pA0, pA1, 0); D_MASKT(pA0, pA1, 0); sm_head<true>(pA0, pA1, mhat, negm, alA, rsA);
    D_VMW();
    D_BAR();
#define D_PSTEP(PX0, PX1, alX, rsX, PY0, PY1, alY, rsY, t, KBX, SLOT) do {                                                     \
        SBAR(); if ((t) + 1 < NT) D_QKT(KBX, PX0, PX1, (t) + 1);                                                               \
        if ((t) + 2 < NT) D_DMAK((t) + 2, SLOT);                                   \
        sm_tail(PY0, PY1, pa0, pa1, pa2, pa3); SBAR();                                                                         \
        { char* s_ = psb + (SLOT) * D_SLOT; *(bf16x8*)(s_) = pa0; *(bf16x8*)(s_ + 1024) = pa1; *(bf16x8*)(s_ + 2048) = pa2; *(bf16x8*)(s_ + 3072) = pa3; \
          float* f_ = psf + (SLOT) * (D_SLOT / 4); if (hi == 0) { f_[r32] = (alY); } if (lane == 0) ((int*)f_)[32] = (rsY) ? 1 : 0; } \
        if ((t) + 1 < NT) { D_MASKT(PX0, PX1, (t) + 1); sm_head<false>(PX0, PX1, mhat, negm, alX, rsX); }                       \
        D_VMW();                                                                                                               \
        D_BAR();                                                                                                               \
    } while (0)
    for (int t = 0; t + 1 < NT; t += 2) {
        D_PSTEP(pB0, pB1, alB, rsB, pA0, pA1, alA, rsA, t, 1, 0);
        D_PSTEP(pA0, pA1, alA, rsA, pB0, pB1, alB, rsB, t + 1, 0, 1);
    }
    D_BAR();
    __builtin_amdgcn_s_setprio(0);
#undef D_PSTEP
#undef D_QKT
#undef D_MASKT
#undef D_NEAR
}
__device__ __forceinline__ void diff_consumer(const DUnit& u, char* lds, int tid) {
    const int lane = tid & 63, wq = __builtin_amdgcn_readfirstlane((tid >> 6) & 3), hi = lane >> 5;
    const int NT = (u.P0 + 127) / KVBLK + 1;
    const float* psf = (const float*)(lds + D_PS + wq * D_PSW + 4096);
    const int psa = (int)(uintptr_t)lds + D_PS + wq * D_PSW + lane * 16;
    const int vb0 = (int)(uintptr_t)lds + v_rd_base(lane);
    D_DMA_SETUP(wq);
    D_BAR();
    f32x16 o0 = {}, o1 = {}, o2 = {}, o3 = {}, o4 = {}, o5 = {}, o6 = {}, o7 = {}, ol = {}; bf16x8 pa0, pa1, pa2, pa3;
    const bf16x8 ones = {0x3F80, 0x3F80, 0x3F80, 0x3F80, 0x3F80, 0x3F80, 0x3F80, 0x3F80};
#define D_MML() do { ol = __builtin_amdgcn_mfma_f32_32x32x16_bf16(pa0, ones, ol, 0, 0, 0); ol = __builtin_amdgcn_mfma_f32_32x32x16_bf16(pa1, ones, ol, 0, 0, 0); \
        ol = __builtin_amdgcn_mfma_f32_32x32x16_bf16(pa2, ones, ol, 0, 0, 0); ol = __builtin_amdgcn_mfma_f32_32x32x16_bf16(pa3, ones, ol, 0, 0, 0); } while (0)
    s16x4 Al0, Al1, Al2, Al3, Ah0, Ah1, Ah2, Ah3, Bl0, Bl1, Bl2, Bl3, Bh0, Bh1, Bh2, Bh3;
    D_VMW();
    D_BAR();
#define D_STAGE_UNUSED(t, SLOT) do { D_VMW(); if ((t) + 2 < NT) D_WRITEK(SLOT); D_WRITEV(SLOT);     \
        if ((t) + 3 < NT) D_LOADK((t) + 3); if ((t) + 1 < NT) D_LOADV((t) + 1); } while (0)
    D_DMAV(0, 0);
    D_VMW();
    D_BAR();
#define D_RDPA(SLOT) do { asm volatile("ds_read_b128 %0, %1 offset:%2" : "=&v"(pa0) : "v"(psa), "i"((SLOT) * D_SLOT) : "memory"); asm volatile("ds_read_b128 %0, %1 offset:%2" : "=&v"(pa1) : "v"(psa), "i"((SLOT) * D_SLOT + 1024) : "memory"); \
        asm volatile("ds_read_b128 %0, %1 offset:%2" : "=&v"(pa2) : "v"(psa), "i"((SLOT) * D_SLOT + 2048) : "memory"); asm volatile("ds_read_b128 %0, %1 offset:%2" : "=&v"(pa3) : "v"(psa), "i"((SLOT) * D_SLOT + 3072) : "memory"); } while (0)
#define D_CPV(VB) do { D_LGKM(0); SBAR();                                        \
        D_MM4(o0, A); D_RD8(A, 2, VB); D_MM4(o1, B); D_RD8(B, 3, VB); D_MML();                                                 \
        D_LGKM(8); SBAR(); D_MM4(o2, A); D_RD8(A, 4, VB);                                                                      \
        D_LGKM(8); SBAR(); D_MM4(o3, B); D_RD8(B, 5, VB);                                                                      \
        D_LGKM(8); SBAR(); D_MM4(o4, A); D_RD8(A, 6, VB);                                                                      \
        D_LGKM(8); SBAR(); D_MM4(o5, B); D_RD8(B, 7, VB);                                                                      \
        D_LGKM(8); SBAR(); D_MM4(o6, A);                                                                                       \
        D_LGKM(0); SBAR(); D_MM4(o7, B); } while (0)
#define D_CRESC(SLOT) do { const float* f_ = psf + (SLOT) * (D_SLOT / 4); if (__builtin_amdgcn_readfirstlane(((const int*)f_)[32]) != 0) { _Pragma("unroll") for (int r = 0; r < 16; ++r) { const float a_ = f_[crow(r, hi)];  \
            o0[r] *= a_; o1[r] *= a_; o2[r] *= a_; o3[r] *= a_; o4[r] *= a_; o5[r] *= a_; o6[r] *= a_; o7[r] *= a_; ol[r] *= a_; } } } while (0)
#define D_CSTEP(t, VB) do { D_RD8(A, 0, VB); if ((t) < NT) { D_DMAV((t), 1 - (VB)); } D_RD8(B, 1, VB); D_RDPA(VB); D_CRESC(VB); D_CPV(VB); D_VMW(); D_BAR(); } while (0)
    for (int t = 1; t < NT; t += 2) {
        D_CSTEP(t, 0);
        D_CSTEP(t + 1, 1);
    }
    {   unsigned short* stg = (unsigned short*)(lds + D_V + wq * 16384);
        const int r32 = lane & 31;
#define D_STG(OACC, colb) do { _Pragma("unroll") for (int r = 0; r < 16; ++r) stg[crow(r, hi) * 256 + (colb) + r32] = (unsigned short)(cvtpk(OACC[r] * __builtin_amdgcn_rcpf(ol[r]), 0.f) & 0xffffu); } while (0)
        D_STG(o0, 0); D_STG(o1, 32); D_STG(o2, 64); D_STG(o3, 96); D_STG(o4, 128); D_STG(o5, 160); D_STG(o6, 192); D_STG(o7, 224);
#undef D_STG
        asm volatile("s_waitcnt lgkmcnt(0)" ::: "memory");
        bf16* Ow = u.O + (unsigned)((wq * QBLK) * 4096);
#pragma unroll
        for (int i = 0; i < 16; ++i) { const int row = 2 * i + (lane >> 5), ch = lane & 31;
            const u32x4 v = *(const u32x4*)(stg + row * 256 + ch * 8); *(u32x4*)(Ow + row * 4096 + ch * 8) = v; }
        asm volatile("s_waitcnt lgkmcnt(0)" ::: "memory");
    }
#undef D_MML
#undef D_CSTEP
#undef D_STAGE_UNUSED
#undef D_CRESC
#undef D_CPV
#undef D_RDPA
}
#undef D_DMA_SETUP
#undef D_DMAK
#undef D_DMAV
#undef D_BAR
#undef D_VMW
#undef D_LGKM
#undef D_TRRD
#undef D_RD8
#undef D_MM4
#undef D_STORE_O
#undef ROW
#undef VMW
#undef VMWN
#undef SLOAD_H
#undef SWRITE_HK
#undef SWRITE_HV
#undef SWRITE_H
#undef KSWZ
#undef SBAR
}
namespace cg = cooperative_groups;
#define LAS __attribute__((address_space(3)))
typedef unsigned short bf16;
typedef unsigned v4u __attribute__((ext_vector_type(4)));
typedef unsigned v2u __attribute__((ext_vector_type(2)));
typedef float f32x4 __attribute__((ext_vector_type(4)));

constexpr int BATCH = 2, SEQ = 16384, DM = 2048, FF = 5632, DEPTH = 2;
constexpr int M = BATCH * SEQ;
constexpr int NQKV = 3 * DM;
constexpr float LN_EPS = 1e-5f;
constexpr float ALPHA = 1.4142135623730951f;
constexpr float QSCALE = 0.08838834764831845f * 1.4426950408889634f;
constexpr int NWAVES = 8, NTHREADS = 512;
constexpr int LDS_BYTES = 147456;

constexpr size_t MiB = 1u << 20;
constexpr size_t WS_WGU1 = 1 * MiB;
constexpr size_t WS_WD1 = WS_WGU1 + 44 * MiB;
constexpr size_t WS_WGU2 = WS_WD1 + 22 * MiB;
constexpr size_t WS_WD2 = WS_WGU2 + 44 * MiB;
constexpr size_t WS_WQKV = WS_WD2 + 22 * MiB;
constexpr size_t WS_WO = WS_WQKV + 24 * MiB;
constexpr size_t WS_XB = WS_WO + 8 * MiB;
constexpr size_t WS_BIG = WS_XB + 128 * MiB;
constexpr size_t WS_OP = WS_BIG + 384 * MiB;
constexpr size_t WS_LF = WS_OP + 256 * MiB;
constexpr size_t WS_C = WS_LF + 2 * MiB;
constexpr size_t WS_NR = WS_C + 2 * MiB;
constexpr size_t WS_CNT = WS_NR + 1 * MiB;
constexpr size_t WS_ST = WS_CNT + 1 * MiB;
constexpr size_t WS_BAR = WS_ST + 1 * MiB;
constexpr size_t WS_END = WS_BAR + 1 * MiB;

__device__ __forceinline__ unsigned f2bf(float f) { unsigned u = __builtin_bit_cast(unsigned, f); return (u + 0x7fffu + ((u >> 16) & 1u)) >> 16; }
__device__ __forceinline__ unsigned pk2(float lo, float hi) { return f2bf(lo) | (f2bf(hi) << 16); }
__device__ __forceinline__ float bf2f(unsigned short b) { return __builtin_bit_cast(float, (unsigned)b << 16); }
__device__ __forceinline__ float wave_sum(float v) {
#pragma unroll
    for (int o = 1; o < 64; o <<= 1) v += __shfl_xor(v, o);
    return v;
}
#define LDS_WAIT() asm volatile("s_waitcnt lgkmcnt(0)" ::: "memory")

__device__ __forceinline__ void transpose_item(const float* W, int K, int N, bf16* WT, int gu, LAS float* scr, int item, int lane) {
    const int nblk = N / 32, kb = item / nblk, nb = item % nblk, k0 = 64 * kb, n0 = 32 * nb;
    const int r0 = gu == 0 ? n0 : ((n0 >> 7) * 256 + (n0 & 127) + (gu == 2 ? 128 : 0));
    float wv[32];
#pragma unroll
    for (int i = 0; i < 32; ++i) { const int kk = 2 * i + (lane >> 5); wv[i] = W[(size_t)(k0 + kk) * N + n0 + (lane & 31)]; }
#pragma unroll
    for (int i = 0; i < 32; ++i) { const int kk = 2 * i + (lane >> 5); scr[kk * 33 + (lane & 31)] = wv[i]; }
    LDS_WAIT(); asm volatile("" ::: "memory");
    const int c = lane & 7;
#pragma unroll
    for (int j = 0; j < 4; ++j) { const int n = (lane >> 3) + 8 * j; const LAS float* s = scr + (8 * c) * 33 + n;
        v4u o; o.x = pk2(s[0 * 33], s[1 * 33]); o.y = pk2(s[2 * 33], s[3 * 33]); o.z = pk2(s[4 * 33], s[5 * 33]); o.w = pk2(s[6 * 33], s[7 * 33]);
        *(v4u*)(WT + (size_t)(r0 + n) * K + k0 + 8 * c) = o; }
    LDS_WAIT(); asm volatile("" ::: "memory");
}

#define XB_TMO      128
#define XB_XCNT(j)  (256  + 64 * (j))
#define XB_XSUB(j)  (1280 + 64 * (j))
#define XB_XGEN(j)  (2304 + 64 * (j))
#define XB_TOP      3328
#define XB_TOPGEN   3392
#define XCD_BAR_WORDS 3456
#define XB_SPIN_CAP (1u << 18)

__device__ __forceinline__ unsigned xb_ld(unsigned* p)              { return __hip_atomic_load(p, __ATOMIC_RELAXED, __HIP_MEMORY_SCOPE_AGENT); }
__device__ __forceinline__ unsigned xb_add(unsigned* p, unsigned v) { return __hip_atomic_fetch_add(p, v, __ATOMIC_RELAXED, __HIP_MEMORY_SCOPE_AGENT); }
__device__ __forceinline__ unsigned xb_xcc_id() { return (unsigned)__builtin_amdgcn_s_getreg((3 << 11) | 20) & 0xFu; }
#define XB_SPIN(cond, bar) do { unsigned _sp = 0; while (cond) { __builtin_amdgcn_s_sleep(1); \
    if ((++_sp & 255u) == 0u) { if (xb_ld(&(bar)[XB_TMO])) break; if (_sp > XB_SPIN_CAP) { atomicAdd(&(bar)[XB_TMO], 1u); break; } } } } while (0)

struct XcdBarrier {
    unsigned* bar; unsigned x;
    volatile LAS unsigned* st;
};

__device__ __forceinline__ XcdBarrier xcd_barrier_post(unsigned* bar, volatile LAS unsigned* st) {
    XcdBarrier b; b.bar = bar; b.x = xb_xcc_id(); b.st = st;
    if (threadIdx.x == 0) (void)xb_add(&bar[XB_XCNT(b.x)], 1u);
    return b;
}
__device__ __forceinline__ void xcd_barrier_complete(unsigned* bar, unsigned x, unsigned& nloc, unsigned& nx) {
    const unsigned G = gridDim.x * gridDim.y * gridDim.z;
    unsigned sum, cnt, mine, sp = 0u;
    for (;;) {
        sum = 0u; cnt = 0u; mine = 0u;
#pragma unroll
        for (unsigned j = 0; j < 16; ++j) { const unsigned c = xb_ld(&bar[XB_XCNT(j)]); sum += c; cnt += (c > 0u) ? 1u : 0u; mine = (j == x) ? c : mine; }
        if (sum == G) break;
        __builtin_amdgcn_s_sleep(1);
        if ((++sp & 255u) == 0u) { if (xb_ld(&bar[XB_TMO])) break; if (sp > XB_SPIN_CAP) { atomicAdd(&bar[XB_TMO], 1u); break; } }
    }
    nloc = mine > 0u ? mine : 1u; nx = cnt > 0u ? cnt : 1u;
}

__device__ __forceinline__ void xcd_barrier(const XcdBarrier& b) {
    asm volatile("s_waitcnt vmcnt(0)" ::: "memory");
    __syncthreads();
    if (threadIdx.x == 0) {
        unsigned* bar = b.bar;
        __builtin_amdgcn_s_waitcnt(0);
        unsigned nloc = b.st[0], nx = b.st[1];
        if (nloc == 0u) { xcd_barrier_complete(bar, b.x, nloc, nx); b.st[0] = nloc; b.st[1] = nx; }
        const unsigned old = xb_add(&bar[XB_XSUB(b.x)], 1u);
        const unsigned gen = old / nloc;
        if (old + 1u == (gen + 1u) * nloc) {
            __builtin_amdgcn_fence(__ATOMIC_RELEASE, "agent");
            asm volatile("s_waitcnt vmcnt(0)" ::: "memory");
            const unsigned og = xb_add(&bar[XB_TOP], 1u);
            const unsigned tg = og / nx;
            if (og + 1u == (tg + 1u) * nx) xb_add(&bar[XB_TOPGEN], 1u);
            else XB_SPIN(xb_ld(&bar[XB_TOPGEN]) == tg, bar);
            __builtin_amdgcn_fence(__ATOMIC_ACQUIRE, "agent");
            xb_add(&bar[XB_XGEN(b.x)], 1u);
            asm volatile("s_waitcnt vmcnt(0)" ::: "memory");
        } else {
            XB_SPIN(xb_ld(&bar[XB_XGEN(b.x)]) == gen, bar);
            __builtin_amdgcn_fence(__ATOMIC_ACQUIRE, "agent");
            asm volatile("s_waitcnt vmcnt(0)" ::: "memory");
        }
    }
    __syncthreads();
}


struct Args { const float* in[21]; float* out; unsigned char* ws; int ph_lo, ph_hi; };

template <bool GATE, bool FINAL>
__device__ __forceinline__ void ln_phase(const float* Y, float* X, bf16* XB, float* ST, const float* g, const float* b, const float* wf, const float* bfv, float* LF,
                                         LAS unsigned char* lds, int gw, int NGW, int tid, int lane) {
    LAS float* wT = (LAS float*)lds;
    if (GATE) {
        for (int idx = tid; idx < DM * 16; idx += NTHREADS) { const int k = idx >> 4, hh = idx & 15; wT[hh * DM + k] = wf[idx]; }
        __syncthreads();
    }
    f32x4 gv[8], bv[8];
#pragma unroll
    for (int j = 0; j < 8; ++j) { gv[j] = ((const f32x4*)g)[64 * j + lane]; bv[j] = ((const f32x4*)b)[64 * j + lane]; }
    f32x4 nx[8];
    if (gw < M) { const f32x4* yr = (const f32x4*)(Y + (size_t)gw * DM) + lane;
#pragma unroll
        for (int j = 0; j < 8; ++j) nx[j] = __builtin_nontemporal_load(&yr[64 * j]); }
    for (int m = gw; m < M; m += NGW) {
        f32x4 v[8]; float s = 0.f;
#pragma unroll
        for (int j = 0; j < 8; ++j) { v[j] = nx[j]; s += (v[j].x + v[j].y) + (v[j].z + v[j].w); }
        if (m + NGW < M) { const f32x4* yr = (const f32x4*)(Y + (size_t)(m + NGW) * DM) + lane;
#pragma unroll
            for (int j = 0; j < 8; ++j) nx[j] = __builtin_nontemporal_load(&yr[64 * j]); }
        const float mean = wave_sum(s) * (1.f / DM); float s2 = 0.f;
#pragma unroll
        for (int j = 0; j < 8; ++j) { v[j] = v[j] - mean; s2 += (v[j].x * v[j].x + v[j].y * v[j].y) + (v[j].z * v[j].z + v[j].w * v[j].w); }
        const float rstd = 1.f / sqrtf(wave_sum(s2) * (1.f / DM) + LN_EPS);
        f32x4* xr = (f32x4*)(X + (size_t)m * DM) + lane;
        v2u* o8 = (v2u*)(XB + (size_t)m * DM) + lane;
#pragma unroll
        for (int j = 0; j < 8; ++j) { v[j] = v[j] * rstd * gv[j] + bv[j];
            if (FINAL) xr[64 * j] = v[j];
            else { v2u w; w.x = pk2(v[j].x, v[j].y); w.y = pk2(v[j].z, v[j].w); o8[64 * j] = w; } }
        if (!FINAL && lane == 0) { ST[2 * (size_t)m] = mean; ST[2 * (size_t)m + 1] = rstd; }
        if (GATE) {
            float zmine = 0.f;
#pragma unroll 1
            for (int hh = 0; hh < 16; ++hh) { float a = 0.f;
#pragma unroll
                for (int j = 0; j < 8; ++j) { const f32x4 w = *(const LAS f32x4*)(wT + hh * DM + 256 * j + 4 * lane);
                    a += (v[j].x * w.x + v[j].y * w.y) + (v[j].z * w.z + v[j].w * w.w); }
                a = wave_sum(a); if (lane == hh) zmine = a; }
            if (lane < 16) { const float z = zmine + bfv[lane];
                const float ls = fminf(z, 0.f) - log1pf(expf(-fabsf(z)));
                LF[(size_t)m * 16 + lane] = ls; }
        }
    }
    if (GATE) __syncthreads();
}

__device__ __forceinline__ void cumsum_unit(const float* LF, float* C, int bh, LAS unsigned char* lds, int tid) {
    const int b = bh >> 4, hh = bh & 15; LAS double* sd = (LAS double*)lds;
    const float* src = LF + ((size_t)b * SEQ + 32 * tid) * 16 + hh;
    double t = 0.0;
    for (int i = 0; i < 32; ++i) t += (double)src[(size_t)i * 16];
    const int ln_ = tid & 63, wv_ = tid >> 6;
    double inc = t;
#pragma unroll
    for (int o = 1; o < 64; o <<= 1) { const double y = __shfl_up(inc, o); if (ln_ >= o) inc += y; }
    if (ln_ == 63) sd[wv_] = inc;
    __syncthreads();
    double pre = inc - t;
    for (int w = 0; w < wv_; ++w) pre += sd[w];
    float* dst = C + (size_t)bh * SEQ + 32 * tid;
    for (int i = 0; i < 32; ++i) { pre += (double)src[(size_t)i * 16]; dst[i] = (float)pre; }
    __syncthreads();
}

__device__ __forceinline__ void diff_combine(const bf16* OP, bf16* OB, const float* lq1, const float* lk1, const float* lq2, const float* lk2, const float* subg, float lam_init,
                                             int gw, int NGW, int lane) {
    const float d1 = wave_sum(lq1[lane] * lk1[lane] + lq1[lane + 64] * lk1[lane + 64]);
    const float d2 = wave_sum(lq2[lane] * lk2[lane] + lq2[lane + 64] * lk2[lane + 64]);
    const float lam = expf(d1) - expf(d2) + lam_init;
    const float osc = 1.f - lam_init;
    const int h = lane >> 3, e0 = (lane & 7) * 32;
    f32x4 sg[8];
#pragma unroll
    for (int i = 0; i < 8; ++i) sg[i] = ((const f32x4*)(subg + e0))[i];
    v4u na[4], nc[4];
    if (gw < M) { const v4u* pa_ = (const v4u*)(OP + (size_t)gw * 4096 + (h * 2 + 0) * 256 + e0); const v4u* pc_ = (const v4u*)(OP + (size_t)gw * 4096 + (h * 2 + 1) * 256 + e0);
#pragma unroll
        for (int i = 0; i < 4; ++i) { na[i] = __builtin_nontemporal_load(&pa_[i]); nc[i] = __builtin_nontemporal_load(&pc_[i]); } }
    for (int m = gw; m < M; m += NGW) {
        v4u a[4], c[4];
#pragma unroll
        for (int i = 0; i < 4; ++i) { a[i] = na[i]; c[i] = nc[i]; }
        if (m + NGW < M) { const v4u* pa_ = (const v4u*)(OP + (size_t)(m + NGW) * 4096 + (h * 2 + 0) * 256 + e0); const v4u* pc_ = (const v4u*)(OP + (size_t)(m + NGW) * 4096 + (h * 2 + 1) * 256 + e0);
#pragma unroll
            for (int i = 0; i < 4; ++i) { na[i] = __builtin_nontemporal_load(&pa_[i]); nc[i] = __builtin_nontemporal_load(&pc_[i]); } }
        float o[32]; float ss = 0.f;
#pragma unroll
        for (int i = 0; i < 4; ++i) {
            const unsigned aw[4] = {a[i].x, a[i].y, a[i].z, a[i].w}, cw[4] = {c[i].x, c[i].y, c[i].z, c[i].w};
#pragma unroll
            for (int j = 0; j < 4; ++j) {
                const float x0 = bf2f((unsigned short)(aw[j] & 0xffff)) - lam * bf2f((unsigned short)(cw[j] & 0xffff));
                const float x1 = bf2f((unsigned short)(aw[j] >> 16)) - lam * bf2f((unsigned short)(cw[j] >> 16));
                o[8 * i + 2 * j] = x0; o[8 * i + 2 * j + 1] = x1; ss += x0 * x0 + x1 * x1; } }
        ss += __shfl_xor(ss, 1); ss += __shfl_xor(ss, 2); ss += __shfl_xor(ss, 4);
        const float r = osc / sqrtf(ss * (1.f / 256.f) + LN_EPS);
        v4u* po = (v4u*)(OB + (size_t)m * DM + h * 256 + e0);
#pragma unroll
        for (int i = 0; i < 4; ++i) { const f32x4 g0 = sg[2 * i], g1 = sg[2 * i + 1]; v4u w;
            w.x = pk2(o[8 * i] * r * g0.x, o[8 * i + 1] * r * g0.y); w.y = pk2(o[8 * i + 2] * r * g0.z, o[8 * i + 3] * r * g0.w);
            w.z = pk2(o[8 * i + 4] * r * g1.x, o[8 * i + 5] * r * g1.y); w.w = pk2(o[8 * i + 6] * r * g1.z, o[8 * i + 7] * r * g1.w); po[i] = w; }
    }
}

template <int MODE>
__device__ __forceinline__ att::BlockRef attn_ref(int bh, int qb, const bf16* QKV, bf16* O, const float* C) {
    att::BlockRef r;
    if (MODE == 0) { const int b = bh >> 5, vh = bh & 31, h = vh >> 2, mp = (vh >> 1) & 1, e = vh & 1;
        const bf16* base = QKV + (size_t)b * SEQ * NQKV;
        r.Q = (const att::bf16*)(base + h * 256 + mp * 128 + (size_t)qb * 256 * NQKV);
        r.K = (const att::bf16*)(base + DM + h * 256 + mp * 128);
        r.V = (const att::bf16*)(base + 2 * DM + h * 256 + e * 128);
        r.O = (att::bf16*)(O + ((size_t)b * SEQ + (size_t)qb * 256) * 4096 + (h * 2 + mp) * 256 + e * 128);
        r.C = nullptr; r.bt = att::OFF_BT + h * 512;
    } else { const int b = bh >> 4, hh = bh & 15;
        const bf16* base = QKV + (size_t)b * SEQ * NQKV;
        r.Q = (const att::bf16*)(base + hh * 128 + (size_t)qb * 256 * NQKV);
        r.K = (const att::bf16*)(base + DM + hh * 128);
        r.V = (const att::bf16*)(base + 2 * DM + hh * 128);
        r.O = (att::bf16*)(O + ((size_t)b * SEQ + (size_t)qb * 256) * DM + hh * 128);
        r.C = C + (size_t)bh * SEQ; r.bt = 0;
    }
    r.P0 = qb * 256; r.jlo = 0;
    return r;
}
__device__ __forceinline__ void attn_decode(int L, int& bh, int& x) { const int xcd = L & 7, k = L >> 3, gi = k >> 5, r = k & 31; bh = gi * 8 + xcd; x = r; }
template <int MODE>
__device__ __forceinline__ void attn_phase(const bf16* QKV, bf16* O, const float* C, const float* rel_table, char* lds, int tid) {
    constexpr int NBH = MODE == 0 ? 64 : 32, NQB = SEQ / 256, total = NBH * 32;
    if (MODE == 0) {
        float* btab = (float*)(lds + att::OFF_BT);
        for (int i = tid; i < 8 * 128; i += NTHREADS) { const int h = i >> 7, n = i & 127;
            int bk = n; if (n >= 16) { bk = 16 + (int)(logf((float)n * (1.f / 16.f)) / 2.0794415416798357f * 16.f); bk = bk > 31 ? 31 : bk; }
            btab[i] = (rel_table[bk * 8 + h] - rel_table[31 * 8 + h]) * att::LOG2E; }
        __syncthreads();
    }
    const int stride = gridDim.x; int L = blockIdx.x; if (L >= total) return;
    int bh, x; attn_decode(L, bh, x); int pass = 0;
    att::BlockRef cur = attn_ref<MODE>(bh, NQB - 1 - x, QKV, O, C);
    att::Seam S;
    att::attn_prime<MODE>(cur, lds, S);
    for (;;) {
        const bool more_pass = pass == 0, more_item = L + stride < total, last = !more_pass && !more_item;
        int bhn = bh, xn = x, passn = pass + 1, Ln = L;
        if (!more_pass) { passn = 0; Ln = more_item ? L + stride : L; attn_decode(Ln, bhn, xn); }
        const att::BlockRef nxt = last ? cur : attn_ref<MODE>(bhn, passn ? xn : NQB - 1 - xn, QKV, O, C);
        att::attn_block<MODE, (MODE == 0 ? 4096 : DM)>(cur, nxt, lds, S);
        if (last) break;
        cur = nxt; bh = bhn; x = xn; pass = passn; L = Ln;
    }
}
__device__ __forceinline__ void diff_phase(const bf16* QKV, bf16* OP, const float* rel_table, char* lds, int tid) {
    {   float* btab = (float*)(lds + att::D_BT);
        for (int i = tid; i < 8 * 128; i += NTHREADS) { const int h = i >> 7, n = i & 127;
            int bk = n; if (n >= 16) { bk = 16 + (int)(logf((float)n * (1.f / 16.f)) / 2.0794415416798357f * 16.f); bk = bk > 31 ? 31 : bk; }
            btab[i] = (rel_table[bk * 8 + h] - rel_table[31 * 8 + h]) * att::LOG2E; }
        __syncthreads(); }
    const int wid = __builtin_amdgcn_readfirstlane(tid >> 6);
#pragma unroll 1
    for (int L = blockIdx.x; L < 2048; L += gridDim.x) {
        const int xcd = L & 7, k = L >> 3, gi = k >> 6, x = k & 63, bhm = gi * 8 + xcd;
        const int b = bhm >> 4, h = (bhm >> 1) & 7, mp = bhm & 1;
        const bf16* base = QKV + (size_t)b * SEQ * NQKV;
#pragma unroll 1
        for (int pass = 0; pass < 2; ++pass) {
            const int qb = pass ? x : 127 - x;
            att::DUnit u; u.P0 = qb * 128;
            u.Q = (const att::bf16*)(base + h * 256 + mp * 128 + (size_t)u.P0 * NQKV);
            u.K = (const att::bf16*)(base + DM + h * 256 + mp * 128);
            u.V = (const att::bf16*)(base + 2 * DM + h * 256);
            u.O = (att::bf16*)(OP + ((size_t)b * SEQ + u.P0) * 4096 + (h * 2 + mp) * 256);
            u.bt = att::D_BT + h * 512;
            int tid2 = tid; asm volatile("" : "+v"(tid2));
            if (wid < 4) att::diff_producer(u, lds, tid2); else att::diff_consumer(u, lds, tid2);
        }
    }
}
constexpr int OFF_MB = att::LDS_BYTES;
__device__ __forceinline__ void fox_fetch(unsigned* CNT, const float* NR, const float* C, int* mb, int lane) {
    asm volatile("" : "+v"(lane));
    const int x = blockIdx.x & 7; int v = -1, tgt = 0;
    if (lane == 0) { const unsigned r = __hip_atomic_fetch_add(CNT, 1u, __ATOMIC_RELAXED, __HIP_MEMORY_SCOPE_AGENT); if (r < 2048u) { v = (int)r; tgt = 0; } (void)x; }
    v = __shfl(v, 0); tgt = __shfl(tgt, 0);
    if (v < 0) { if (lane == 0) mb[3] = 0; return; }
    const int bh = tgt + (v & 31), qb = 63 - (v >> 5);
    const float* qn = NR + bh * 256 + 4 * qb; const float* kn = NR + 8192 + bh * 256; const float* Cb = C + (size_t)bh * SEQ;
    const float Qm = fmaxf(fmaxf(qn[0], qn[1]), fmaxf(qn[2], qn[3])), Kd = fmaxf(fmaxf(kn[4 * qb], kn[4 * qb + 1]), fmaxf(kn[4 * qb + 2], kn[4 * qb + 3]));
    const float rhs = -(Qm * Kd) - 36.f, cref = Cb[256 * qb];
    const int nvalid = 4 * qb; float carry = 0.f; int jlo = 0;
    float knv[4], cjv[4];
#pragma unroll
    for (int c_ = 0; c_ < 4; ++c_) { const int j = 64 * c_ + lane; const bool ok = j < nvalid; knv[c_] = ok ? kn[j] : 0.f; cjv[c_] = ok ? Cb[64 * j + 63] : 0.f; }
#pragma unroll
    for (int c_ = 0; c_ < 4; ++c_) { const int base = 64 * c_; if (base >= nvalid) break;
        const int j = base + lane; const bool ok = j < nvalid;
        float k = knv[c_];
#pragma unroll
        for (int o = 1; o < 64; o <<= 1) { const float t = __shfl_up(k, o); if (lane >= o) k = fmaxf(k, t); }
        k = fmaxf(k, carry);
        const float cj = cjv[c_];
        const bool skip = ok && (Qm * k + (cref - cj) * att::LOG2E < rhs);
        const unsigned long long m = __ballot(skip);
        const int cnt = (~m == 0ull) ? 64 : __builtin_ctzll(~m);
        jlo += cnt;
        if (cnt < 64) break;
        carry = __shfl(k, 63);
    }
    if (lane == 0) { mb[0] = bh; mb[1] = qb; mb[2] = jlo; mb[3] = 1; }
}
__device__ __forceinline__ void fox_phase(const bf16* QKV, bf16* O, const float* C, const float* NR, unsigned* CNT, char* lds, int tid) {
    const int lane = tid & 63, wid = __builtin_amdgcn_readfirstlane(tid >> 6);
    int* mb = (int*)(lds + OFF_MB);
    if (wid == 0) fox_fetch(CNT, NR, C, mb, lane);
    __syncthreads();
    if (__builtin_amdgcn_readfirstlane(mb[3]) == 0) return;
    if (wid >= 4) __builtin_amdgcn_s_setprio(1);
    att::BlockRef cur = attn_ref<1>(__builtin_amdgcn_readfirstlane(mb[0]), __builtin_amdgcn_readfirstlane(mb[1]), QKV, O, C); cur.jlo = __builtin_amdgcn_readfirstlane(mb[2]);
    __syncthreads();
    att::Seam S;
    att::attn_prime<1>(cur, lds, S);
    for (;;) {
        if (wid == 0) fox_fetch(CNT, NR, C, mb, lane);
        __syncthreads();
        const bool has = __builtin_amdgcn_readfirstlane(mb[3]) != 0;
        att::BlockRef nxt = cur; if (has) { nxt = attn_ref<1>(__builtin_amdgcn_readfirstlane(mb[0]), __builtin_amdgcn_readfirstlane(mb[1]), QKV, O, C); nxt.jlo = __builtin_amdgcn_readfirstlane(mb[2]); }
        att::attn_block<1, DM>(cur, nxt, lds, S);
        if (!has) break;
        cur = nxt;
    }
    __builtin_amdgcn_s_setprio(0);
}
__device__ __forceinline__ void norm_phase(const bf16* QKV, float* NR, int gw, int NGW, int lane) {
    for (int w = gw; w < 2 * 32 * 256; w += NGW) {
        const int which = w >> 13, bh = (w >> 8) & 31, chunk = w & 255, b = bh >> 4, hh = bh & 15;
        const v4u* p = (const v4u*)(QKV + ((size_t)b * SEQ + chunk * 64 + lane) * NQKV + which * DM + hh * 128);
        float ss = 0.f;
#pragma unroll 4
        for (int i = 0; i < 16; ++i) { const v4u v = p[i];
            const float a0 = bf2f((unsigned short)(v.x & 0xffff)), a1 = bf2f((unsigned short)(v.x >> 16)), a2 = bf2f((unsigned short)(v.y & 0xffff)), a3 = bf2f((unsigned short)(v.y >> 16));
            const float a4 = bf2f((unsigned short)(v.z & 0xffff)), a5 = bf2f((unsigned short)(v.z >> 16)), a6 = bf2f((unsigned short)(v.w & 0xffff)), a7 = bf2f((unsigned short)(v.w >> 16));
            ss += (a0 * a0 + a1 * a1) + (a2 * a2 + a3 * a3) + (a4 * a4 + a5 * a5) + (a6 * a6 + a7 * a7); }
        float nrm = sqrtf(ss) * 1.0001f;
#pragma unroll
        for (int o = 1; o < 64; o <<= 1) nrm = fmaxf(nrm, __shfl_xor(nrm, o));
        if (lane == 0) NR[w] = nrm;
    }
}

#define PHASE_BEGIN if (ph >= lo && ph < hi) {
#if defined(PROBE_A)
#define PROBE_STAMP(i) do { if (blockIdx.x == 0 && threadIdx.x == 0) ((unsigned long long*)(args.ws + WS_END))[(i)] = __builtin_amdgcn_s_memrealtime(); } while (0)
#else
#define PROBE_STAMP(i) do { } while (0)
#endif
#define PHASE_END   if (ph + 1 < hi) { if (lo < 0) grid.sync(); xcd_barrier(xbar); } PROBE_STAMP(ph + 1); } ++ph;
template <int layer>
__device__ __forceinline__ void layer_body(const Args& args, cg::grid_group& grid, const XcdBarrier& xbar, unsigned char* lds, int& ph) {
    LAS unsigned char* ldsl = (LAS unsigned char*)lds;
    const int tid = threadIdx.x, lane = tid & 63, wave = __builtin_amdgcn_readfirstlane(tid >> 6);
    const int G = gridDim.x; const int bx = blockIdx.x;
    const int vcu = (G % 8 == 0) ? (bx % 8) * (G / 8) + bx / 8 : bx;
    const int gw = vcu * NWAVES + wave, NGW = G * NWAVES;
    unsigned char* ws = args.ws;
    const float* x_in = args.in[0]; float* X = args.out;
    bf16* Wgu1 = (bf16*)(ws + WS_WGU1); bf16* Wd1 = (bf16*)(ws + WS_WD1); bf16* Wgu2 = (bf16*)(ws + WS_WGU2); bf16* Wd2 = (bf16*)(ws + WS_WD2);
    bf16* Wqkv = (bf16*)(ws + WS_WQKV); bf16* Wo = (bf16*)(ws + WS_WO);
    bf16* XB = (bf16*)(ws + WS_XB); bf16* HB = (bf16*)(ws + WS_BIG); bf16* QKV = (bf16*)(ws + WS_BIG); bf16* OP = (bf16*)(ws + WS_OP);
    float* LF = (float*)(ws + WS_LF); float* CC = (float*)(ws + WS_C); float* NR = (float*)(ws + WS_NR); unsigned* CNT = (unsigned*)(ws + WS_CNT); float* ST = (float*)(ws + WS_ST);
    const int lo = args.ph_lo, hi = args.ph_hi;
        constexpr bool fox = (layer & 1) != 0;
        const float* w1g = args.in[2] + (size_t)layer * DM * FF; const float* w1u = args.in[3] + (size_t)layer * DM * FF; const float* w1d = args.in[4] + (size_t)layer * DM * FF;
        const float* w2g = args.in[5] + (size_t)layer * DM * FF; const float* w2u = args.in[6] + (size_t)layer * DM * FF; const float* w2d = args.in[7] + (size_t)layer * DM * FF;
        const float* lng = args.in[8] + (size_t)layer * 3 * DM; const float* lnb = args.in[9] + (size_t)layer * 3 * DM;
        const float* wqkv_f = fox ? args.in[17] : args.in[10]; const float* wo_f = fox ? args.in[18] : args.in[11];

        PHASE_BEGIN
            LAS float* scr = (LAS float*)(ldsl + wave * 16384);
            constexpr int I_F = (DM / 64) * (FF / 32), I_D = (FF / 64) * (DM / 32), I_Q = (DM / 64) * (NQKV / 32), I_O = (DM / 64) * (DM / 32);
            constexpr int NITEMS = 4 * I_F + 2 * I_D + I_Q + I_O;
            for (int it = gw; it < NITEMS; it += NGW) {
                int r = it;
                if (r < I_F) { transpose_item(w1g, DM, FF, Wgu1, 1, scr, r, lane); continue; } r -= I_F;
                if (r < I_F) { transpose_item(w1u, DM, FF, Wgu1, 2, scr, r, lane); continue; } r -= I_F;
                if (r < I_D) { transpose_item(w1d, FF, DM, Wd1, 0, scr, r, lane); continue; } r -= I_D;
                if (r < I_F) { transpose_item(w2g, DM, FF, Wgu2, 1, scr, r, lane); continue; } r -= I_F;
                if (r < I_F) { transpose_item(w2u, DM, FF, Wgu2, 2, scr, r, lane); continue; } r -= I_F;
                if (r < I_D) { transpose_item(w2d, FF, DM, Wd2, 0, scr, r, lane); continue; } r -= I_D;
                if (r < I_Q) { transpose_item(wqkv_f, DM, NQKV, Wqkv, 0, scr, r, lane); continue; } r -= I_Q;
                transpose_item(wo_f, DM, DM, Wo, 0, scr, r, lane);
            }
            if (fox && bx == 0 && tid < 8) CNT[tid * 64] = 0u;
            if (layer == 0) {
                for (int m = gw; m < M; m += NGW) { const f32x4* xr = (const f32x4*)(x_in + (size_t)m * DM) + lane; v2u* o8 = (v2u*)(XB + (size_t)m * DM) + lane;
#pragma unroll
                    for (int j = 0; j < 8; ++j) { const f32x4 v = xr[64 * j]; v2u w; w.x = pk2(v.x, v.y); w.y = pk2(v.z, v.w); o8[64 * j] = w; } }
            }
            __syncthreads();
        PHASE_END

        PHASE_BEGIN
            pg8::Gemm g{XB, Wgu1, M, 2 * FF, DM}; pg8::StaticOrder S; S.init(M, 2 * FF, G, bx);
            pg8::EpiSwiGLU E{HB, FF};
#ifndef NO_GEMM_SW
            pg8::gemm_phase<pg8::EpiSwiGLU, pg8::StaticOrder, true, true>(ldsl, g, S, E);
#endif
        PHASE_END
        PHASE_BEGIN
            pg8::Gemm g{HB, Wd1, M, DM, FF}; pg8::StaticOrder S; S.init(M, DM, G, bx);
#ifndef NO_GEMM_RES
            if constexpr (layer == 0) { pg8::EpiRes<false> E{x_in, X, DM, ALPHA, 0.5f, nullptr, nullptr, nullptr};
                pg8::gemm_phase<pg8::EpiRes<false>, pg8::StaticOrder, true, true>(ldsl, g, S, E); }
            else { pg8::EpiRes<true> E{X, X, DM, ALPHA, 0.5f, (const pg8::f32x2*)ST, lng - DM, lnb - DM};
                pg8::gemm_phase<pg8::EpiRes<true>, pg8::StaticOrder, true, true>(ldsl, g, S, E); }
#endif
        PHASE_END
        PHASE_BEGIN
            if (fox) ln_phase<true, false>(X, X, XB, ST, lng, lnb, args.in[19], args.in[20], LF, ldsl, gw, NGW, tid, lane);
            else ln_phase<false, false>(X, X, XB, ST, lng, lnb, nullptr, nullptr, nullptr, ldsl, gw, NGW, tid, lane);
        PHASE_END
        PHASE_BEGIN
            if (fox && bx < 32) cumsum_unit(LF, CC, bx, ldsl, tid);
            pg8::Gemm g{XB, Wqkv, M, NQKV, DM}; pg8::StaticOrder S; S.init(M, NQKV, G, bx);
            pg8::EpiBf16S E{QKV, NQKV, DM, QSCALE};
#ifndef NO_GEMM_QKV
            pg8::gemm_phase<pg8::EpiBf16S, pg8::StaticOrder, true, true>(ldsl, g, S, E);
#endif
        PHASE_END
        if (fox) {
        PHASE_BEGIN
            norm_phase(QKV, NR, gw, NGW, lane);
        PHASE_END
        } else { ++ph; }
        PHASE_BEGIN
#ifndef NO_ATT1
            if (fox) fox_phase(QKV, XB, CC, NR, CNT, (char*)lds, tid);
#endif
#ifndef NO_ATT0
            if (!fox) diff_phase(QKV, OP, args.in[1], (char*)lds, tid);
#endif
            __syncthreads();
        PHASE_END
        if (!fox) {
        PHASE_BEGIN
            const float lam_init = 0.8f - 0.6f * expf(-0.3f * (float)layer);
            diff_combine(OP, XB, args.in[12], args.in[13], args.in[14], args.in[15], args.in[16], lam_init, gw, NGW, lane);
        PHASE_END
        } else { ++ph; }
        PHASE_BEGIN
            pg8::Gemm g{XB, Wo, M, DM, DM}; pg8::StaticOrder S; S.init(M, DM, G, bx);
            pg8::EpiRes<true> E{X, X, DM, ALPHA, 1.0f, (const pg8::f32x2*)ST, lng, lnb};
#ifndef NO_GEMM_RES
            pg8::gemm_phase<pg8::EpiRes<true>, pg8::StaticOrder, true, true>(ldsl, g, S, E);
#endif
        PHASE_END
        PHASE_BEGIN
            ln_phase<false, false>(X, X, XB, ST, lng + DM, lnb + DM, nullptr, nullptr, nullptr, ldsl, gw, NGW, tid, lane);
        PHASE_END
        PHASE_BEGIN
            pg8::Gemm g{XB, Wgu2, M, 2 * FF, DM}; pg8::StaticOrder S; S.init(M, 2 * FF, G, bx);
            pg8::EpiSwiGLU E{HB, FF};
#ifndef NO_GEMM_SW
            pg8::gemm_phase<pg8::EpiSwiGLU, pg8::StaticOrder, true, true>(ldsl, g, S, E);
#endif
        PHASE_END
        PHASE_BEGIN
            pg8::Gemm g{HB, Wd2, M, DM, FF}; pg8::StaticOrder S; S.init(M, DM, G, bx);
            pg8::EpiRes<true> E{X, X, DM, ALPHA, 0.5f, (const pg8::f32x2*)ST, lng + DM, lnb + DM};
#ifndef NO_GEMM_RES
            pg8::gemm_phase<pg8::EpiRes<true>, pg8::StaticOrder, true, true>(ldsl, g, S, E);
#endif
        PHASE_END
        PHASE_BEGIN
            ln_phase<false, (layer == DEPTH - 1)>(X, X, XB, ST, lng + 2 * DM, lnb + 2 * DM, nullptr, nullptr, nullptr, ldsl, gw, NGW, tid, lane);
        PHASE_END
    }
#undef PHASE_BEGIN
#undef PHASE_END
__global__ void __launch_bounds__(NTHREADS, 2) fwd_megakernel(Args args) {
    extern __shared__ __attribute__((aligned(16))) unsigned char lds[];
    cg::grid_group grid = cg::this_grid();
    int ph = 0;
    PROBE_STAMP(0);
    volatile LAS unsigned* xst = (volatile LAS unsigned*)((LAS unsigned char*)lds + (LDS_BYTES - 64));
    if (threadIdx.x < 2) xst[threadIdx.x] = 0u;
    __syncthreads();
    const XcdBarrier xbar = xcd_barrier_post((unsigned*)(args.ws + WS_BAR), xst);
    layer_body<0>(args, grid, xbar, lds, ph);
    layer_body<1>(args, grid, xbar, lds, ph);
#if defined(PROBE_A)
    {
        const unsigned long long* ts = (const unsigned long long*)(args.ws + WS_END);
        float* o = args.out + (size_t)blockIdx.x * (size_t)(M / 256) * DM;
        for (int i = threadIdx.x; i < (M / 256) * DM; i += NTHREADS) o[i] = 1000.f;
        __syncthreads();
        if (blockIdx.x == 0 && threadIdx.x == 0) o[0] = (float)(ts[PROBE_A + 1] - ts[PROBE_S]) * 1e-2f;
    }
#endif
}

extern "C" void kernel_launch(void* const* d_in, const int* in_sizes, int n_in, void* d_out, int out_size, void* d_ws, size_t ws_size, hipStream_t stream) {
    static int grid = 0;
    if (grid == 0) {
        if (n_in != 21 || in_sizes[0] != M * DM || out_size != M * DM || ws_size < WS_END) {
            fprintf(stderr, "kernel_launch: unexpected shapes (n_in %d, in0 %d, out %d, ws %zu < %zu); nothing launched\n", n_in, n_in > 0 ? in_sizes[0] : -1, out_size, ws_size, (size_t)WS_END); grid = -1; return; }
        int dev = 0, cus = 0, per_cu = 0;
        (void)hipGetDevice(&dev); (void)hipDeviceGetAttribute(&cus, hipDeviceAttributeMultiprocessorCount, dev);
        if (hipFuncSetAttribute((const void*)fwd_megakernel, hipFuncAttributeMaxDynamicSharedMemorySize, LDS_BYTES) != hipSuccess) { fprintf(stderr, "kernel_launch: hipFuncSetAttribute failed\n"); grid = -1; return; }
        if (hipOccupancyMaxActiveBlocksPerMultiprocessor(&per_cu, (const void*)fwd_megakernel, NTHREADS, LDS_BYTES) != hipSuccess || per_cu < 1) { fprintf(stderr, "kernel_launch: occupancy query says %d\n", per_cu); per_cu = 1; }
        (void)hipGetLastError();
        grid = cus * 1;
        if (grid <= 0) grid = 256;
    }
    if (grid < 0) return;
    Args a{};
    for (int i = 0; i < 21; ++i) a.in[i] = (const float*)d_in[i];
    a.out = (float*)d_out; a.ws = (unsigned char*)d_ws; a.ph_lo = 0; a.ph_hi = 26;
    (void)hipMemsetAsync((unsigned char*)d_ws + WS_BAR, 0, XCD_BAR_WORDS * sizeof(unsigned), stream);
    void* kargs[] = {&a};
    hipError_t e = hipLaunchCooperativeKernel((const void*)fwd_megakernel, dim3(grid), dim3(NTHREADS), kargs, LDS_BYTES, stream);
    if (e != hipSuccess) fprintf(stderr, "kernel_launch: cooperative launch failed: %s (grid %d)\n", hipGetErrorString(e), grid);
}
```

```cpp
#include <hip/hip_runtime.h>
#include <hip/hip_cooperative_groups.h>
#include <hip/hip_bf16.h>
#include <cstdio>
#include <cstdint>
#include <cmath>
namespace pg8 {
#define PG8_LAS __attribute__((address_space(3)))
typedef unsigned short bf16_t;
typedef short bf16x8 __attribute__((ext_vector_type(8)));
typedef float f32x4 __attribute__((ext_vector_type(4)));
typedef unsigned u32x4 __attribute__((ext_vector_type(4)));
constexpr int BM = 256, BK = 64, HALF = 128, HTB = HALF * BK * 2  , STAGE_BYTES = 8 * HTB, NXCD = 8, WGM = 8;

__host__ __device__ __forceinline__ int lds_byte(int r, int c) { const int st = (r >> 4) * 2 + (c >> 5), rr = r & 15, cc = c & 31, ob = rr * 64 + cc * 2; return st * 1024 + (ob ^ (((ob >> 9) & 1) << 5)); }
__host__ __device__ __forceinline__ void stage_rc(int b, int& R, int& C) { const int st = b / 1024, sb = b % 1024, swz = sb ^ (((sb >> 9) & 1) << 5); R = (st >> 1) * 16 + swz / 64; C = (st & 1) * 32 + (swz % 64) / 2; }
__host__ __device__ __forceinline__ int perm32(int rho) { const int n = rho >> 4, i = rho & 15; return 8 * (i >> 2) + 4 * n + (i & 3); }

struct Unit { int pm, pn; };
struct Gemm { const bf16_t* A; const bf16_t* Bt; int M, N, K; };

struct StaticOrder {
    int nM, nN, nwg, G, c;
    __host__ __device__ void init(int M, int N, int G_, int c_) { nM = M / BM; nN = N / BM; nwg = nM * nN; G = G_; c = c_; }
    __host__ __device__ bool next(int i, Unit& u) const {
        const long L = (long)i * G + c; if (L >= nwg) return false;
        int wgid = (int)L; { const int q = nwg / NXCD, r = nwg % NXCD, xcd = wgid % NXCD, off = wgid / NXCD; wgid = (xcd < r ? xcd * (q + 1) : r * (q + 1) + (xcd - r) * q) + off; }
        const int nig = WGM * nN, gid = wgid / nig, fm = gid * WGM, gsz = (nM - fm) < WGM ? (nM - fm) : WGM;
        u.pm = fm + ((wgid % nig) % gsz); u.pn = (wgid % nig) / gsz; return true;
    }
    __device__ __forceinline__ void a_ready(const Unit&) const {}
    __device__ __forceinline__ void done(const Unit&) const {}
};

__device__ __forceinline__ unsigned cvt_pk_bf16(float lo, float hi) { unsigned r; asm volatile("v_cvt_pk_bf16_f32 %0, %1, %2" : "=v"(r) : "v"(lo), "v"(hi)); return r; }
typedef float f32x2 __attribute__((ext_vector_type(2)));
struct EpiBf16S {
    static constexpr bool PERM = true, AFTER_DRAIN = false;
    bf16_t* O; int ldc; int scale_cols; float scale0;
    __device__ __forceinline__ void operator()(const f32x4 (&acc)[2][2][4][2], const Unit& u, int wr, int wc, int fr, int fq) const {
        const int row0 = u.pm * BM + wr * 64 + fr; const int colt = u.pn * BM;
        const float sc = (colt < scale_cols) ? scale0 : 1.f;
        const int col0 = colt + wc * 32 + 8 * fq;
#pragma unroll
        for (int ai = 0; ai < 2; ++ai)
#pragma unroll
            for (int m = 0; m < 4; ++m) { bf16_t* rowp = O + (size_t)(row0 + ai * HALF + m * 16) * ldc + col0;
#pragma unroll
                for (int bj = 0; bj < 2; ++bj) { f32x4 v0 = acc[ai][bj][m][0] * sc, v1 = acc[ai][bj][m][1] * sc;
                    u32x4 w; w.x = cvt_pk_bf16(v0[0], v0[1]); w.y = cvt_pk_bf16(v0[2], v0[3]); w.z = cvt_pk_bf16(v1[0], v1[1]); w.w = cvt_pk_bf16(v1[2], v1[3]);
                    *(u32x4*)(rowp + bj * HALF) = w; } }
    }
};
__device__ __forceinline__ float silu_mul(float g, float u) { return g * __builtin_amdgcn_rcpf(1.f + __builtin_amdgcn_exp2f(-1.4426950408889634f * g)) * u; }
struct EpiSwiGLU {
    static constexpr bool PERM = true, AFTER_DRAIN = false;
    bf16_t* H; int ldh;
    __device__ __forceinline__ void operator()(const f32x4 (&acc)[2][2][4][2], const Unit& u, int wr, int wc, int fr, int fq) const {
        const int row0 = u.pm * BM + wr * 64 + fr; const int col0 = u.pn * HALF + wc * 32 + 8 * fq;
#pragma unroll
        for (int ai = 0; ai < 2; ++ai)
#pragma unroll
            for (int m = 0; m < 4; ++m) { bf16_t* rowp = H + (size_t)(row0 + ai * HALF + m * 16) * ldh + col0;
                const f32x4 g0 = acc[ai][0][m][0], g1 = acc[ai][0][m][1], u0 = acc[ai][1][m][0], u1 = acc[ai][1][m][1];
                u32x4 w;
                w.x = cvt_pk_bf16(silu_mul(g0[0], u0[0]), silu_mul(g0[1], u0[1])); w.y = cvt_pk_bf16(silu_mul(g0[2], u0[2]), silu_mul(g0[3], u0[3]));
                w.z = cvt_pk_bf16(silu_mul(g1[0], u1[0]), silu_mul(g1[1], u1[1])); w.w = cvt_pk_bf16(silu_mul(g1[2], u1[2]), silu_mul(g1[3], u1[3]));
                *(u32x4*)rowp = w; }
    }
};
template <bool LNB> struct EpiRes {
    static constexpr bool PERM = false, AFTER_DRAIN = false;
    const float* base; float* out; int ldc; float alpha, s; const f32x2* st; const float* g; const float* b;
    __device__ __forceinline__ void operator()(const f32x4 (&acc)[2][2][4][2], const Unit& u, int wr, int wc, int fr, int fq) const {
        const int row0 = u.pm * BM + wr * 64 + fr; const int col0 = u.pn * BM + wc * 32 + 4 * fq;
        f32x2 mr[2][4];
        if (LNB) {
#pragma unroll
            for (int ai = 0; ai < 2; ++ai)
#pragma unroll
                for (int m = 0; m < 4; ++m) mr[ai][m] = st[row0 + ai * HALF + m * 16];
        }
#pragma unroll
        for (int bj = 0; bj < 2; ++bj)
#pragma unroll
            for (int n = 0; n < 2; ++n) { const int cc = col0 + bj * HALF + n * 16;
                f32x4 gv = {1.f, 1.f, 1.f, 1.f}, bv = {0.f, 0.f, 0.f, 0.f}; if (LNB) { gv = *(const f32x4*)(g + cc); bv = *(const f32x4*)(b + cc); }
#pragma unroll
                for (int ai = 0; ai < 2; ++ai)
#pragma unroll
                    for (int m = 0; m < 4; ++m) { const size_t off = (size_t)(row0 + ai * HALF + m * 16) * ldc + cc;
                        f32x4 y = *(const f32x4*)(base + off);
                        if (LNB) y = (y - mr[ai][m].x) * mr[ai][m].y * gv + bv;
                        const f32x4 o = y * alpha + acc[ai][bj][m][n] * s; *(f32x4*)(out + off) = o; }
                asm volatile("" ::: "memory"); }
    }
};
template <class Epi, class Sched, bool ALIGN_EPI = false, bool SP2 = false>
__device__ __forceinline__ void gemm_phase(PG8_LAS unsigned char* lds, const Gemm g, const Sched& S, const Epi& E) {
    const int tid = threadIdx.x, wid = __builtin_amdgcn_readfirstlane(tid >> 6), lane = tid & 63, wr = wid >> 2, wc = wid & 3, fr = lane & 15, fq = lane >> 4;
    const int K = g.K, nt = K / BK;
    unsigned voffA[2], voffB[2];
#pragma unroll
    for (int i = 0; i < 2; ++i) { int R, C; stage_rc(tid * 16 + i * 8192, R, C); const int Rb = Epi::PERM ? ((R & ~31) + perm32(R & 31)) : R;
        voffA[i] = (unsigned)(R * K + C) * 2u; voffB[i] = (unsigned)(Rb * K + C) * 2u; }
    const size_t kstep = (size_t)(BK * 2);
    const size_t hstep = (size_t)HALF * K * 2;
    const size_t tstep = 2 * hstep;
    const unsigned ldsw = (unsigned)wid * 1024u;
    const int aoff = lds_byte(wr * 64 + fr, fq * 8), boff = lds_byte(wc * 32 + fr, fq * 8);
#define PG8_SA(b, h) (((b) * 2 + (h)) * HTB)
#define PG8_SB(b, h) ((4 + (b) * 2 + (h)) * HTB)
#define PG8_STAGE(bufoff, gbase, voff) do { _Pragma("unroll") for (int _i = 0; _i < 2; ++_i) \
        __builtin_amdgcn_global_load_lds((const unsigned*)((const char*)(gbase) + (voff)[_i]), (PG8_LAS unsigned*)(lds + (bufoff) + ldsw + _i * 8192), 16, 0, 0); } while (0)
#define PG8_LDA(dst, b, h) do { _Pragma("unroll") for (int m = 0; m < 4; ++m) _Pragma("unroll") for (int k = 0; k < 2; ++k) dst[m][k] = *(const PG8_LAS bf16x8*)(lds + PG8_SA(b, h) + aoff + m * 2048 + k * 1024); } while (0)
#define PG8_LDB(dst, b, h) do { _Pragma("unroll") for (int n = 0; n < 2; ++n) _Pragma("unroll") for (int k = 0; k < 2; ++k) dst[n][k] = *(const PG8_LAS bf16x8*)(lds + PG8_SB(b, h) + boff + n * 2048 + k * 1024); } while (0)
#define PG8_MMA(ai, bj, At, Bt) do { __builtin_amdgcn_s_setprio(1); _Pragma("unroll") for (int m = 0; m < 4; ++m) _Pragma("unroll") for (int n = 0; n < 2; ++n) _Pragma("unroll") for (int k = 0; k < 2; ++k) \
        acc[ai][bj][m][n] = __builtin_amdgcn_mfma_f32_16x16x32_bf16(Bt[n][k], At[m][k], acc[ai][bj][m][n], 0, 0, 0); __builtin_amdgcn_s_setprio(0); } while (0)
#define PG8_WAIT_V(n) asm volatile("s_waitcnt vmcnt(" #n ")" ::: "memory")
#define PG8_WAIT_L(n) asm volatile("s_waitcnt lgkmcnt(" #n ")" ::: "memory")
#define PG8_BAR __builtin_amdgcn_s_barrier()
#define PG8_SCHED __builtin_amdgcn_sched_barrier(0)
    Unit cur, nxt; int ui = 0;
    if (!S.next(0, cur)) return;
    f32x4 acc[2][2][4][2];
#pragma unroll
    for (int a = 0; a < 2; ++a)
#pragma unroll
        for (int b = 0; b < 2; ++b)
#pragma unroll
            for (int m = 0; m < 4; ++m)
#pragma unroll
                for (int n = 0; n < 2; ++n) acc[a][b][m][n] = (f32x4){0.f, 0.f, 0.f, 0.f};
    bf16x8 At[4][2], B0[2][2], B1[2][2];
    const char* cA = (const char*)g.A + (size_t)cur.pm * tstep; const char* cB = (const char*)g.Bt + (size_t)cur.pn * tstep;
    S.a_ready(cur);
    if constexpr (SP2) {
        PG8_STAGE(PG8_SB(0, 0), cB, voffB); PG8_STAGE(PG8_SB(0, 1), cB + hstep, voffB); PG8_STAGE(PG8_SA(0, 0), cA, voffA); PG8_STAGE(PG8_SA(0, 1), cA + hstep, voffA);
        if (wr == 1) PG8_BAR;
        PG8_WAIT_V(2); PG8_BAR;
        PG8_STAGE(PG8_SB(1, 0), cB + kstep, voffB); PG8_STAGE(PG8_SA(1, 0), cA + kstep, voffA); PG8_STAGE(PG8_SB(1, 1), cB + hstep + kstep, voffB);
        PG8_WAIT_V(6); PG8_BAR;
    } else {
        PG8_STAGE(PG8_SB(0, 0), cB, voffB); PG8_STAGE(PG8_SA(0, 0), cA, voffA); PG8_STAGE(PG8_SB(0, 1), cB + hstep, voffB); PG8_STAGE(PG8_SA(0, 1), cA + hstep, voffA);
        if (wr == 1) PG8_BAR;
        PG8_WAIT_V(4); PG8_BAR;
        PG8_STAGE(PG8_SB(1, 0), cB + kstep, voffB); PG8_STAGE(PG8_SA(1, 0), cA + kstep, voffA); PG8_STAGE(PG8_SB(1, 1), cB + hstep + kstep, voffB);
        PG8_WAIT_V(6); PG8_BAR;
    }
    for (;;) {
        const bool has_next = S.next(ui + 1, nxt);
        const char* nA = has_next ? (const char*)g.A + (size_t)nxt.pm * tstep : cA; const char* nB = has_next ? (const char*)g.Bt + (size_t)nxt.pn * tstep : cB;
        for (int t = 0; t < nt; t += 2) {
            const bool last = (t == nt - 2);
            const char* a1 = cA + (size_t)(t + 1) * kstep;
            const char* a2 = last ? nA : cA + (size_t)(t + 2) * kstep; const char* b2 = last ? nB : cB + (size_t)(t + 2) * kstep;
            const char* a3 = a2 + kstep; const char* b3 = b2 + kstep;
            if (last && has_next) S.a_ready(nxt);
            if constexpr (SP2) {
            PG8_LDB(B0, 0, 0); PG8_LDB(B1, 0, 1); PG8_SCHED; PG8_LDA(At, 0, 0); PG8_STAGE(PG8_SA(1, 1), a1 + hstep, voffA);
            PG8_WAIT_V(8); PG8_WAIT_L(0); PG8_BAR; PG8_MMA(0, 0, At, B0); PG8_MMA(0, 1, At, B1); PG8_BAR; PG8_SCHED;
            PG8_LDA(At, 0, 1); PG8_STAGE(PG8_SB(0, 0), b2, voffB); PG8_STAGE(PG8_SB(0, 1), b2 + hstep, voffB); PG8_STAGE(PG8_SA(0, 0), a2, voffA);
            PG8_WAIT_V(8); PG8_WAIT_L(0); PG8_BAR; PG8_MMA(1, 0, At, B0); PG8_MMA(1, 1, At, B1); PG8_BAR; PG8_SCHED;
            PG8_LDB(B0, 1, 0); PG8_LDB(B1, 1, 1); PG8_SCHED; PG8_LDA(At, 1, 0); PG8_STAGE(PG8_SA(0, 1), a2 + hstep, voffA);
            PG8_WAIT_V(8); PG8_WAIT_L(0); PG8_BAR; PG8_MMA(0, 0, At, B0); PG8_MMA(0, 1, At, B1); PG8_BAR; PG8_SCHED;
            PG8_LDA(At, 1, 1); PG8_STAGE(PG8_SB(1, 0), b3, voffB); PG8_STAGE(PG8_SB(1, 1), b3 + hstep, voffB); PG8_STAGE(PG8_SA(1, 0), a3, voffA);
            PG8_WAIT_V(8); PG8_WAIT_L(0); PG8_BAR; PG8_MMA(1, 0, At, B0); PG8_MMA(1, 1, At, B1); PG8_BAR; PG8_SCHED;
            } else {
            PG8_LDB(B0, 0, 0); PG8_SCHED; PG8_LDA(At, 0, 0); PG8_STAGE(PG8_SA(1, 1), a1 + hstep, voffA);
            PG8_WAIT_L(8); PG8_BAR; PG8_WAIT_L(0); PG8_MMA(0, 0, At, B0); PG8_BAR; PG8_SCHED;
            PG8_LDB(B1, 0, 1); PG8_STAGE(PG8_SB(0, 0), b2, voffB);
            PG8_BAR; PG8_WAIT_L(0); PG8_MMA(0, 1, At, B1); PG8_BAR;
            PG8_LDA(At, 0, 1); PG8_STAGE(PG8_SA(0, 0), a2, voffA);
            PG8_BAR; PG8_WAIT_L(0); PG8_MMA(1, 0, At, B0); PG8_BAR; PG8_SCHED;
            PG8_STAGE(PG8_SB(0, 1), b2 + hstep, voffB);
            PG8_WAIT_V(6); PG8_BAR; PG8_MMA(1, 1, At, B1); PG8_BAR;
            PG8_LDB(B0, 1, 0); PG8_SCHED; PG8_LDA(At, 1, 0); PG8_STAGE(PG8_SA(0, 1), a2 + hstep, voffA);
            PG8_WAIT_L(8); PG8_BAR; PG8_WAIT_L(0); PG8_MMA(0, 0, At, B0); PG8_BAR; PG8_SCHED;
            PG8_LDB(B1, 1, 1); PG8_STAGE(PG8_SB(1, 0), b3, voffB);
            PG8_BAR; PG8_WAIT_L(0); PG8_MMA(0, 1, At, B1); PG8_BAR;
            PG8_LDA(At, 1, 1); PG8_STAGE(PG8_SA(1, 0), a3, voffA);
            PG8_BAR; PG8_WAIT_L(0); PG8_MMA(1, 0, At, B0); PG8_BAR; PG8_SCHED;
            PG8_STAGE(PG8_SB(1, 1), b3 + hstep, voffB);
            PG8_WAIT_V(6); PG8_BAR; PG8_MMA(1, 1, At, B1); PG8_BAR;
            }
        }
        if constexpr (ALIGN_EPI) { if (wr == 0) PG8_BAR; }
        if constexpr (!Epi::AFTER_DRAIN) { E(acc, cur, wr, wc, fr, fq); S.done(cur); }
        if (!has_next) break;
#pragma unroll
        for (int a = 0; a < 2; ++a)
#pragma unroll
            for (int b = 0; b < 2; ++b)
#pragma unroll
                for (int m = 0; m < 4; ++m)
#pragma unroll
                    for (int n = 0; n < 2; ++n) acc[a][b][m][n] = (f32x4){0.f, 0.f, 0.f, 0.f};
        cur = nxt; cA = nA; cB = nB; ++ui;
        if constexpr (ALIGN_EPI) { if (wr == 1) PG8_BAR; }
    }
    PG8_WAIT_V(0);
    if constexpr (!ALIGN_EPI) { if (wr == 0) PG8_BAR; }
    PG8_BAR;
    if constexpr (Epi::AFTER_DRAIN) { E.fused(acc, cur, wr, wc, fr, fq, lds, wid, lane); S.done(cur); }
#undef PG8_SA
#undef PG8_SB
#undef PG8_STAGE
#undef PG8_LDA
#undef PG8_LDB
#undef PG8_MMA
#undef PG8_WAIT_V
#undef PG8_WAIT_L
#undef PG8_BAR
#undef PG8_SCHED
}
}
namespace att {
using bf16 = __hip_bfloat16;
typedef short bf16x8 __attribute__((ext_vector_type(8)));
typedef short s16x4 __attribute__((ext_vector_type(4)));
typedef float f32x16 __attribute__((ext_vector_type(16)));
typedef float f32x4 __attribute__((ext_vector_type(4)));
typedef unsigned u32x4 __attribute__((ext_vector_type(4)));
constexpr int D = 128, NW = 8, QBLK = 32, KVBLK = 64, QB = NW * QBLK;
constexpr int SHM_V = KVBLK * D * 2, SHM_K = KVBLK * D * 2;
constexpr int OFF_WS = 2 * SHM_V + 2 * SHM_K;
constexpr int OFF_CK = OFF_WS + NW * 64 * 4;
constexpr int OFF_BT = OFF_CK + 512;
constexpr int LDS_BYTES = OFF_BT + 8 * 128 * 4;
constexpr int LDQ = 6144;
constexpr float THR2 = 11.5f;
constexpr float LOG2E = 1.4426950408889634f;
constexpr unsigned WBIG = 1u << 30;

#define KSWZ(row, colB) ((row) * 256 + ((colB) ^ (((row) & 7) << 4)))
#define SBAR() __builtin_amdgcn_sched_barrier(0)
__device__ __forceinline__ int v_st(int k, int c) { const int kk = (k & ~0xC) | ((k & 4) << 1) | ((k & 8) >> 1); return ((kk >> 3) * 4 + (c >> 5)) * 512 + ((kk & 7) * 32 + (c & 31)) * 2; }
__device__ __forceinline__ int v_rd_base(int lane) { return ((lane & 3) << 3) | (((lane >> 2) & 3) << 6) | (((lane >> 4) & 1) << 5) | (((lane >> 5) & 1) << 8); }
constexpr int v_rd_off(int d0, int ks, int half) { return d0 * 512 + ks * 4096 + half * 2048; }
__device__ __forceinline__ int crow(int r, int hi) { return (r & 3) + 8 * (r >> 2) + 4 * hi; }
__device__ __forceinline__ unsigned cvtpk(float lo, float hi) { unsigned r; asm volatile("v_cvt_pk_bf16_f32 %0, %1, %2" : "=v"(r) : "v"(lo), "v"(hi)); return r; }
__device__ __forceinline__ bf16x8 load8(const bf16* p) { return *reinterpret_cast<const bf16x8*>(p); }
__device__ __forceinline__ void mask_tile(f32x16& p0, f32x16& p1, int dq, unsigned W) {
    const float NEG = -__builtin_inff();
#pragma unroll
    for (int r = 0; r < 16; ++r) {
        const int c = (r & 3) + 8 * (r >> 2);
        if ((unsigned)(dq - c) >= W) p0[r] = NEG;
        if ((unsigned)(dq - c - 32) >= W) p1[r] = NEG;
    }
}
__device__ __forceinline__ void partialSM(f32x16& p0, f32x16& p1, float& m_reg, float& mn, float& alpha) {
    float mx0 = fmaxf(p0[0], p1[0]), mx1 = fmaxf(p0[1], p1[1]), mx2 = fmaxf(p0[2], p1[2]), mx3 = fmaxf(p0[3], p1[3]);
    for (int r = 4; r < 16; r += 4) { mx0 = fmaxf(mx0, fmaxf(p0[r], p1[r])); mx1 = fmaxf(mx1, fmaxf(p0[r + 1], p1[r + 1])); mx2 = fmaxf(mx2, fmaxf(p0[r + 2], p1[r + 2])); mx3 = fmaxf(mx3, fmaxf(p0[r + 3], p1[r + 3])); }
    float pmax = fmaxf(fmaxf(mx0, mx1), fmaxf(mx2, mx3));
    { auto rr = __builtin_amdgcn_permlane32_swap(__float_as_uint(pmax), __float_as_uint(pmax), false, false);
      pmax = fmaxf(__uint_as_float(rr[0]), __uint_as_float(rr[1])); }
    if (__builtin_expect(__all((pmax - m_reg) <= THR2), 1)) { mn = m_reg; alpha = 1.f; }
    else { mn = fmaxf(m_reg, pmax); alpha = __builtin_amdgcn_exp2f(m_reg - mn); m_reg = mn; }
    for (int r = 0; r < 16; ++r) p0[r] = p0[r] - mn; for (int r = 0; r < 16; ++r) p1[r] = p1[r] - mn;
    for (int r = 0; r < 16; ++r) p0[r] = __builtin_amdgcn_exp2f(p0[r]);
}
__device__ __forceinline__ void finishSM(f32x16& p0, f32x16& p1, float alpha, float& l_reg, bf16x8& pa0, bf16x8& pa1, bf16x8& pa2, bf16x8& pa3) {
    for (int r = 0; r < 16; ++r) p1[r] = __builtin_amdgcn_exp2f(p1[r]);
    float ps0 = p0[0] + p1[0], ps1 = p0[1] + p1[1], ps2 = p0[2] + p1[2], ps3 = p0[3] + p1[3];
    for (int r = 4; r < 16; r += 4) { ps0 += p0[r] + p1[r]; ps1 += p0[r + 1] + p1[r + 1]; ps2 += p0[r + 2] + p1[r + 2]; ps3 += p0[r + 3] + p1[r + 3]; }
    float ps = (ps0 + ps1) + (ps2 + ps3);
    { auto rr = __builtin_amdgcn_permlane32_swap(__float_as_uint(ps), __float_as_uint(ps), false, false);
      ps = __uint_as_float(rr[0]) + __uint_as_float(rr[1]); }
    l_reg = l_reg * alpha + ps;
#define PK4(P, B_, OUT) do { unsigned a0 = cvtpk(P[B_+0], P[B_+1]), a1 = cvtpk(P[B_+2], P[B_+3]);                          \
        unsigned b0 = cvtpk(P[B_+4], P[B_+5]), b1 = cvtpk(P[B_+6], P[B_+7]);                                             \
        auto r0 = __builtin_amdgcn_permlane32_swap(a0, b0, false, false); auto r1 = __builtin_amdgcn_permlane32_swap(a1, b1, false, false); \
        u32x4 w = {r0[0], r1[0], r0[1], r1[1]}; OUT = *reinterpret_cast<bf16x8*>(&w); } while (0)
    PK4(p0, 0, pa0); PK4(p0, 8, pa1); PK4(p1, 0, pa2); PK4(p1, 8, pa3);
#undef PK4
}
template <int KB, int MODE>
__device__ __forceinline__ void qkt(f32x16& p0, f32x16& p1, const char* K_lds, const char* lds, int r32, int hi, const bf16x8* qr, bool near, int dq, int bt) {
    if constexpr (MODE == 1) {
        const f32x4* cp = (const f32x4*)(lds + OFF_CK + KB * 256 + hi * 16);
#pragma unroll
        for (int i = 0; i < 4; ++i) { const f32x4 a = cp[2 * i], b = cp[2 * i + 8];
            p0[4 * i] = a[0]; p0[4 * i + 1] = a[1]; p0[4 * i + 2] = a[2]; p0[4 * i + 3] = a[3];
            p1[4 * i] = b[0]; p1[4 * i + 1] = b[1]; p1[4 * i + 2] = b[2]; p1[4 * i + 3] = b[3]; }
    } else {
        if (near) { const float* btp = (const float*)(lds + bt);
#pragma unroll
            for (int r = 0; r < 16; ++r) { const int c = (r & 3) + 8 * (r >> 2); int d0 = dq - c, d1 = dq - c - 32;
                d0 = d0 < 0 ? 0 : (d0 > 127 ? 127 : d0); d1 = d1 < 0 ? 0 : (d1 > 127 ? 127 : d1);
                p0[r] = btp[d0]; p1[r] = btp[d1]; } }
        else { p0 = f32x16{}; p1 = f32x16{}; }
    }
    const char* kb[4];
#pragma unroll
    for (int dd = 0; dd < 4; ++dd) kb[dd] = K_lds + KB * SHM_K + KSWZ(r32, (dd * 16 + hi * 8) * 2);
#pragma unroll
    for (int d0 = 0; d0 < 8; ++d0) { const char* a = kb[d0 & 3] + (d0 >> 2) * 128;
        bf16x8 b0 = *reinterpret_cast<const bf16x8*>(a);
        bf16x8 b1 = *reinterpret_cast<const bf16x8*>(a + 32 * 256);
        p0 = __builtin_amdgcn_mfma_f32_32x32x16_bf16(b0, qr[d0], p0, 0, 0, 0);
        p1 = __builtin_amdgcn_mfma_f32_32x32x16_bf16(b1, qr[d0], p1, 0, 0, 0); }
}
template <int VB>
__device__ __forceinline__ void pv_tile(f32x16* o, int vb0, bf16x8 pa0, bf16x8 pa1, bf16x8 pa2, bf16x8 pa3) {
#define TRRD(dst, off) asm volatile("ds_read_b64_tr_b16 %0, %1 offset:%2" : "=&v"(dst) : "v"(vb0), "i"(off) : "memory")
#define PV_D0(d0) do { s16x4 l0, l1, l2, l3, h0, h1, h2, h3; constexpr int b_ = VB * SHM_V + v_rd_off(d0, 0, 0); \
        TRRD(l0, b_); TRRD(h0, b_ + 2048); TRRD(l1, b_ + 4096); TRRD(h1, b_ + 6144); TRRD(l2, b_ + 8192); TRRD(h2, b_ + 10240); TRRD(l3, b_ + 12288); TRRD(h3, b_ + 14336); \
        asm volatile("s_waitcnt lgkmcnt(0)" ::: "memory"); SBAR();   \
        o[d0] = __builtin_amdgcn_mfma_f32_32x32x16_bf16(pa0, (bf16x8){l0[0], l0[1], l0[2], l0[3], h0[0], h0[1], h0[2], h0[3]}, o[d0], 0, 0, 0);   \
        o[d0] = __builtin_amdgcn_mfma_f32_32x32x16_bf16(pa1, (bf16x8){l1[0], l1[1], l1[2], l1[3], h1[0], h1[1], h1[2], h1[3]}, o[d0], 0, 0, 0);   \
        o[d0] = __builtin_amdgcn_mfma_f32_32x32x16_bf16(pa2, (bf16x8){l2[0], l2[1], l2[2], l2[3], h2[0], h2[1], h2[2], h2[3]}, o[d0], 0, 0, 0);   \
        o[d0] = __builtin_amdgcn_mfma_f32_32x32x16_bf16(pa3, (bf16x8){l3[0], l3[1], l3[2], l3[3], h3[0], h3[1], h3[2], h3[3]}, o[d0], 0, 0, 0); } while (0)
    PV_D0(0); PV_D0(1); PV_D0(2); PV_D0(3);
#undef PV_D0
#undef TRRD
}

struct BlockRef { const bf16* Q; const bf16* K; const bf16* V; bf16* O; const float* C; int P0; int bt; int jlo; };
struct Seam { bf16x8 qr[8]; bf16x8 st_v0, st_v1, st_k0, st_k1; float st_c; };
#define ROW(p, k0, rr) ((p) + (unsigned)(((k0) + (rr)) * LDQ + sc))
#define VMW() asm volatile("s_waitcnt vmcnt(0)" ::: "memory")
#define VMWN(n) asm volatile("s_waitcnt vmcnt(%0)" :: "i"(n) : "memory")
#define SLOAD_H(Kp, Vp, Cp, k0) do { S.st_v0 = load8(ROW(Vp, k0, sr)); S.st_v1 = load8(ROW(Vp, k0, 32 + sr));              \
                         S.st_k0 = load8(ROW(Kp, k0, sr)); S.st_k1 = load8(ROW(Kp, k0, 32 + sr));                        \
                         if (MODE == 1 && wid == 0) S.st_c = (Cp)[(k0) + lane]; } while (0)
#define SWRITE_HK(bf, cr) do { *(bf16x8*)(K_lds + (bf) * SHM_K + kws) = S.st_k0; *(bf16x8*)(K_lds + (bf) * SHM_K + kws + 32 * 256) = S.st_k1; \
                         if (MODE == 1 && wid == 0) ((float*)(lds + OFF_CK))[(bf) * 64 + lane] = ((cr) - S.st_c) * LOG2E; } while (0)
#define SWRITE_HV(bf) do { *(bf16x8*)(V_lds + (bf) * SHM_V + vst0) = S.st_v0; *(bf16x8*)(V_lds + (bf) * SHM_V + vst0 + 8192) = S.st_v1; } while (0)
#define SWRITE_H(bf, cr) do { SWRITE_HV(bf); SWRITE_HK(bf, cr); } while (0)
template <int MODE>
__device__ __forceinline__ void attn_prime(const BlockRef& cur, char* lds, Seam& S) {
    const int tid = threadIdx.x, wid = __builtin_amdgcn_readfirstlane(tid >> 6), lane = tid & 63, r32 = lane & 31, hi = lane >> 5;
    const int sr = tid >> 4, sc = (tid & 15) * 8, kws = KSWZ(sr, sc * 2); char* K_lds = lds + 2 * SHM_V;
    float cref = 0.f; if (MODE == 1) cref = cur.C[cur.P0];
    for (int d0 = 0; d0 < 8; ++d0) S.qr[d0] = load8(cur.Q + (size_t)(wid * QBLK + r32) * LDQ + d0 * 16 + hi * 8);
    SLOAD_H(cur.K, cur.V, cur.C, cur.jlo * KVBLK); VMW(); SWRITE_HK(0, cref);
    __syncthreads();
}
template <int MODE, int LDO>
__device__ __forceinline__ void attn_block(const BlockRef& cur, const BlockRef& nxt, char* lds, Seam& S) {
    const int tid = threadIdx.x, wid = __builtin_amdgcn_readfirstlane(tid >> 6), lane = tid & 63, r32 = lane & 31, hi = lane >> 5;
    const int j_lo = cur.jlo, NT = (cur.P0 + QB - 1) / KVBLK + 1 - j_lo;
    const int kbn = nxt.jlo * KVBLK;
    const int qlo = cur.P0 + wid * QBLK, qm = qlo + r32 - 4 * hi;
    char* V_lds = lds; char* K_lds = lds + 2 * SHM_V;
    float* ws = (float*)(lds + OFF_WS) + wid * 64; float* li_l = ws, * al_l = ws + 32;
    float m_reg = -1e30f, l_reg = 0; f32x16 o[4] = {};
    const int sr = tid >> 4, sc = (tid & 15) * 8, vst0 = v_st(sr, sc), kws = KSWZ(sr, sc * 2);
    const int vb0 = (int)(uintptr_t)V_lds + v_rd_base(lane);
    const bf16* Kh = cur.K; const bf16* Vh = cur.V; const float* Ch = cur.C;
    float cref = 0.f, crefn = 0.f; if (MODE == 1) { cref = cur.C[cur.P0]; crefn = nxt.C[nxt.P0]; }
    const int bt = cur.bt;
#define RESC(a) do { if (__any((a) < 1.f)) { if (hi == 0) al_l[r32] = (a); asm volatile("s_waitcnt lgkmcnt(0)" ::: "memory");              \
                     for (int d_ = 0; d_ < 4; ++d_) for (int r = 0; r < 16; ++r) o[d_][r] *= al_l[crow(r, hi)]; } } while (0)
#define KBASE(t) ((j_lo + (t)) * KVBLK)
#define NEAR(t) (KBASE(t) + 191 > qlo)
#define MASKT(P0_, P1_, t) do { const int kb_ = KBASE(t); if (kb_ + KVBLK - 1 > qlo) mask_tile(P0_, P1_, qm - kb_, WBIG); } while (0)
#define QKT(KB, PX0, PX1, t) qkt<KB, MODE>(PX0, PX1, K_lds, lds, r32, hi, S.qr, NEAR(t), qm - KBASE(t), bt)
    constexpr int NQL = 8;
#define SEAM_K0() do { VMWN(NQL); SWRITE_HK(0, crefn); SBAR(); } while (0)
    f32x16 pA0, pA1, pB0, pB1; float mnA, mnB, alA, alB; bf16x8 pa0, pa1, pa2, pa3;
    SWRITE_HV(0); SBAR();
    if (NT > 1) { SLOAD_H(Kh, Vh, Ch, KBASE(1)); }
    SBAR(); QKT(0, pA0, pA1, 0);
    MASKT(pA0, pA1, 0); partialSM(pA0, pA1, m_reg, mnA, alA);
    if (NT > 1) { VMW(); SWRITE_H(1, cref); }
    __syncthreads();
#define HALF_STEP(PX0, PX1, mnX, alX, PY0, PY1, alY, t, KB, VB, SB) do {                                                      \
        SBAR(); QKT(KB, PX0, PX1, t);                                                                                         \
        finishSM(PY0, PY1, alY, l_reg, pa0, pa1, pa2, pa3); SBAR();                                                           \
        if ((t) + 1 < NT) { SLOAD_H(Kh, Vh, Ch, KBASE((t) + 1)); SBAR(); }                                                    \
        pv_tile<VB>(o, vb0, pa0, pa1, pa2, pa3); MASKT(PX0, PX1, (t)); partialSM(PX0, PX1, m_reg, mnX, alX);                  \
        __syncthreads();                                                                                                      \
        if ((t) + 1 < NT) { VMW(); SWRITE_H(SB, cref); }                                                                      \
        RESC(alX); __syncthreads(); } while (0)
    for (int t = 1; t + 1 < NT; t += 2) {
        HALF_STEP(pB0, pB1, mnB, alB, pA0, pA1, alA, t, 1, 0, 0);
        HALF_STEP(pA0, pA1, mnA, alA, pB0, pB1, alB, t + 1, 0, 1, 1);
    }
    const bool even = (NT & 1) == 0;
    if (even) { SBAR(); QKT(1, pB0, pB1, NT - 1); SBAR(); }
    SLOAD_H(nxt.K, nxt.V, nxt.C, kbn); SBAR();
#pragma unroll
    for (int d0 = 0; d0 < 8; ++d0) S.qr[d0] = load8(nxt.Q + (size_t)(wid * QBLK + r32) * LDQ + d0 * 16 + hi * 8);
    SBAR();
    finishSM(pA0, pA1, alA, l_reg, pa0, pa1, pa2, pa3); SBAR();
    pv_tile<0>(o, vb0, pa0, pa1, pa2, pa3);
    if (even) { MASKT(pB0, pB1, NT - 1); partialSM(pB0, pB1, m_reg, mnB, alB); __syncthreads(); RESC(alB);
        finishSM(pB0, pB1, alB, l_reg, pa0, pa1, pa2, pa3); SBAR(); pv_tile<1>(o, vb0, pa0, pa1, pa2, pa3); }
    SBAR(); SEAM_K0();
    if (hi == 0) li_l[r32] = l_reg; asm volatile("s_waitcnt lgkmcnt(0)" ::: "memory");
    float rli[16];
#pragma unroll
    for (int r = 0; r < 16; ++r) rli[r] = __builtin_amdgcn_rcpf(li_l[crow(r, hi)]);
    int lane2 = lane; asm volatile("" : "+v"(lane2));
    const int r32b = lane2 & 31, hib = lane2 >> 5;
    bf16* Ow = cur.O + (size_t)(wid * QBLK) * LDO + (unsigned)(hib * 4 * LDO + r32b);
#pragma unroll
    for (int r = 0; r < 16; ++r) { const int orow = (r & 3) + 8 * (r >> 2);
#pragma unroll
        for (int d0 = 0; d0 < 4; ++d0) { const float v = o[d0][r] * rli[r];
            const float vn = __shfl_xor(v, 1);
            if ((r32b & 1) == 0) *(unsigned*)(Ow + orow * LDO + d0 * 32) = cvtpk(v, vn); } }
    __syncthreads();
#undef RESC
#undef KBASE
#undef NEAR
#undef MASKT
#undef QKT
#undef SEAM_K0
#undef HALF_STEP
}
constexpr int D_V = 0, D_K = 65536, D_PS = 98304, D_PSW = 4608, D_SLOT = 4 * D_PSW, D_BT = D_PS + 2 * D_SLOT, D_LDS_BYTES = D_BT + 4096;
template <int KB>
__device__ __forceinline__ void qkt_ref(f32x16& p0, f32x16& p1, const char* K_lds, const char* lds, int r32, int hi, const bf16x8* qr, bool near, int dq, int bt, const f32x16& negm, float mhat) {
    const char* kb[4];
#pragma unroll
    for (int dd = 0; dd < 4; ++dd) kb[dd] = K_lds + KB * SHM_K + KSWZ(r32, (dd * 16 + hi * 8) * 2);
    if (near) { const float* btp = (const float*)(lds + bt);
#pragma unroll
        for (int r = 0; r < 16; ++r) { const int c = (r & 3) + 8 * (r >> 2); int d0 = dq - c, d1 = dq - c - 32;
            d0 = d0 < 0 ? 0 : (d0 > 127 ? 127 : d0); d1 = d1 < 0 ? 0 : (d1 > 127 ? 127 : d1);
            p0[r] = btp[d0] - mhat; p1[r] = btp[d1] - mhat; }
#pragma unroll
        for (int d0 = 0; d0 < 8; ++d0) { const char* a = kb[d0 & 3] + (d0 >> 2) * 128;
            bf16x8 b0 = *reinterpret_cast<const bf16x8*>(a); bf16x8 b1 = *reinterpret_cast<const bf16x8*>(a + 32 * 256);
            p0 = __builtin_amdgcn_mfma_f32_32x32x16_bf16(b0, qr[d0], p0, 0, 0, 0); p1 = __builtin_amdgcn_mfma_f32_32x32x16_bf16(b1, qr[d0], p1, 0, 0, 0); }
    } else {
#pragma unroll
        for (int d0 = 0; d0 < 8; ++d0) { const char* a = kb[d0 & 3] + (d0 >> 2) * 128;
            bf16x8 b0 = *reinterpret_cast<const bf16x8*>(a); bf16x8 b1 = *reinterpret_cast<const bf16x8*>(a + 32 * 256);
            if (d0 == 0) { p0 = __builtin_amdgcn_mfma_f32_32x32x16_bf16(b0, qr[0], negm, 0, 0, 0); p1 = __builtin_amdgcn_mfma_f32_32x32x16_bf16(b1, qr[0], negm, 0, 0, 0); }
            else { p0 = __builtin_amdgcn_mfma_f32_32x32x16_bf16(b0, qr[d0], p0, 0, 0, 0); p1 = __builtin_amdgcn_mfma_f32_32x32x16_bf16(b1, qr[d0], p1, 0, 0, 0); } }
    }
}
#define D_MX3(a, b, c) __builtin_fmaxf(__builtin_fmaxf((a), (b)), (c))
template <bool FIRST>
__device__ __forceinline__ void sm_head(f32x16& p0, f32x16& p1, float& mhat, f32x16& negm, float& alpha, bool& rs) {
    float a = D_MX3(p0[0], p0[1], p1[0]), b = D_MX3(p0[2], p0[3], p1[1]); a = D_MX3(a, p1[2], p1[3]);
#pragma unroll
    for (int r = 4; r < 16; r += 4) { a = D_MX3(a, p0[r], p0[r + 1]); b = D_MX3(b, p0[r + 2], p0[r + 3]); a = D_MX3(a, p1[r], p1[r + 1]); b = D_MX3(b, p1[r + 2], p1[r + 3]); }
    float rm = __builtin_fmaxf(a, b);
    { auto rr = __builtin_amdgcn_permlane32_swap(__float_as_uint(rm), __float_as_uint(rm), false, false); rm = __builtin_fmaxf(__uint_as_float(rr[0]), __uint_as_float(rr[1])); }
    alpha = 1.f; rs = false;
    if (FIRST || __any(rm > THR2)) {
        const float dl = FIRST ? rm : __builtin_fmaxf(rm, 0.f);
        mhat += dl;
#pragma unroll
        for (int r = 0; r < 16; ++r) { p0[r] -= dl; p1[r] -= dl; }
#pragma unroll
        for (int r = 0; r < 16; ++r) negm[r] = -mhat;
        if (!FIRST) { alpha = __builtin_amdgcn_exp2f(-dl); rs = true; }
    }
#pragma unroll
    for (int r = 0; r < 16; ++r) p0[r] = __builtin_amdgcn_exp2f(p0[r]);
}
__device__ __forceinline__ void sm_tail(f32x16& p0, f32x16& p1, bf16x8& pa0, bf16x8& pa1, bf16x8& pa2, bf16x8& pa3) {
#pragma unroll
    for (int r = 0; r < 16; ++r) p1[r] = __builtin_amdgcn_exp2f(p1[r]);
#define PK4(P, B_, OUT) do { unsigned a0 = cvtpk(P[B_+0], P[B_+1]), a1 = cvtpk(P[B_+2], P[B_+3]);                          \
        unsigned b0 = cvtpk(P[B_+4], P[B_+5]), b1 = cvtpk(P[B_+6], P[B_+7]);                                             \
        auto r0 = __builtin_amdgcn_permlane32_swap(a0, b0, false, false); auto r1 = __builtin_amdgcn_permlane32_swap(a1, b1, false, false); \
        u32x4 w = {r0[0], r1[0], r0[1], r1[1]}; OUT = *reinterpret_cast<bf16x8*>(&w); } while (0)
    PK4(p0, 0, pa0); PK4(p0, 8, pa1); PK4(p1, 0, pa2); PK4(p1, 8, pa3);
#undef PK4
}
__device__ __forceinline__ void glds16s(const void* gbase, unsigned voff, unsigned lds_dst) { unsigned keep;
    asm volatile("s_mov_b32 %0, m0\n\ts_mov_b32 m0, %3\n\ts_nop 0\n\tglobal_load_lds_dwordx4 %1, %2\n\ts_mov_b32 m0, %0" : "=&s"(keep) : "v"(voff), "s"(gbase), "s"(lds_dst) : "memory"); }
struct DUnit { const bf16* Q; const bf16* K; const bf16* V; bf16* O; int P0; int bt; };
#define D_BAR() asm volatile("s_waitcnt lgkmcnt(0)\n\ts_barrier" ::: "memory")
#define D_VMW() asm volatile("s_waitcnt vmcnt(0)" ::: "memory")
#define D_LGKM(n) asm volatile("s_waitcnt lgkmcnt(" #n ")" ::: "memory")
#define D_TRRD(dst, off) asm volatile("ds_read_b64_tr_b16 %0, %1 offset:%2" : "=&v"(dst) : "v"(vb0), "i"(off) : "memory")
#define D_RD8(S, d0, VB) do { constexpr int b_ = D_V + (VB) * 32768 + ((d0) >> 2) * 16384 + ((d0) & 3) * 512; \
        D_TRRD(S##l0, b_); D_TRRD(S##h0, b_ + 2048); D_TRRD(S##l1, b_ + 4096); D_TRRD(S##h1, b_ + 6144); D_TRRD(S##l2, b_ + 8192); D_TRRD(S##h2, b_ + 10240); D_TRRD(S##l3, b_ + 12288); D_TRRD(S##h3, b_ + 14336); } while (0)
#define D_MM4(OACC, S) do { \
        OACC = __builtin_amdgcn_mfma_f32_32x32x16_bf16(pa0, (bf16x8){S##l0[0], S##l0[1], S##l0[2], S##l0[3], S##h0[0], S##h0[1], S##h0[2], S##h0[3]}, OACC, 0, 0, 0);   \
        OACC = __builtin_amdgcn_mfma_f32_32x32x16_bf16(pa1, (bf16x8){S##l1[0], S##l1[1], S##l1[2], S##l1[3], S##h1[0], S##h1[1], S##h1[2], S##h1[3]}, OACC, 0, 0, 0);   \
        OACC = __builtin_amdgcn_mfma_f32_32x32x16_bf16(pa2, (bf16x8){S##l2[0], S##l2[1], S##l2[2], S##l2[3], S##h2[0], S##h2[1], S##h2[2], S##h2[3]}, OACC, 0, 0, 0);   \
        OACC = __builtin_amdgcn_mfma_f32_32x32x16_bf16(pa3, (bf16x8){S##l3[0], S##l3[1], S##l3[2], S##l3[3], S##h3[0], S##h3[1], S##h3[2], S##h3[3]}, OACC, 0, 0, 0); } while (0)
#define D_STORE_O(OACC, colb) do { _Pragma("unroll") for (int r = 0; r < 16; ++r) { const int orow = (r & 3) + 8 * (r >> 2); const float v = OACC[r] * rli[r]; const float vn = __shfl_xor(v, 1); \
        if ((r32b & 1) == 0) *(unsigned*)(Ow + orow * 4096 + (colb)) = cvtpk(v, vn); } } while (0)

#define D_DMA_SETUP(w4)                                                     \
    const unsigned ldsb = (unsigned)(uintptr_t)lds;                                                                            \
    const int dw4 = (w4);                                                                                                      \
    const int krow = 4 * dw4 + (lane >> 4);                                                                                    \
    const unsigned koff = (unsigned)((krow * LDQ + (((lane & 15) ^ (krow & 7)) * 8)) * 2);                                     \
    const int kkl = (lane & 31) >> 2, vsub = lane >> 5, vj = dw4 & 1, ve = dw4 >> 1;                                            \
    const unsigned voff = (unsigned)((((8 * (kkl >> 2) + (kkl & 3)) * LDQ) + ve * 128 + (2 * vj + vsub) * 32 + (lane & 3) * 8) * 2); \
    const char* Kb = (const char*)u.K; const char* Vb = (const char*)u.V;
#define D_DMAK(t, buf) do { _Pragma("unroll") for (int i_ = 0; i_ < 4; ++i_) \
        glds16s(Kb + (size_t)((t) * KVBLK + 16 * i_) * (LDQ * 2), koff, (unsigned)__builtin_amdgcn_readfirstlane(ldsb + D_K + (buf) * 16384 + (dw4 + 4 * i_) * 1024)); } while (0)
#define D_DMAV(t, buf) do { _Pragma("unroll") for (int q_ = 0; q_ < 8; ++q_) \
        glds16s(Vb + (size_t)((t) * KVBLK + 16 * (q_ >> 1) + 4 * (q_ & 1)) * (LDQ * 2), voff, (unsigned)__builtin_amdgcn_readfirstlane(ldsb + D_V + (buf) * 32768 + ve * 16384 + (q_ * 2 + vj) * 1024)); } while (0)
__device__ __forceinline__ void diff_producer(const DUnit& u, char* lds, int tid) {
    const int lane = tid & 63, wq = __builtin_amdgcn_readfirstlane(tid >> 6), r32 = lane & 31, hi = lane >> 5;
    const int NT = (u.P0 + 127) / KVBLK + 1;
    const int qlo = u.P0 + wq * QBLK, qm = qlo + r32 - 4 * hi;
    const char* K_lds = lds + D_K;
    char* psb = lds + D_PS + wq * D_PSW + lane * 16;
    float* psf = (float*)(lds + D_PS + wq * D_PSW + 4096);
    const int bt = u.bt;
    bf16x8 qr[8];
    D_DMA_SETUP(wq);
#pragma unroll
    for (int d0 = 0; d0 < 8; ++d0) qr[d0] = load8(u.Q + (unsigned)((wq * QBLK + r32) * LDQ + d0 * 16 + hi * 8));
    D_DMAK(0, 0); D_VMW();
    __builtin_amdgcn_s_setprio(2);
    D_BAR();
    D_DMAK(1, 1);
    float mhat = 0.f; f32x16 negm = {};
    f32x16 pA0, pA1, pB0, pB1; float alA, alB; bool rsA, rsB = false; bf16x8 pa0, pa1, pa2, pa3;
#define D_NEAR(t) ((t) * KVBLK + 191 > qlo)
#define D_MASKT(P0_, P1_, t) do { const int kb_ = (t) * KVBLK; if (kb_ + KVBLK - 1 > qlo) mask_tile(P0_, P1_, qm - kb_, WBIG); } while (0)
#define D_QKT(KB, PX0, PX1, t) qkt_ref<KB>(PX0, PX1, K_lds, lds, r32, hi, qr, D_NEAR(t), qm - (t) * KVBLK, bt, negm, mhat)
    SBAR(); D_QKT(0, pA0, pA1, 0); D_MASKT(pA0, pA1, 0); sm_head<true>(pA0, pA1, mhat, negm, alA, rsA);
    D_VMW();
    D_BAR();
#define D_PSTEP(PX0, PX1, alX, rsX, PY0, PY1, alY, rsY, t, KBX, SLOT) do {                                                     \
        SBAR(); if ((t) + 1 < NT) D_QKT(KBX, PX0, PX1, (t) + 1);                                                               \
        if ((t) + 2 < NT) D_DMAK((t) + 2, SLOT);                                   \
        sm_tail(PY0, PY1, pa0, pa1, pa2, pa3); SBAR();                                                                         \
        { char* s_ = psb + (SLOT) * D_SLOT; *(bf16x8*)(s_) = pa0; *(bf16x8*)(s_ + 1024) = pa1; *(bf16x8*)(s_ + 2048) = pa2; *(bf16x8*)(s_ + 3072) = pa3; \
          float* f_ = psf + (SLOT) * (D_SLOT / 4); if (hi == 0) { f_[r32] = (alY); } if (lane == 0) ((int*)f_)[32] = (rsY) ? 1 : 0; } \
        if ((t) + 1 < NT) { D_MASKT(PX0, PX1, (t) + 1); sm_head<false>(PX0, PX1, mhat, negm, alX, rsX); }                       \
        D_VMW();                                                                                                               \
        D_BAR();                                                                                                               \
    } while (0)
    for (int t = 0; t + 1 < NT; t += 2) {
        D_PSTEP(pB0, pB1, alB, rsB, pA0, pA1, alA, rsA, t, 1, 0);
        D_PSTEP(pA0, pA1, alA, rsA, pB0, pB1, alB, rsB, t + 1, 0, 1);
    }
    D_BAR();
    __builtin_amdgcn_s_setprio(0);
#undef D_PSTEP
#undef D_QKT
#undef D_MASKT
#undef D_NEAR
}
__device__ __forceinline__ void diff_consumer(const DUnit& u, char* lds, int tid) {
    const int lane = tid & 63, wq = __builtin_amdgcn_readfirstlane((tid >> 6) & 3), hi = lane >> 5;
    const int NT = (u.P0 + 127) / KVBLK + 1;
    const float* psf = (const float*)(lds + D_PS + wq * D_PSW + 4096);
    const int psa = (int)(uintptr_t)lds + D_PS + wq * D_PSW + lane * 16;
    const int vb0 = (int)(uintptr_t)lds + v_rd_base(lane);
    D_DMA_SETUP(wq);
    D_BAR();
    f32x16 o0 = {}, o1 = {}, o2 = {}, o3 = {}, o4 = {}, o5 = {}, o6 = {}, o7 = {}, ol = {}; bf16x8 pa0, pa1, pa2, pa3;
    const bf16x8 ones = {0x3F80, 0x3F80, 0x3F80, 0x3F80, 0x3F80, 0x3F80, 0x3F80, 0x3F80};
#define D_MML() do { ol = __builtin_amdgcn_mfma_f32_32x32x16_bf16(pa0, ones, ol, 0, 0, 0); ol = __builtin_amdgcn_mfma_f32_32x32x16_bf16(pa1, ones, ol, 0, 0, 0); \
        ol = __builtin_amdgcn_mfma_f32_32x32x16_bf16(pa2, ones, ol, 0, 0, 0); ol = __builtin_amdgcn_mfma_f32_32x32x16_bf16(pa3, ones, ol, 0, 0, 0); } while (0)
    s16x4 Al0, Al1, Al2, Al3, Ah0, Ah1, Ah2, Ah3, Bl0, Bl1, Bl2, Bl3, Bh0, Bh1, Bh2, Bh3;
    D_VMW();
    D_BAR();
#define D_STAGE_UNUSED(t, SLOT) do { D_VMW(); if ((t) + 2 < NT) D_WRITEK(SLOT); D_WRITEV(SLOT);     \
        if ((t) + 3 < NT) D_LOADK((t) + 3); if ((t) + 1 < NT) D_LOADV((t) + 1); } while (0)
    D_DMAV(0, 0);
    D_VMW();
    D_BAR();
#define D_RDPA(SLOT) do { asm volatile("ds_read_b128 %0, %1 offset:%2" : "=&v"(pa0) : "v"(psa), "i"((SLOT) * D_SLOT) : "memory"); asm volatile("ds_read_b128 %0, %1 offset:%2" : "=&v"(pa1) : "v"(psa), "i"((SLOT) * D_SLOT + 1024) : "memory"); \
        asm volatile("ds_read_b128 %0, %1 offset:%2" : "=&v"(pa2) : "v"(psa), "i"((SLOT) * D_SLOT + 2048) : "memory"); asm volatile("ds_read_b128 %0, %1 offset:%2" : "=&v"(pa3) : "v"(psa), "i"((SLOT) * D_SLOT + 3072) : "memory"); } while (0)
#define D_CPV(VB) do { D_LGKM(0); SBAR();                                        \
        D_MM4(o0, A); D_RD8(A, 2, VB); D_MM4(o1, B); D_RD8(B, 3, VB); D_MML();                                                 \
        D_LGKM(8); SBAR(); D_MM4(o2, A); D_RD8(A, 4, VB);                                                                      \
        D_LGKM(8); SBAR(); D_MM4(o3, B); D_RD8(B, 5, VB);                                                                      \
        D_LGKM(8); SBAR(); D_MM4(o4, A); D_RD8(A, 6, VB);                                                                      \
        D_LGKM(8); SBAR(); D_MM4(o5, B); D_RD8(B, 7, VB);                                                                      \
        D_LGKM(8); SBAR(); D_MM4(o6, A);                                                                                       \
        D_LGKM(0); SBAR(); D_MM4(o7, B); } while (0)
#define D_CRESC(SLOT) do { const float* f_ = psf + (SLOT) * (D_SLOT / 4); if (__builtin_amdgcn_readfirstlane(((const int*)f_)[32]) != 0) { _Pragma("unroll") for (int r = 0; r < 16; ++r) { const float a_ = f_[crow(r, hi)];  \
            o0[r] *= a_; o1[r] *= a_; o2[r] *= a_; o3[r] *= a_; o4[r] *= a_; o5[r] *= a_; o6[r] *= a_; o7[r] *= a_; ol[r] *= a_; } } } while (0)
#define D_CSTEP(t, VB) do { D_RD8(A, 0, VB); if ((t) < NT) { D_DMAV((t), 1 - (VB)); } D_RD8(B, 1, VB); D_RDPA(VB); D_CRESC(VB); D_CPV(VB); D_VMW(); D_BAR(); } while (0)
    for (int t = 1; t < NT; t += 2) {
        D_CSTEP(t, 0);
        D_CSTEP(t + 1, 1);
    }
    {   unsigned short* stg = (unsigned short*)(lds + D_V + wq * 16384);
        const int r32 = lane & 31;
#define D_STG(OACC, colb) do { _Pragma("unroll") for (int r = 0; r < 16; ++r) stg[crow(r, hi) * 256 + (colb) + r32] = (unsigned short)(cvtpk(OACC[r] * __builtin_amdgcn_rcpf(ol[r]), 0.f) & 0xffffu); } while (0)
        D_STG(o0, 0); D_STG(o1, 32); D_STG(o2, 64); D_STG(o3, 96); D_STG(o4, 128); D_STG(o5, 160); D_STG(o6, 192); D_STG(o7, 224);
#undef D_STG
        asm volatile("s_waitcnt lgkmcnt(0)" ::: "memory");
        bf16* Ow = u.O + (unsigned)((wq * QBLK) * 4096);
#pragma unroll
        for (int i = 0; i < 16; ++i) { const int row = 2 * i + (lane >> 5), ch = lane & 31;
            const u32x4 v = *(const u32x4*)(stg + row * 256 + ch * 8); *(u32x4*)(Ow + row * 4096 + ch * 8) = v; }
        asm volatile("s_waitcnt lgkmcnt(0)" ::: "memory");
    }
#undef D_MML
#undef D_CSTEP
#undef D_STAGE_UNUSED
#undef D_CRESC
#undef D_CPV
#undef D_RDPA
}
#undef D_DMA_SETUP
#undef D_DMAK
#undef D_DMAV
#undef D_BAR
#undef D_VMW
#undef D_LGKM
#undef D_TRRD
#undef D_RD8
#undef D_MM4
#undef D_STORE_O
#undef ROW
#undef VMW
#undef VMWN
#undef SLOAD_H
#undef SWRITE_HK
#undef SWRITE_HV
#undef SWRITE_H
#undef KSWZ
#undef SBAR
}
namespace cg = cooperative_groups;
#define LAS __attribute__((address_space(3)))
typedef unsigned short bf16;
typedef unsigned v4u __attribute__((ext_vector_type(4)));
typedef unsigned v2u __attribute__((ext_vector_type(2)));
typedef float f32x4 __attribute__((ext_vector_type(4)));

constexpr int BATCH = 2, SEQ = 16384, DM = 2048, FF = 5632, DEPTH = 2;
constexpr int M = BATCH * SEQ;
constexpr int NQKV = 3 * DM;
constexpr float LN_EPS = 1e-5f;
constexpr float ALPHA = 1.4142135623730951f;
constexpr float QSCALE = 0.08838834764831845f * 1.4426950408889634f;
constexpr int NWAVES = 8, NTHREADS = 512;
constexpr int LDS_BYTES = 147456;

constexpr size_t MiB = 1u << 20;
constexpr size_t WS_WGU1 = 1 * MiB;
constexpr size_t WS_WD1 = WS_WGU1 + 44 * MiB;
constexpr size_t WS_WGU2 = WS_WD1 + 22 * MiB;
constexpr size_t WS_WD2 = WS_WGU2 + 44 * MiB;
constexpr size_t WS_WQKV = WS_WD2 + 22 * MiB;
constexpr size_t WS_WO = WS_WQKV + 24 * MiB;
constexpr size_t WS_XB = WS_WO + 8 * MiB;
constexpr size_t WS_BIG = WS_XB + 128 * MiB;
constexpr size_t WS_OP = WS_BIG + 384 * MiB;
constexpr size_t WS_LF = WS_OP + 256 * MiB;
constexpr size_t WS_C = WS_LF + 2 * MiB;
constexpr size_t WS_NR = WS_C + 2 * MiB;
constexpr size_t WS_CNT = WS_NR + 1 * MiB;
constexpr size_t WS_ST = WS_CNT + 1 * MiB;
constexpr size_t WS_BAR = WS_ST + 1 * MiB;
constexpr size_t WS_END = WS_BAR + 1 * MiB;

__device__ __forceinline__ unsigned f2bf(float f) { unsigned u = __builtin_bit_cast(unsigned, f); return (u + 0x7fffu + ((u >> 16) & 1u)) >> 16; }
__device__ __forceinline__ unsigned pk2(float lo, float hi) { return f2bf(lo) | (f2bf(hi) << 16); }
__device__ __forceinline__ float bf2f(unsigned short b) { return __builtin_bit_cast(float, (unsigned)b << 16); }
__device__ __forceinline__ float wave_sum(float v) {
#pragma unroll
    for (int o = 1; o < 64; o <<= 1) v += __shfl_xor(v, o);
    return v;
}
#define LDS_WAIT() asm volatile("s_waitcnt lgkmcnt(0)" ::: "memory")

__device__ __forceinline__ void transpose_item(const float* W, int K, int N, bf16* WT, int gu, LAS float* scr, int item, int lane) {
    const int nblk = N / 32, kb = item / nblk, nb = item % nblk, k0 = 64 * kb, n0 = 32 * nb;
    const int r0 = gu == 0 ? n0 : ((n0 >> 7) * 256 + (n0 & 127) + (gu == 2 ? 128 : 0));
    float wv[32];
#pragma unroll
    for (int i = 0; i < 32; ++i) { const int kk = 2 * i + (lane >> 5); wv[i] = __builtin_nontemporal_load(&W[(size_t)(k0 + kk) * N + n0 + (lane & 31)]); }
#pragma unroll
    for (int i = 0; i < 32; ++i) { const int kk = 2 * i + (lane >> 5); scr[kk * 33 + (lane & 31)] = wv[i]; }
    LDS_WAIT(); asm volatile("" ::: "memory");
    const int c = lane & 7;
#pragma unroll
    for (int j = 0; j < 4; ++j) { const int n = (lane >> 3) + 8 * j; const LAS float* s = scr + (8 * c) * 33 + n;
        v4u o; o.x = pk2(s[0 * 33], s[1 * 33]); o.y = pk2(s[2 * 33], s[3 * 33]); o.z = pk2(s[4 * 33], s[5 * 33]); o.w = pk2(s[6 * 33], s[7 * 33]);
        *(v4u*)(WT + (size_t)(r0 + n) * K + k0 + 8 * c) = o; }
    LDS_WAIT(); asm volatile("" ::: "memory");
}

#define XB_TMO      128
#define XB_XCNT(j)  (256  + 64 * (j))
#define XB_XSUB(j)  (1280 + 64 * (j))
#define XB_XGEN(j)  (2304 + 64 * (j))
#define XB_TOP      3328
#define XB_TOPGEN   3392
#define XCD_BAR_WORDS 3456
#define XB_SPIN_CAP (1u << 18)

__device__ __forceinline__ unsigned xb_ld(unsigned* p)              { return __hip_atomic_load(p, __ATOMIC_RELAXED, __HIP_MEMORY_SCOPE_AGENT); }
__device__ __forceinline__ unsigned xb_add(unsigned* p, unsigned v) { return __hip_atomic_fetch_add(p, v, __ATOMIC_RELAXED, __HIP_MEMORY_SCOPE_AGENT); }
__device__ __forceinline__ unsigned xb_xcc_id() { return (unsigned)__builtin_amdgcn_s_getreg((3 << 11) | 20) & 0xFu; }
#define XB_SPIN(cond, bar) do { unsigned _sp = 0; while (cond) { __builtin_amdgcn_s_sleep(1); \
    if ((++_sp & 255u) == 0u) { if (xb_ld(&(bar)[XB_TMO])) break; if (_sp > XB_SPIN_CAP) { atomicAdd(&(bar)[XB_TMO], 1u); break; } } } } while (0)

struct XcdBarrier {
    unsigned* bar; unsigned x;
    volatile LAS unsigned* st;
};

__device__ __forceinline__ XcdBarrier xcd_barrier_post(unsigned* bar, volatile LAS unsigned* st) {
    XcdBarrier b; b.bar = bar; b.x = xb_xcc_id(); b.st = st;
    if (threadIdx.x == 0) (void)xb_add(&bar[XB_XCNT(b.x)], 1u);
    return b;
}
__device__ __forceinline__ void xcd_barrier_complete(unsigned* bar, unsigned x, unsigned& nloc, unsigned& nx) {
    const unsigned G = gridDim.x * gridDim.y * gridDim.z;
    unsigned sum, cnt, mine, sp = 0u;
    for (;;) {
        sum = 0u; cnt = 0u; mine = 0u;
#pragma unroll
        for (unsigned j = 0; j < 16; ++j) { const unsigned c = xb_ld(&bar[XB_XCNT(j)]); sum += c; cnt += (c > 0u) ? 1u : 0u; mine = (j == x) ? c : mine; }
        if (sum == G) break;
        __builtin_amdgcn_s_sleep(1);
        if ((++sp & 255u) == 0u) { if (xb_ld(&bar[XB_TMO])) break; if (sp > XB_SPIN_CAP) { atomicAdd(&bar[XB_TMO], 1u); break; } }
    }
    nloc = mine > 0u ? mine : 1u; nx = cnt > 0u ? cnt : 1u;
}

__device__ __forceinline__ void xcd_barrier(const XcdBarrier& b) {
    asm volatile("s_waitcnt vmcnt(0)" ::: "memory");
    __syncthreads();
    if (threadIdx.x == 0) {
        unsigned* bar = b.bar;
        __builtin_amdgcn_s_waitcnt(0);
        unsigned nloc = b.st[0], nx = b.st[1];
        if (nloc == 0u) { xcd_barrier_complete(bar, b.x, nloc, nx); b.st[0] = nloc; b.st[1] = nx; }
        const unsigned old = xb_add(&bar[XB_XSUB(b.x)], 1u);
        const unsigned gen = old / nloc;
        if (old + 1u == (gen + 1u) * nloc) {
            __builtin_amdgcn_fence(__ATOMIC_RELEASE, "agent");
            asm volatile("s_waitcnt vmcnt(0)" ::: "memory");
            const unsigned og = xb_add(&bar[XB_TOP], 1u);
            const unsigned tg = og / nx;
            if (og + 1u == (tg + 1u) * nx) xb_add(&bar[XB_TOPGEN], 1u);
            else XB_SPIN(xb_ld(&bar[XB_TOPGEN]) == tg, bar);
            __builtin_amdgcn_fence(__ATOMIC_ACQUIRE, "agent");
            xb_add(&bar[XB_XGEN(b.x)], 1u);
            asm volatile("s_waitcnt vmcnt(0)" ::: "memory");
        } else {
            XB_SPIN(xb_ld(&bar[XB_XGEN(b.x)]) == gen, bar);
            __builtin_amdgcn_fence(__ATOMIC_ACQUIRE, "agent");
            asm volatile("s_waitcnt vmcnt(0)" ::: "memory");
        }
    }
    __syncthreads();
}


struct Args { const float* in[21]; float* out; unsigned char* ws; int ph_lo, ph_hi; };

template <bool GATE, bool FINAL>
__device__ __forceinline__ void ln_phase(const float* Y, float* X, bf16* XB, float* ST, const float* g, const float* b, const float* wf, const float* bfv, float* LF,
                                         LAS unsigned char* lds, int gw, int NGW, int tid, int lane) {
    LAS float* wT = (LAS float*)lds;
    if (GATE) {
        for (int idx = tid; idx < DM * 16; idx += NTHREADS) { const int k = idx >> 4, hh = idx & 15; wT[hh * DM + k] = wf[idx]; }
        __syncthreads();
    }
    f32x4 gv[8], bv[8];
#pragma unroll
    for (int j = 0; j < 8; ++j) { gv[j] = ((const f32x4*)g)[64 * j + lane]; bv[j] = ((const f32x4*)b)[64 * j + lane]; }
    f32x4 nx[8];
    if (gw < M) { const f32x4* yr = (const f32x4*)(Y + (size_t)gw * DM) + lane;
#pragma unroll
        for (int j = 0; j < 8; ++j) nx[j] = __builtin_nontemporal_load(&yr[64 * j]); }
    for (int m = gw; m < M; m += NGW) {
        f32x4 v[8]; float s = 0.f;
#pragma unroll
        for (int j = 0; j < 8; ++j) { v[j] = nx[j]; s += (v[j].x + v[j].y) + (v[j].z + v[j].w); }
        if (m + NGW < M) { const f32x4* yr = (const f32x4*)(Y + (size_t)(m + NGW) * DM) + lane;
#pragma unroll
            for (int j = 0; j < 8; ++j) nx[j] = __builtin_nontemporal_load(&yr[64 * j]); }
        const float mean = wave_sum(s) * (1.f / DM); float s2 = 0.f;
#pragma unroll
        for (int j = 0; j < 8; ++j) { v[j] = v[j] - mean; s2 += (v[j].x * v[j].x + v[j].y * v[j].y) + (v[j].z * v[j].z + v[j].w * v[j].w); }
        const float rstd = 1.f / sqrtf(wave_sum(s2) * (1.f / DM) + LN_EPS);
        f32x4* xr = (f32x4*)(X + (size_t)m * DM) + lane;
        v2u* o8 = (v2u*)(XB + (size_t)m * DM) + lane;
#pragma unroll
        for (int j = 0; j < 8; ++j) { v[j] = v[j] * rstd * gv[j] + bv[j];
            if (FINAL) xr[64 * j] = v[j];
            else { v2u w; w.x = pk2(v[j].x, v[j].y); w.y = pk2(v[j].z, v[j].w); o8[64 * j] = w; } }
        if (!FINAL && lane == 0) { ST[2 * (size_t)m] = mean; ST[2 * (size_t)m + 1] = rstd; }
        if (GATE) {
            float zmine = 0.f;
#pragma unroll 1
            for (int hh = 0; hh < 16; ++hh) { float a = 0.f;
#pragma unroll
                for (int j = 0; j < 8; ++j) { const f32x4 w = *(const LAS f32x4*)(wT + hh * DM + 256 * j + 4 * lane);
                    a += (v[j].x * w.x + v[j].y * w.y) + (v[j].z * w.z + v[j].w * w.w); }
                a = wave_sum(a); if (lane == hh) zmine = a; }
            if (lane < 16) { const float z = zmine + bfv[lane];
                const float ls = fminf(z, 0.f) - log1pf(expf(-fabsf(z)));
                LF[(size_t)m * 16 + lane] = ls; }
        }
    }
    if (GATE) __syncthreads();
}

__device__ __forceinline__ void cumsum_unit(const float* LF, float* C, int bh, LAS unsigned char* lds, int tid) {
    const int b = bh >> 4, hh = bh & 15; LAS double* sd = (LAS double*)lds;
    const float* src = LF + ((size_t)b * SEQ + 32 * tid) * 16 + hh;
    double t = 0.0;
    for (int i = 0; i < 32; ++i) t += (double)src[(size_t)i * 16];
    const int ln_ = tid & 63, wv_ = tid >> 6;
    double inc = t;
#pragma unroll
    for (int o = 1; o < 64; o <<= 1) { const double y = __shfl_up(inc, o); if (ln_ >= o) inc += y; }
    if (ln_ == 63) sd[wv_] = inc;
    __syncthreads();
    double pre = inc - t;
    for (int w = 0; w < wv_; ++w) pre += sd[w];
    float* dst = C + (size_t)bh * SEQ + 32 * tid;
    for (int i = 0; i < 32; ++i) { pre += (double)src[(size_t)i * 16]; dst[i] = (float)pre; }
    __syncthreads();
}

__device__ __forceinline__ void diff_combine(const bf16* OP, bf16* OB, const float* lq1, const float* lk1, const float* lq2, const float* lk2, const float* subg, float lam_init,
                                             int gw, int NGW, int lane) {
    const float d1 = wave_sum(lq1[lane] * lk1[lane] + lq1[lane + 64] * lk1[lane + 64]);
    const float d2 = wave_sum(lq2[lane] * lk2[lane] + lq2[lane + 64] * lk2[lane + 64]);
    const float lam = expf(d1) - expf(d2) + lam_init;
    const float osc = 1.f - lam_init;
    const int h = lane >> 3, e0 = (lane & 7) * 32;
    f32x4 sg[8];
#pragma unroll
    for (int i = 0; i < 8; ++i) sg[i] = ((const f32x4*)(subg + e0))[i];
    v4u na[4], nc[4];
    if (gw < M) { const v4u* pa_ = (const v4u*)(OP + (size_t)gw * 4096 + (h * 2 + 0) * 256 + e0); const v4u* pc_ = (const v4u*)(OP + (size_t)gw * 4096 + (h * 2 + 1) * 256 + e0);
#pragma unroll
        for (int i = 0; i < 4; ++i) { na[i] = __builtin_nontemporal_load(&pa_[i]); nc[i] = __builtin_nontemporal_load(&pc_[i]); } }
    for (int m = gw; m < M; m += NGW) {
        v4u a[4], c[4];
#pragma unroll
        for (int i = 0; i < 4; ++i) { a[i] = na[i]; c[i] = nc[i]; }
        if (m + NGW < M) { const v4u* pa_ = (const v4u*)(OP + (size_t)(m + NGW) * 4096 + (h * 2 + 0) * 256 + e0); const v4u* pc_ = (const v4u*)(OP + (size_t)(m + NGW) * 4096 + (h * 2 + 1) * 256 + e0);
#pragma unroll
            for (int i = 0; i < 4; ++i) { na[i] = __builtin_nontemporal_load(&pa_[i]); nc[i] = __builtin_nontemporal_load(&pc_[i]); } }
        float o[32]; float ss = 0.f;
#pragma unroll
        for (int i = 0; i < 4; ++i) {
            const unsigned aw[4] = {a[i].x, a[i].y, a[i].z, a[i].w}, cw[4] = {c[i].x, c[i].y, c[i].z, c[i].w};
#pragma unroll
            for (int j = 0; j < 4; ++j) {
                const float x0 = bf2f((unsigned short)(aw[j] & 0xffff)) - lam * bf2f((unsigned short)(cw[j] & 0xffff));
                const float x1 = bf2f((unsigned short)(aw[j] >> 16)) - lam * bf2f((unsigned short)(cw[j] >> 16));
                o[8 * i + 2 * j] = x0; o[8 * i + 2 * j + 1] = x1; ss += x0 * x0 + x1 * x1; } }
        ss += __shfl_xor(ss, 1); ss += __shfl_xor(ss, 2); ss += __shfl_xor(ss, 4);
        const float r = osc / sqrtf(ss * (1.f / 256.f) + LN_EPS);
        v4u* po = (v4u*)(OB + (size_t)m * DM + h * 256 + e0);
#pragma unroll
        for (int i = 0; i < 4; ++i) { const f32x4 g0 = sg[2 * i], g1 = sg[2 * i + 1]; v4u w;
            w.x = pk2(o[8 * i] * r * g0.x, o[8 * i + 1] * r * g0.y); w.y = pk2(o[8 * i + 2] * r * g0.z, o[8 * i + 3] * r * g0.w);
            w.z = pk2(o[8 * i + 4] * r * g1.x, o[8 * i + 5] * r * g1.y); w.w = pk2(o[8 * i + 6] * r * g1.z, o[8 * i + 7] * r * g1.w); po[i] = w; }
    }
}

template <int MODE>
__device__ __forceinline__ att::BlockRef attn_ref(int bh, int qb, const bf16* QKV, bf16* O, const float* C) {
    att::BlockRef r;
    if (MODE == 0) { const int b = bh >> 5, vh = bh & 31, h = vh >> 2, mp = (vh >> 1) & 1, e = vh & 1;
        const bf16* base = QKV + (size_t)b * SEQ * NQKV;
        r.Q = (const att::bf16*)(base + h * 256 + mp * 128 + (size_t)qb * 256 * NQKV);
        r.K = (const att::bf16*)(base + DM + h * 256 + mp * 128);
        r.V = (const att::bf16*)(base + 2 * DM + h * 256 + e * 128);
        r.O = (att::bf16*)(O + ((size_t)b * SEQ + (size_t)qb * 256) * 4096 + (h * 2 + mp) * 256 + e * 128);
        r.C = nullptr; r.bt = att::OFF_BT + h * 512;
    } else { const int b = bh >> 4, hh = bh & 15;
        const bf16* base = QKV + (size_t)b * SEQ * NQKV;
        r.Q = (const att::bf16*)(base + hh * 128 + (size_t)qb * 256 * NQKV);
        r.K = (const att::bf16*)(base + DM + hh * 128);
        r.V = (const att::bf16*)(base + 2 * DM + hh * 128);
        r.O = (att::bf16*)(O + ((size_t)b * SEQ + (size_t)qb * 256) * DM + hh * 128);
        r.C = C + (size_t)bh * SEQ; r.bt = 0;
    }
    r.P0 = qb * 256; r.jlo = 0;
    return r;
}
__device__ __forceinline__ void attn_decode(int L, int& bh, int& x) { const int xcd = L & 7, k = L >> 3, gi = k >> 5, r = k & 31; bh = gi * 8 + xcd; x = r; }
template <int MODE>
__device__ __forceinline__ void attn_phase(const bf16* QKV, bf16* O, const float* C, const float* rel_table, char* lds, int tid) {
    constexpr int NBH = MODE == 0 ? 64 : 32, NQB = SEQ / 256, total = NBH * 32;
    if (MODE == 0) {
        float* btab = (float*)(lds + att::OFF_BT);
        for (int i = tid; i < 8 * 128; i += NTHREADS) { const int h = i >> 7, n = i & 127;
            int bk = n; if (n >= 16) { bk = 16 + (int)(logf((float)n * (1.f / 16.f)) / 2.0794415416798357f * 16.f); bk = bk > 31 ? 31 : bk; }
            btab[i] = (rel_table[bk * 8 + h] - rel_table[31 * 8 + h]) * att::LOG2E; }
        __syncthreads();
    }
    const int stride = gridDim.x; int L = blockIdx.x; if (L >= total) return;
    int bh, x; attn_decode(L, bh, x); int pass = 0;
    att::BlockRef cur = attn_ref<MODE>(bh, NQB - 1 - x, QKV, O, C);
    att::Seam S;
    att::attn_prime<MODE>(cur, lds, S);
    for (;;) {
        const bool more_pass = pass == 0, more_item = L + stride < total, last = !more_pass && !more_item;
        int bhn = bh, xn = x, passn = pass + 1, Ln = L;
        if (!more_pass) { passn = 0; Ln = more_item ? L + stride : L; attn_decode(Ln, bhn, xn); }
        const att::BlockRef nxt = last ? cur : attn_ref<MODE>(bhn, passn ? xn : NQB - 1 - xn, QKV, O, C);
        att::attn_block<MODE, (MODE == 0 ? 4096 : DM)>(cur, nxt, lds, S);
        if (last) break;
        cur = nxt; bh = bhn; x = xn; pass = passn; L = Ln;
    }
}
__device__ __forceinline__ void diff_phase(const bf16* QKV, bf16* OP, const float* rel_table, char* lds, int tid) {
    {   float* btab = (float*)(lds + att::D_BT);
        for (int i = tid; i < 8 * 128; i += NTHREADS) { const int h = i >> 7, n = i & 127;
            int bk = n; if (n >= 16) { bk = 16 + (int)(logf((float)n * (1.f / 16.f)) / 2.0794415416798357f * 16.f); bk = bk > 31 ? 31 : bk; }
            btab[i] = (rel_table[bk * 8 + h] - rel_table[31 * 8 + h]) * att::LOG2E; }
        __syncthreads(); }
    const int wid = __builtin_amdgcn_readfirstlane(tid >> 6);
#pragma unroll 1
    for (int L = blockIdx.x; L < 2048; L += gridDim.x) {
        const int xcd = L & 7, k = L >> 3, gi = k >> 6, x = k & 63, bhm = gi * 8 + xcd;
        const int b = bhm >> 4, h = (bhm >> 1) & 7, mp = bhm & 1;
        const bf16* base = QKV + (size_t)b * SEQ * NQKV;
#pragma unroll 1
        for (int pass = 0; pass < 2; ++pass) {
            const int qb = pass ? x : 127 - x;
            att::DUnit u; u.P0 = qb * 128;
            u.Q = (const att::bf16*)(base + h * 256 + mp * 128 + (size_t)u.P0 * NQKV);
            u.K = (const att::bf16*)(base + DM + h * 256 + mp * 128);
            u.V = (const att::bf16*)(base + 2 * DM + h * 256);
            u.O = (att::bf16*)(OP + ((size_t)b * SEQ + u.P0) * 4096 + (h * 2 + mp) * 256);
            u.bt = att::D_BT + h * 512;
            int tid2 = tid; asm volatile("" : "+v"(tid2));
            if (wid < 4) att::diff_producer(u, lds, tid2); else att::diff_consumer(u, lds, tid2);
        }
    }
}
constexpr int OFF_MB = att::LDS_BYTES;
__device__ __forceinline__ void fox_fetch(unsigned* CNT, const float* NR, const float* C, int* mb, int lane) {
    asm volatile("" : "+v"(lane));
    const int x = blockIdx.x & 7; int v = -1, tgt = 0;
    if (lane == 0) { const unsigned r = __hip_atomic_fetch_add(CNT, 1u, __ATOMIC_RELAXED, __HIP_MEMORY_SCOPE_AGENT); if (r < 2048u) { v = (int)r; tgt = 0; } (void)x; }
    v = __shfl(v, 0); tgt = __shfl(tgt, 0);
    if (v < 0) { if (lane == 0) mb[3] = 0; return; }
    const int bh = tgt + (v & 31), qb = 63 - (v >> 5);
    const float* qn = NR + bh * 256 + 4 * qb; const float* kn = NR + 8192 + bh * 256; const float* Cb = C + (size_t)bh * SEQ;
    const float Qm = fmaxf(fmaxf(qn[0], qn[1]), fmaxf(qn[2], qn[3])), Kd = fmaxf(fmaxf(kn[4 * qb], kn[4 * qb + 1]), fmaxf(kn[4 * qb + 2], kn[4 * qb + 3]));
    const float rhs = -(Qm * Kd) - 36.f, cref = Cb[256 * qb];
    const int nvalid = 4 * qb; float carry = 0.f; int jlo = 0;
    float knv[4], cjv[4];
#pragma unroll
    for (int c_ = 0; c_ < 4; ++c_) { const int j = 64 * c_ + lane; const bool ok = j < nvalid; knv[c_] = ok ? kn[j] : 0.f; cjv[c_] = ok ? Cb[64 * j + 63] : 0.f; }
#pragma unroll
    for (int c_ = 0; c_ < 4; ++c_) { const int base = 64 * c_; if (base >= nvalid) break;
        const int j = base + lane; const bool ok = j < nvalid;
        float k = knv[c_];
#pragma unroll
        for (int o = 1; o < 64; o <<= 1) { const float t = __shfl_up(k, o); if (lane >= o) k = fmaxf(k, t); }
        k = fmaxf(k, carry);
        const float cj = cjv[c_];
        const bool skip = ok && (Qm * k + (cref - cj) * att::LOG2E < rhs);
        const unsigned long long m = __ballot(skip);
        const int cnt = (~m == 0ull) ? 64 : __builtin_ctzll(~m);
        jlo += cnt;
        if (cnt < 64) break;
        carry = __shfl(k, 63);
    }
    if (lane == 0) { mb[0] = bh; mb[1] = qb; mb[2] = jlo; mb[3] = 1; }
}
__device__ __forceinline__ void fox_phase(const bf16* QKV, bf16* O, const float* C, const float* NR, unsigned* CNT, char* lds, int tid) {
    const int lane = tid & 63, wid = __builtin_amdgcn_readfirstlane(tid >> 6);
    int* mb = (int*)(lds + OFF_MB);
    if (wid == 0) fox_fetch(CNT, NR, C, mb, lane);
    __syncthreads();
    if (__builtin_amdgcn_readfirstlane(mb[3]) == 0) return;
    if (wid >= 4) __builtin_amdgcn_s_setprio(1);
    att::BlockRef cur = attn_ref<1>(__builtin_amdgcn_readfirstlane(mb[0]), __builtin_amdgcn_readfirstlane(mb[1]), QKV, O, C); cur.jlo = __builtin_amdgcn_readfirstlane(mb[2]);
    __syncthreads();
    att::Seam S;
    att::attn_prime<1>(cur, lds, S);
    for (;;) {
        if (wid == 0) fox_fetch(CNT, NR, C, mb, lane);
        __syncthreads();
        const bool has = __builtin_amdgcn_readfirstlane(mb[3]) != 0;
        att::BlockRef nxt = cur; if (has) { nxt = attn_ref<1>(__builtin_amdgcn_readfirstlane(mb[0]), __builtin_amdgcn_readfirstlane(mb[1]), QKV, O, C); nxt.jlo = __builtin_amdgcn_readfirstlane(mb[2]); }
        att::attn_block<1, DM>(cur, nxt, lds, S);
        if (!has) break;
        cur = nxt;
    }
    __builtin_amdgcn_s_setprio(0);
}
__device__ __forceinline__ void norm_phase(const bf16* QKV, float* NR, int gw, int NGW, int lane) {
    for (int w = gw; w < 2 * 32 * 256; w += NGW) {
        const int which = w >> 13, bh = (w >> 8) & 31, chunk = w & 255, b = bh >> 4, hh = bh & 15;
        const v4u* p = (const v4u*)(QKV + ((size_t)b * SEQ + chunk * 64 + lane) * NQKV + which * DM + hh * 128);
        float ss = 0.f;
#pragma unroll 4
        for (int i = 0; i < 16; ++i) { const v4u v = p[i];
            const float a0 = bf2f((unsigned short)(v.x & 0xffff)), a1 = bf2f((unsigned short)(v.x >> 16)), a2 = bf2f((unsigned short)(v.y & 0xffff)), a3 = bf2f((unsigned short)(v.y >> 16));
            const float a4 = bf2f((unsigned short)(v.z & 0xffff)), a5 = bf2f((unsigned short)(v.z >> 16)), a6 = bf2f((unsigned short)(v.w & 0xffff)), a7 = bf2f((unsigned short)(v.w >> 16));
            ss += (a0 * a0 + a1 * a1) + (a2 * a2 + a3 * a3) + (a4 * a4 + a5 * a5) + (a6 * a6 + a7 * a7); }
        float nrm = sqrtf(ss) * 1.0001f;
#pragma unroll
        for (int o = 1; o < 64; o <<= 1) nrm = fmaxf(nrm, __shfl_xor(nrm, o));
        if (lane == 0) NR[w] = nrm;
    }
}

#define PHASE_BEGIN if (ph >= lo && ph < hi) {
#if defined(PROBE_A)
#define PROBE_STAMP(i) do { if (blockIdx.x == 0 && threadIdx.x == 0) ((unsigned long long*)(args.ws + WS_END))[(i)] = __builtin_amdgcn_s_memrealtime(); } while (0)
#else
#define PROBE_STAMP(i) do { } while (0)
#endif
#define PHASE_END   if (ph + 1 < hi && ph != 12) { if (lo < 0) grid.sync(); xcd_barrier(xbar); }     PROBE_STAMP(ph + 1); } ++ph;
template <int layer>
__device__ __forceinline__ void layer_body(const Args& args, cg::grid_group& grid, const XcdBarrier& xbar, unsigned char* lds, int& ph) {
    LAS unsigned char* ldsl = (LAS unsigned char*)lds;
    const int tid = threadIdx.x, lane = tid & 63, wave = __builtin_amdgcn_readfirstlane(tid >> 6);
    const int G = gridDim.x; const int bx = blockIdx.x;
    const int vcu = (G % 8 == 0) ? (bx % 8) * (G / 8) + bx / 8 : bx;
    const int gw = vcu * NWAVES + wave, NGW = G * NWAVES;
    unsigned char* ws = args.ws;
    const float* x_in = args.in[0]; float* X = args.out;
    bf16* Wgu1 = (bf16*)(ws + WS_WGU1); bf16* Wd1 = (bf16*)(ws + WS_WD1); bf16* Wgu2 = (bf16*)(ws + WS_WGU2); bf16* Wd2 = (bf16*)(ws + WS_WD2);
    bf16* Wqkv = (bf16*)(ws + WS_WQKV); bf16* Wo = (bf16*)(ws + WS_WO);
    bf16* XB = (bf16*)(ws + WS_XB); bf16* HB = (bf16*)(ws + WS_BIG); bf16* QKV = (bf16*)(ws + WS_BIG); bf16* OP = (bf16*)(ws + WS_OP);
    float* LF = (float*)(ws + WS_LF); float* CC = (float*)(ws + WS_C); float* NR = (float*)(ws + WS_NR); unsigned* CNT = (unsigned*)(ws + WS_CNT); float* ST = (float*)(ws + WS_ST);
    const int lo = args.ph_lo, hi = args.ph_hi;
        constexpr bool fox = (layer & 1) != 0;
        const float* w1g = args.in[2] + (size_t)layer * DM * FF; const float* w1u = args.in[3] + (size_t)layer * DM * FF; const float* w1d = args.in[4] + (size_t)layer * DM * FF;
        const float* w2g = args.in[5] + (size_t)layer * DM * FF; const float* w2u = args.in[6] + (size_t)layer * DM * FF; const float* w2d = args.in[7] + (size_t)layer * DM * FF;
        const float* lng = args.in[8] + (size_t)layer * 3 * DM; const float* lnb = args.in[9] + (size_t)layer * 3 * DM;
        const float* wqkv_f = fox ? args.in[17] : args.in[10]; const float* wo_f = fox ? args.in[18] : args.in[11];

        PHASE_BEGIN
            LAS float* scr = (LAS float*)(ldsl + wave * 16384);
            constexpr int I_F = (DM / 64) * (FF / 32), I_D = (FF / 64) * (DM / 32), I_Q = (DM / 64) * (NQKV / 32), I_O = (DM / 64) * (DM / 32);
            constexpr int NITEMS = 4 * I_F + 2 * I_D + I_Q + I_O;
            for (int it = gw; it < NITEMS; it += NGW) {
                int r = it;
                if (r < I_F) { transpose_item(w1g, DM, FF, Wgu1, 1, scr, r, lane); continue; } r -= I_F;
                if (r < I_F) { transpose_item(w1u, DM, FF, Wgu1, 2, scr, r, lane); continue; } r -= I_F;
                if (r < I_D) { transpose_item(w1d, FF, DM, Wd1, 0, scr, r, lane); continue; } r -= I_D;
                if (r < I_F) { transpose_item(w2g, DM, FF, Wgu2, 1, scr, r, lane); continue; } r -= I_F;
                if (r < I_F) { transpose_item(w2u, DM, FF, Wgu2, 2, scr, r, lane); continue; } r -= I_F;
                if (r < I_D) { transpose_item(w2d, FF, DM, Wd2, 0, scr, r, lane); continue; } r -= I_D;
                if (r < I_Q) { transpose_item(wqkv_f, DM, NQKV, Wqkv, 0, scr, r, lane); continue; } r -= I_Q;
                transpose_item(wo_f, DM, DM, Wo, 0, scr, r, lane);
            }
            if (fox && bx == 0 && tid < 8) CNT[tid * 64] = 0u;
            if (layer == 0) {
                for (int m = gw; m < M; m += NGW) { const f32x4* xr = (const f32x4*)(x_in + (size_t)m * DM) + lane; v2u* o8 = (v2u*)(XB + (size_t)m * DM) + lane;
#pragma unroll
                    for (int j = 0; j < 8; ++j) { const f32x4 v = __builtin_nontemporal_load(&xr[64 * j]); v2u w; w.x = pk2(v.x, v.y); w.y = pk2(v.z, v.w); o8[64 * j] = w; } }
            }
            __syncthreads();
        PHASE_END

        PHASE_BEGIN
            pg8::Gemm g{XB, Wgu1, M, 2 * FF, DM}; pg8::StaticOrder S; S.init(M, 2 * FF, G, bx);
            pg8::EpiSwiGLU E{HB, FF};
#ifndef NO_GEMM_SW
            pg8::gemm_phase<pg8::EpiSwiGLU, pg8::StaticOrder, true, true>(ldsl, g, S, E);
#endif
        PHASE_END
        PHASE_BEGIN
            pg8::Gemm g{HB, Wd1, M, DM, FF}; pg8::StaticOrder S; S.init(M, DM, G, bx);
#ifndef NO_GEMM_RES
            if constexpr (layer == 0) { pg8::EpiRes<false> E{x_in, X, DM, ALPHA, 0.5f, nullptr, nullptr, nullptr};
                pg8::gemm_phase<pg8::EpiRes<false>, pg8::StaticOrder, true, true>(ldsl, g, S, E); }
            else { pg8::EpiRes<true> E{X, X, DM, ALPHA, 0.5f, (const pg8::f32x2*)ST, lng - DM, lnb - DM};
                pg8::gemm_phase<pg8::EpiRes<true>, pg8::StaticOrder, true, true>(ldsl, g, S, E); }
#endif
        PHASE_END
        PHASE_BEGIN
            if (fox) ln_phase<true, false>(X, X, XB, ST, lng, lnb, args.in[19], args.in[20], LF, ldsl, gw, NGW, tid, lane);
            else ln_phase<false, false>(X, X, XB, ST, lng, lnb, nullptr, nullptr, nullptr, ldsl, gw, NGW, tid, lane);
        PHASE_END
        PHASE_BEGIN
            if (fox && bx < 32) cumsum_unit(LF, CC, bx, ldsl, tid);
            pg8::Gemm g{XB, Wqkv, M, NQKV, DM}; pg8::StaticOrder S; S.init(M, NQKV, G, bx);
            pg8::EpiBf16S E{QKV, NQKV, DM, QSCALE};
#ifndef NO_GEMM_QKV
            pg8::gemm_phase<pg8::EpiBf16S, pg8::StaticOrder, true, true>(ldsl, g, S, E);
#endif
        PHASE_END
        if (fox) {
        PHASE_BEGIN
            norm_phase(QKV, NR, gw, NGW, lane);
        PHASE_END
        } else { ++ph; }
        PHASE_BEGIN
#ifndef NO_ATT1
            if (fox) fox_phase(QKV, XB, CC, NR, CNT, (char*)lds, tid);
#endif
#ifndef NO_ATT0
            if (!fox) diff_phase(QKV, OP, args.in[1], (char*)lds, tid);
#endif
            __syncthreads();
        PHASE_END
        if (!fox) {
        PHASE_BEGIN
            const float lam_init = 0.8f - 0.6f * expf(-0.3f * (float)layer);
            diff_combine(OP, XB, args.in[12], args.in[13], args.in[14], args.in[15], args.in[16], lam_init, gw, NGW, lane);
        PHASE_END
        } else { ++ph; }
        PHASE_BEGIN
            pg8::Gemm g{XB, Wo, M, DM, DM}; pg8::StaticOrder S; S.init(M, DM, G, bx);
            pg8::EpiRes<true> E{X, X, DM, ALPHA, 1.0f, (const pg8::f32x2*)ST, lng, lnb};
#ifndef NO_GEMM_RES
            pg8::gemm_phase<pg8::EpiRes<true>, pg8::StaticOrder, true, true>(ldsl, g, S, E);
#endif
        PHASE_END
        PHASE_BEGIN
            ln_phase<false, false>(X, X, XB, ST, lng + DM, lnb + DM, nullptr, nullptr, nullptr, ldsl, gw, NGW, tid, lane);
        PHASE_END
        PHASE_BEGIN
            pg8::Gemm g{XB, Wgu2, M, 2 * FF, DM}; pg8::StaticOrder S; S.init(M, 2 * FF, G, bx);
            pg8::EpiSwiGLU E{HB, FF};
#ifndef NO_GEMM_SW
            pg8::gemm_phase<pg8::EpiSwiGLU, pg8::StaticOrder, true, true>(ldsl, g, S, E);
#endif
        PHASE_END
        PHASE_BEGIN
            pg8::Gemm g{HB, Wd2, M, DM, FF}; pg8::StaticOrder S; S.init(M, DM, G, bx);
            pg8::EpiRes<true> E{X, X, DM, ALPHA, 0.5f, (const pg8::f32x2*)ST, lng + DM, lnb + DM};
#ifndef NO_GEMM_RES
            pg8::gemm_phase<pg8::EpiRes<true>, pg8::StaticOrder, true, true>(ldsl, g, S, E);
#endif
        PHASE_END
        PHASE_BEGIN
            ln_phase<false, (layer == DEPTH - 1)>(X, X, XB, ST, lng + 2 * DM, lnb + 2 * DM, nullptr, nullptr, nullptr, ldsl, gw, NGW, tid, lane);
        PHASE_END
    }
#undef PHASE_BEGIN
#undef PHASE_END
__global__ void __launch_bounds__(NTHREADS, 2) fwd_megakernel(Args args) {
    extern __shared__ __attribute__((aligned(16))) unsigned char lds[];
    cg::grid_group grid = cg::this_grid();
    int ph = 0;
    PROBE_STAMP(0);
    volatile LAS unsigned* xst = (volatile LAS unsigned*)((LAS unsigned char*)lds + (LDS_BYTES - 64));
    if (threadIdx.x < 2) xst[threadIdx.x] = 0u;
    __syncthreads();
    const XcdBarrier xbar = xcd_barrier_post((unsigned*)(args.ws + WS_BAR), xst);
    layer_body<0>(args, grid, xbar, lds, ph);
    layer_body<1>(args, grid, xbar, lds, ph);
#if defined(PROBE_A)
    {
        const unsigned long long* ts = (const unsigned long long*)(args.ws + WS_END);
        float* o = args.out + (size_t)blockIdx.x * (size_t)(M / 256) * DM;
        for (int i = threadIdx.x; i < (M / 256) * DM; i += NTHREADS) o[i] = 1000.f;
        __syncthreads();
        if (blockIdx.x == 0 && threadIdx.x == 0) o[0] = (float)(ts[PROBE_A + 1] - ts[PROBE_S]) * 1e-2f;
    }
#endif
}

extern "C" void kernel_launch(void* const* d_in, const int* in_sizes, int n_in, void* d_out, int out_size, void* d_ws, size_t ws_size, hipStream_t stream) {
    static int grid = 0;
    if (grid == 0) {
        if (n_in != 21 || in_sizes[0] != M * DM || out_size != M * DM || ws_size < WS_END) {
            fprintf(stderr, "kernel_launch: unexpected shapes (n_in %d, in0 %d, out %d, ws %zu < %zu); nothing launched\n", n_in, n_in > 0 ? in_sizes[0] : -1, out_size, ws_size, (size_t)WS_END); grid = -1; return; }
        int dev = 0, cus = 0, per_cu = 0;
        (void)hipGetDevice(&dev); (void)hipDeviceGetAttribute(&cus, hipDeviceAttributeMultiprocessorCount, dev);
        if (hipFuncSetAttribute((const void*)fwd_megakernel, hipFuncAttributeMaxDynamicSharedMemorySize, LDS_BYTES) != hipSuccess) { fprintf(stderr, "kernel_launch: hipFuncSetAttribute failed\n"); grid = -1; return; }
        if (hipOccupancyMaxActiveBlocksPerMultiprocessor(&per_cu, (const void*)fwd_megakernel, NTHREADS, LDS_BYTES) != hipSuccess || per_cu < 1) { fprintf(stderr, "kernel_launch: occupancy query says %d\n", per_cu); per_cu = 1; }
        (void)hipGetLastError();
        grid = cus * 1;
        if (grid <= 0) grid = 256;
    }
    if (grid < 0) return;
    Args a{};
    for (int i = 0; i < 21; ++i) a.in[i] = (const float*)d_in[i];
    a.out = (float*)d_out; a.ws = (unsigned char*)d_ws; a.ph_lo = 0; a.ph_hi = 26;
    (void)hipMemsetAsync((unsigned char*)d_ws + WS_BAR, 0, XCD_BAR_WORDS * sizeof(unsigned), stream);
    void* kargs[] = {&a};
    hipError_t e = hipLaunchCooperativeKernel((const void*)fwd_megakernel, dim3(grid), dim3(NTHREADS), kargs, LDS_BYTES, stream);
    if (e != hipSuccess) fprintf(stderr, "kernel_launch: cooperative launch failed: %s (grid %d)\n", hipGetErrorString(e), grid);
}
```
